# Optimizing an MI355X kernel written in HIP

```python
import math
import jax
import jax.numpy as jnp
from jax import lax
import numpy as np

D_MODEL = 1024
BATCH = 8
SEQ = 2048
DEPTH = 4
DEC_BATCH = 128
DEC_SEQ = 1
PAST_LEN = 8192
PAGE_SIZE = 128

N_A = DEPTH // 2
N_B = DEPTH - N_A
D_A = D_MODEL
DK_A = 128
H_A = D_A // DK_A
DV_A = D_A // H_A
CHUNK_A = 32
LB_FLOOR = 1e-30
H_B = D_MODEL // 128
NOPE = 128
ROPE_DIM = 64
V_DIM = 128
Q_LORA = 384
KV_LORA = 256
ROPE_THETA = 10000.0
Q_BLOCK = 128
SCALE = (NOPE + ROPE_DIM) ** -0.5
MASK_VALUE = -1e30
D_FF = ((8 * D_MODEL // 3 + 255) // 256) * 256
EPS = 1e-6

kernel_name = 'yoco_hgrn2_mla_decoder_step'


def rmsnorm(x, gain):
    xf = x.astype(jnp.float32)
    y = xf * lax.rsqrt(jnp.mean(xf * xf, axis=-1, keepdims=True) + EPS)
    return (y * gain.astype(jnp.float32)).astype(x.dtype)


def rope(x, pos):
    half = x.shape[-1] // 2
    inv = ROPE_THETA ** (-jnp.arange(half, dtype=jnp.float32) / half)
    ang = pos.astype(jnp.float32)[:, None] * inv[None, :]
    shape = (1, x.shape[1]) + (1,) * (x.ndim - 3) + (half,)
    cos = jnp.cos(ang).reshape(shape)
    sin = jnp.sin(ang).reshape(shape)
    xf = x.astype(jnp.float32)
    x1, x2 = xf[..., :half], xf[..., half:]
    return jnp.concatenate([x1 * cos - x2 * sin, x2 * cos + x1 * sin], axis=-1).astype(x.dtype)


def swiglu(h, w_in, w_out):
    g, u = jnp.split(h @ w_in, 2, axis=-1)
    return (jax.nn.silu(g) * u) @ w_out


def hgrn_lower_bounds(lb_logits):
    p = jax.nn.softmax(lb_logits.astype(jnp.float32), axis=0)
    return jnp.cumsum(p, axis=0) - p[0:1]


def hgrn2_chunked(q, k, v, log_f, s0, chunk):
    B, T, H, _ = q.shape
    DV = v.shape[-1]
    n = T // chunk

    def to_chunks(a):
        return a.reshape(B, n, chunk, H, a.shape[-1]).transpose(1, 0, 3, 2, 4)

    tril = jnp.tril(jnp.ones((chunk, chunk), dtype=bool))

    def step(s, inp):
        qc, kc, vc, gc = inp
        b = jnp.cumsum(gc, axis=2)
        diff = b[:, :, :, None, :] - b[:, :, None, :, :]
        decay = jnp.where(tril[:, :, None], jnp.exp(jnp.minimum(diff, 0.0)), 0.0)
        scores = jnp.einsum('bhtk,bhsk,bhtsk->bhts', qc, kc, decay)
        o = (jnp.einsum('bhts,bhsv->bhtv', scores, vc)
             + jnp.einsum('bhtk,bhkv->bhtv', qc * jnp.exp(b), s))
        b_last = b[:, :, -1:, :]
        s = (jnp.exp(b_last[:, :, 0, :, None]) * s
             + jnp.einsum('bhsk,bhsv->bhkv', kc * jnp.exp(b_last - b), vc))
        return s, o

    s, o = lax.scan(step, s0, (to_chunks(q), to_chunks(k), to_chunks(v), to_chunks(log_f)))
    o = o.transpose(1, 0, 3, 2, 4).reshape(B, T, H, DV)
    return o, s


def hgrn2_mixer(h, s0, lb, w_in, g_norm, w_out):
    B, T, _ = h.shape
    q, fz, i, gz = jnp.split(h @ w_in, 4, axis=-1)

    def heads(a):
        return a.astype(jnp.float32).reshape(B, T, H_A, -1)

    q = jax.nn.silu(heads(q)) * (DK_A ** -0.5)
    lbh = lb.reshape(H_A, DK_A)
    log_lb = jnp.log(jnp.maximum(lbh, LB_FLOOR))
    log_f = jnp.logaddexp(log_lb, jnp.log1p(-lbh) + jax.nn.log_sigmoid(heads(fz)))
    log_f = jnp.minimum(log_f, 0.0)
    k = -jnp.expm1(log_f)
    v = heads(i)
    o, s = hgrn2_chunked(q, k, v, log_f, s0.astype(jnp.float32), math.gcd(T, CHUNK_A))
    o = o * lax.rsqrt(jnp.mean(o * o, axis=-1, keepdims=True) + EPS)
    o = o * g_norm.astype(jnp.float32).reshape(H_A, DV_A) * jax.nn.silu(heads(gz))
    return o.reshape(B, T, D_A).astype(h.dtype) @ w_out, s


def mla_shared_kv(x, pos, kv_norm, w_dkv, kv_a_norm):
    ckr = rmsnorm(x, kv_norm) @ w_dkv
    c = rmsnorm(ckr[..., :KV_LORA], kv_a_norm)
    kr = rope(ckr[..., KV_LORA:], pos)
    return c, kr


def mla_attend(q_lat, q_rope, c_all, kr_all, q_pos, k_pos):
    B, T = q_lat.shape[0], q_lat.shape[1]

    def block(qb):
        ql, qr, qp = qb
        s = (jnp.einsum('bthc,bsc->bhts', ql, c_all)
             + jnp.einsum('bthr,bsr->bhts', qr, kr_all)).astype(jnp.float32) * SCALE
        s = jnp.where(k_pos[None, None, None, :] <= qp[None, None, :, None], s, MASK_VALUE)
        p = jax.nn.softmax(s, axis=-1).astype(c_all.dtype)
        return jnp.einsum('bhts,bsc->bthc', p, c_all)

    if T > Q_BLOCK and T % Q_BLOCK == 0:
        nb = T // Q_BLOCK

        def split(a):
            return a.reshape((B, nb, Q_BLOCK) + a.shape[2:]).swapaxes(0, 1)

        out = lax.map(block, (split(q_lat), split(q_rope), q_pos.reshape(nb, Q_BLOCK)))
        return out.swapaxes(0, 1).reshape(B, T, H_B, KV_LORA)
    return block((q_lat, q_rope, q_pos))


def mla_mixer(h, pos, c_all, kr_all, k_pos, w_ukv, w_dq, q_a_norm, w_uq, w_out):
    B, T, _ = h.shape
    q = (rmsnorm(h @ w_dq, q_a_norm) @ w_uq).reshape(B, T, H_B, NOPE + ROPE_DIM)
    q_nope, q_rope = q[..., :NOPE], rope(q[..., NOPE:], pos)
    w_ukv_h = w_ukv.reshape(KV_LORA, H_B, NOPE + V_DIM)
    q_lat = jnp.einsum('bthn,chn->bthc', q_nope, w_ukv_h[..., :NOPE])
    o_lat = mla_attend(q_lat, q_rope, c_all, kr_all, pos, k_pos)
    o = jnp.einsum('bthc,chv->bthv', o_lat, w_ukv_h[..., NOPE:]).reshape(B, T, H_B * V_DIM)
    return o @ w_out


def run_trunk(x, hgrn_states, c_past, kr_past, pos,
              norm_gains, w_ffn_in, w_ffn_out, w_in_a, lb_logits, g_norm_a, w_out_a,
              kv_norm, w_dkv, kv_a_norm, w_ukv, w_dq, q_a_norm, w_uq, w_out_b):
    lb = hgrn_lower_bounds(lb_logits)
    new_states = []
    c_new = kr_new = c_all = kr_all = k_pos = None
    for l in range(DEPTH):
        g = norm_gains[l]
        h = rmsnorm(x, g[0])
        if l < N_A:
            mix, s = hgrn2_mixer(h, hgrn_states[l], lb[l], w_in_a[l], g_norm_a[l], w_out_a[l])
            new_states.append(s)
        else:
            if l == N_A:
                c_new, kr_new = mla_shared_kv(x, pos, kv_norm, w_dkv, kv_a_norm)
                if c_past is None:
                    c_all, kr_all, k_pos = c_new, kr_new, pos
                else:
                    past_len = c_past.shape[1]
                    c_all = jnp.concatenate([c_past.astype(c_new.dtype), c_new], axis=1)
                    kr_all = jnp.concatenate([kr_past.astype(kr_new.dtype), kr_new], axis=1)
                    k_pos = jnp.concatenate([jnp.arange(past_len, dtype=jnp.int32), pos])
            j = l - N_A
            mix = mla_mixer(h, pos, c_all, kr_all, k_pos, w_ukv, w_dq[j], q_a_norm[j], w_uq[j], w_out_b[j])
        x = x + rmsnorm(mix, g[1])
        x = x + rmsnorm(swiglu(rmsnorm(x, g[2]), w_ffn_in[l], w_ffn_out[l]), g[3])
    return x, jnp.stack(new_states), c_new, kr_new


def setup_inputs(seed: int = 0) -> dict:
    key = jax.random.key(seed)
    ks = jax.random.split(key, 24)
    f32 = jnp.float32

    def nrm(k, shape, fan_in):
        return jax.random.normal(k, shape, f32) * (fan_in ** -0.5)

    def gain(k, shape):
        return 1.0 + 0.05 * jax.random.normal(k, shape, f32)

    n_pages = PAST_LEN // PAGE_SIZE
    n_used = DEC_BATCH * n_pages
    n_pool = n_used + max(1, n_used // 4)
    page_table = jax.random.permutation(ks[5], n_pool)[:n_used].reshape(DEC_BATCH, n_pages).astype(jnp.int32)

    return {
        'x_prompt': jax.random.normal(ks[0], (BATCH, SEQ, D_MODEL), f32),
        'x_sample': jax.random.normal(ks[1], (DEC_BATCH, DEC_SEQ, D_MODEL), f32),
        'state_hgrn': 0.3 * jax.random.normal(ks[2], (N_A, DEC_BATCH, H_A, DK_A, DV_A), f32),
        'cache_kv_latent': jax.random.normal(ks[3], (n_pool, PAGE_SIZE, KV_LORA), f32),
        'cache_k_rope': jax.random.normal(ks[4], (n_pool, PAGE_SIZE, ROPE_DIM), f32),
        'page_table': page_table,
        'norm_gains': gain(ks[6], (DEPTH, 4, D_MODEL)),
        'w_ffn_in': nrm(ks[7], (DEPTH, D_MODEL, 2 * D_FF), D_MODEL),
        'w_ffn_out': nrm(ks[8], (DEPTH, D_FF, D_MODEL), D_FF),
        'w_in_a': nrm(ks[9], (N_A, D_MODEL, 4 * D_A), D_MODEL),
        'lb_logits': 0.5 * jax.random.normal(ks[10], (N_A, D_A), f32),
        'g_norm_a': gain(ks[11], (N_A, D_A)),
        'w_out_a': nrm(ks[12], (N_A, D_A, D_MODEL), D_A),
        'kv_norm': gain(ks[13], (D_MODEL,)),
        'w_dkv': nrm(ks[14], (D_MODEL, KV_LORA + ROPE_DIM), D_MODEL),
        'kv_a_norm': gain(ks[15], (KV_LORA,)),
        'w_ukv': nrm(ks[16], (KV_LORA, H_B * (NOPE + V_DIM)), KV_LORA),
        'w_dq': nrm(ks[17], (N_B, D_MODEL, Q_LORA), D_MODEL),
        'q_a_norm': gain(ks[18], (N_B, Q_LORA)),
        'w_uq': nrm(ks[19], (N_B, Q_LORA, H_B * (NOPE + ROPE_DIM)), Q_LORA),
        'w_out_b': nrm(ks[20], (N_B, H_B * V_DIM, D_MODEL), H_B * V_DIM),
    }


def reference(x_prompt, x_sample, state_hgrn, cache_kv_latent, cache_k_rope, page_table,
              norm_gains, w_ffn_in, w_ffn_out, w_in_a, lb_logits, g_norm_a, w_out_a,
              kv_norm, w_dkv, kv_a_norm, w_ukv, w_dq, q_a_norm, w_uq, w_out_b):
    weights = (norm_gains, w_ffn_in, w_ffn_out, w_in_a, lb_logits, g_norm_a, w_out_a,
               kv_norm, w_dkv, kv_a_norm, w_ukv, w_dq, q_a_norm, w_uq, w_out_b)
    pos_p = jnp.arange(x_prompt.shape[1], dtype=jnp.int32)
    s0_p = jnp.zeros((N_A, x_prompt.shape[0], H_A, DK_A, DV_A), jnp.float32)
    y_p, st_p, c_p, kr_p = run_trunk(x_prompt, s0_p, None, None, pos_p, *weights)
    db, n_pages = page_table.shape
    past_len = n_pages * cache_kv_latent.shape[1]
    c_past = cache_kv_latent[page_table].reshape(db, past_len, KV_LORA)
    kr_past = cache_k_rope[page_table].reshape(db, past_len, ROPE_DIM)
    pos_s = past_len + jnp.arange(x_sample.shape[1], dtype=jnp.int32)
    y_s, st_s, c_s, kr_s = run_trunk(x_sample, state_hgrn, c_past, kr_past, pos_s, *weights)
    return (y_p, y_s, st_p, c_p, kr_p, st_s, c_s, kr_s)
```

```cpp
#include <hip/hip_runtime.h>
#include <math.h>

namespace {
constexpr int D = 1024, BATCH = 8, SEQ = 2048, MP = BATCH * SEQ, DB = 128, M = MP + DB;
constexpr int NA = 2, HA = 8, DK = 128, DV = 128;
constexpr int HB = 8, ROPE = 64, QL = 384, KVL = 256;
constexpr int PAST = 8192, PAGE = 128, NPAGES = PAST / PAGE;
constexpr int DFF = 2816;
constexpr float EPS = 1e-6f;

__global__ void __launch_bounds__(256) k_gemm(const float* __restrict__ A, const float* __restrict__ W, float* __restrict__ C, int Mm, int N, int K, int lda, int ldc) {
    __shared__ float As[16][64 + 4];
    __shared__ float Ws[16][64 + 4];
    const int tx = threadIdx.x & 15, ty = threadIdx.x >> 4;
    const int m0 = blockIdx.y * 64, n0 = blockIdx.x * 64;
    float acc[4][4] = {};
    for (int k0 = 0; k0 < K; k0 += 16) {
        for (int i = threadIdx.x; i < 64 * 16; i += 256) { const int r = i >> 4, kk = i & 15; As[kk][r] = A[(size_t)(m0 + r) * lda + k0 + kk]; }
        for (int i = threadIdx.x; i < 16 * 64; i += 256) { const int kk = i >> 6, c = i & 63; Ws[kk][c] = W[(size_t)(k0 + kk) * N + n0 + c]; }
        __syncthreads();
#pragma unroll
        for (int kk = 0; kk < 16; ++kk) {
            float a[4], b[4];
#pragma unroll
            for (int i = 0; i < 4; ++i) { a[i] = As[kk][ty * 4 + i]; b[i] = Ws[kk][tx * 4 + i]; }
#pragma unroll
            for (int i = 0; i < 4; ++i)
#pragma unroll
                for (int j = 0; j < 4; ++j) acc[i][j] += a[i] * b[j];
        }
        __syncthreads();
    }
#pragma unroll
    for (int i = 0; i < 4; ++i)
#pragma unroll
        for (int j = 0; j < 4; ++j) C[(size_t)(m0 + ty * 4 + i) * ldc + n0 + tx * 4 + j] = acc[i][j];
}

__device__ __forceinline__ float block_sum(float v, float* red) {
#pragma unroll
    for (int o = 32; o >= 1; o >>= 1) v += __shfl_xor(v, o);
    __syncthreads();
    if ((threadIdx.x & 63) == 0) red[threadIdx.x >> 6] = v;
    __syncthreads();
    return (red[0] + red[1]) + (red[2] + red[3]);
}

__global__ void __launch_bounds__(256) k_rmsnorm(const float* __restrict__ in, int ldi, const float* __restrict__ gain, float* out, int ldo, int n, int add) {
    __shared__ float red[4];
    const float* x = in + (size_t)blockIdx.x * ldi;
    float s = 0.f;
    for (int i = threadIdx.x; i < n; i += 256) s += x[i] * x[i];
    s = block_sum(s, red);
    const float r = rsqrtf(s / (float)n + EPS);
    float* o = out + (size_t)blockIdx.x * ldo;
    for (int i = threadIdx.x; i < n; i += 256) { const float y = x[i] * r * gain[i]; o[i] = add ? o[i] + y : y; }
}

__global__ void k_copy(const float* __restrict__ a, float* __restrict__ b, size_t n) {
    for (size_t i = (size_t)blockIdx.x * blockDim.x + threadIdx.x; i < n; i += (size_t)gridDim.x * blockDim.x) b[i] = a[i];
}

__device__ __forceinline__ float silu_f(float x) { return x / (1.f + expf(-x)); }

__global__ void k_hgrn_prep(float* P, const float* __restrict__ lb_logits, int layer) {
    const size_t n = (size_t)M * 1024;
    for (size_t i = (size_t)blockIdx.x * blockDim.x + threadIdx.x; i < n; i += (size_t)gridDim.x * blockDim.x) {
        const size_t row = i >> 10; const int d = (int)(i & 1023);
        float* p = P + row * 4096;
        const float q = p[d], z = p[1024 + d], gz = p[3072 + d];
        p[d] = silu_f(q) * 0.08838834764831845f;
        float lb = 0.f;
        if (layer == 1) { const float a0 = lb_logits[d], a1 = lb_logits[1024 + d]; lb = 1.f / (1.f + expf(a0 - a1)); }
        const float log_lb = logf(fmaxf(lb, 1e-30f));
        const float lsig = fminf(z, 0.f) - log1pf(expf(-fabsf(z)));
        const float bb = log1pf(-lb) + lsig;
        const float mx = fmaxf(log_lb, bb), mn = fminf(log_lb, bb);
        float lf = mx + log1pf(expf(mn - mx));
        lf = fminf(lf, 0.f);
        p[1024 + d] = lf;
        p[3072 + d] = silu_f(gz);
    }
}

__global__ void __launch_bounds__(128) k_hgrn_rec(const float* __restrict__ P, int row0, int T, const float* __restrict__ s0, float* __restrict__ s_out, float* __restrict__ O) {
    __shared__ float sq[128], sf[128], sk[128];
    const int seq = blockIdx.x >> 3, h = blockIdx.x & 7, dv = threadIdx.x;
    float S[128];
    const size_t sbase = ((size_t)seq * HA + h) * DK * DV;
#pragma unroll
    for (int k = 0; k < 128; ++k) S[k] = s0 ? s0[sbase + (size_t)k * DV + dv] : 0.f;
    for (int t = 0; t < T; ++t) {
        const float* p = P + (size_t)(row0 + seq * T + t) * 4096 + h * 128;
        __syncthreads();
        sq[dv] = p[dv]; { const float lf = p[1024 + dv]; sf[dv] = expf(lf); sk[dv] = -expm1f(lf); }
        const float v = p[2048 + dv];
        __syncthreads();
        float o = 0.f;
#pragma unroll
        for (int k = 0; k < 128; ++k) { S[k] = sf[k] * S[k] + sk[k] * v; o += sq[k] * S[k]; }
        O[(size_t)(row0 + seq * T + t) * 1024 + h * 128 + dv] = o;
    }
#pragma unroll
    for (int k = 0; k < 128; ++k) s_out[sbase + (size_t)k * DV + dv] = S[k];
}

__global__ void __launch_bounds__(128) k_hgrn_post(const float* __restrict__ O, const float* __restrict__ P, const float* __restrict__ gnorm, float* __restrict__ OG) {
    __shared__ float red[2];
    const size_t row = blockIdx.x >> 3; const int h = blockIdx.x & 7, dv = threadIdx.x;
    const float o = O[row * 1024 + h * 128 + dv];
    float s = o * o;
#pragma unroll
    for (int off = 32; off >= 1; off >>= 1) s += __shfl_xor(s, off);
    if ((dv & 63) == 0) red[dv >> 6] = s;
    __syncthreads();
    const float r = rsqrtf((red[0] + red[1]) / 128.f + EPS);
    OG[row * 1024 + h * 128 + dv] = o * r * gnorm[h * 128 + dv] * P[row * 4096 + 3072 + h * 128 + dv];
}

__global__ void k_swiglu(const float* __restrict__ U, float* __restrict__ ACT) {
    const size_t n = (size_t)M * DFF;
    for (size_t i = (size_t)blockIdx.x * blockDim.x + threadIdx.x; i < n; i += (size_t)gridDim.x * blockDim.x) {
        const size_t row = i / DFF; const int j = (int)(i % DFF);
        ACT[i] = silu_f(U[row * (2 * DFF) + j]) * U[row * (2 * DFF) + DFF + j];
    }
}

__device__ __forceinline__ int row_pos(int row) { return row < MP ? (row & (SEQ - 1)) : PAST; }

__global__ void __launch_bounds__(256) k_kv_finish(const float* __restrict__ CKR, const float* __restrict__ kv_a_norm, float* c_p, float* kr_p, float* c_s, float* kr_s) {
    __shared__ float red[4];
    const int row = blockIdx.x, t = threadIdx.x;
    const float* x = CKR + (size_t)row * 320;
    const float v = x[t];
    const float s = block_sum(v * v, red);
    const float r = rsqrtf(s / 256.f + EPS);
    float* c = row < MP ? c_p + (size_t)row * 256 : c_s + (size_t)(row - MP) * 256;
    float* kr = row < MP ? kr_p + (size_t)row * 64 : kr_s + (size_t)(row - MP) * 64;
    c[t] = v * r * kv_a_norm[t];
    if (t < 32) {
        const double inv = pow(10000.0, -(double)t / 32.0);
        const double ang = (double)row_pos(row) * inv;
        const float cs = (float)cos(ang), sn = (float)sin(ang);
        const float x1 = x[256 + t], x2 = x[256 + 32 + t];
        kr[t] = x1 * cs - x2 * sn; kr[32 + t] = x2 * cs + x1 * sn;
    }
}

__global__ void k_q_rope(float* Q) {
    const size_t n = (size_t)M * HB * 32;
    for (size_t i = (size_t)blockIdx.x * blockDim.x + threadIdx.x; i < n; i += (size_t)gridDim.x * blockDim.x) {
        const int j = (int)(i & 31); const int h = (int)((i >> 5) & 7); const int row = (int)(i >> 8);
        const double inv = pow(10000.0, -(double)j / 32.0);
        const double ang = (double)row_pos(row) * inv;
        const float cs = (float)cos(ang), sn = (float)sin(ang);
        float* q = Q + (size_t)row * 1536 + h * 192 + 128;
        const float x1 = q[j], x2 = q[32 + j];
        q[j] = x1 * cs - x2 * sn; q[32 + j] = x2 * cs + x1 * sn;
    }
}

__global__ void __launch_bounds__(256) k_attn_prompt(const float* __restrict__ Q, const float* __restrict__ KV, const float* __restrict__ KR, float* __restrict__ O) {
    __shared__ __attribute__((aligned(16))) float sq[192];
    __shared__ float sc[SEQ];
    __shared__ float red[8];
    const int t = blockIdx.x & (SEQ - 1), h = (blockIdx.x >> 11) & 7, b = blockIdx.x >> 14;
    const int row = b * SEQ + t, tid = threadIdx.x;
    if (tid < 192) sq[tid] = Q[(size_t)row * 1536 + h * 192 + tid];
    __syncthreads();
    const float scale = 0.07216878364870322f;
    float mx = -1e30f;
    for (int s = tid; s <= t; s += 256) {
        const float4* kn = (const float4*)(KV + (size_t)(b * SEQ + s) * 2048 + h * 256);
        const float4* kr = (const float4*)(KR + (size_t)(b * SEQ + s) * 64);
        float d = 0.f;
        for (int i = 0; i < 32; ++i) { const float4 k4 = kn[i]; const float4 q4 = *(const float4*)(sq + 4 * i); d += q4.x * k4.x + q4.y * k4.y + q4.z * k4.z + q4.w * k4.w; }
        for (int i = 0; i < 16; ++i) { const float4 k4 = kr[i]; const float4 q4 = *(const float4*)(sq + 128 + 4 * i); d += q4.x * k4.x + q4.y * k4.y + q4.z * k4.z + q4.w * k4.w; }
        d *= scale; sc[s] = d; mx = fmaxf(mx, d);
    }
#pragma unroll
    for (int o = 32; o >= 1; o >>= 1) mx = fmaxf(mx, __shfl_xor(mx, o));
    __syncthreads();
    if ((tid & 63) == 0) red[tid >> 6] = mx;
    __syncthreads();
    mx = fmaxf(fmaxf(red[0], red[1]), fmaxf(red[2], red[3]));
    float sum = 0.f;
    for (int s = tid; s <= t; s += 256) { const float p = expf(sc[s] - mx); sc[s] = p; sum += p; }
    sum = block_sum(sum, red + 4);
    __syncthreads();
    const int d = tid & 127, half = tid >> 7;
    float o = 0.f;
    for (int s = half; s <= t; s += 2) o += sc[s] * KV[(size_t)(b * SEQ + s) * 2048 + h * 256 + 128 + d];
    __syncthreads();
    if (half == 1) sq[d] = o;
    __syncthreads();
    if (half == 0) O[(size_t)row * 1024 + h * 128 + d] = (o + sq[d]) / sum;
}

constexpr int SCP = PAST + 64;
__global__ void __launch_bounds__(256) k_attn_sample(const float* __restrict__ Q, const float* __restrict__ w_ukv, const float* __restrict__ cache_c, const float* __restrict__ cache_kr,
                                                    const int* __restrict__ page_table, const float* __restrict__ c_s, const float* __restrict__ kr_s, float* SC, float* __restrict__ O) {
    __shared__ __attribute__((aligned(16))) float ql[8][256];
    __shared__ __attribute__((aligned(16))) float qr[8][64];
    __shared__ float red[4];
    __shared__ float smx[8], ssum[8];
    const int b = blockIdx.x, tid = threadIdx.x, row = MP + b;
    const float scale = 0.07216878364870322f;
    for (int h = 0; h < 8; ++h) {
        const float* qn = Q + (size_t)row * 1536 + h * 192;
        const float* w = w_ukv + (size_t)tid * 2048 + h * 256;
        float a = 0.f;
        for (int n = 0; n < 128; ++n) a += qn[n] * w[n];
        ql[h][tid] = a;
        if (tid < 64) qr[h][tid] = qn[128 + tid];
    }
    __syncthreads();
    float* sc = SC + (size_t)b * 8 * SCP;
    float mx0 = -1e30f, mx1 = -1e30f, mx2 = -1e30f, mx3 = -1e30f, mx4 = -1e30f, mx5 = -1e30f, mx6 = -1e30f, mx7 = -1e30f;
    for (int s = tid; s <= PAST; s += 256) {
        const float4* c; const float4* kr;
        if (s < PAST) { const int pg = page_table[b * NPAGES + (s >> 7)]; c = (const float4*)(cache_c + ((size_t)pg * PAGE + (s & 127)) * 256); kr = (const float4*)(cache_kr + ((size_t)pg * PAGE + (s & 127)) * 64); }
        else { c = (const float4*)(c_s + (size_t)b * 256); kr = (const float4*)(kr_s + (size_t)b * 64); }
        float d0 = 0.f, d1 = 0.f, d2 = 0.f, d3 = 0.f, d4 = 0.f, d5 = 0.f, d6 = 0.f, d7 = 0.f;
#define DOT4(dst, qp) { const float4 q4 = *(const float4*)(qp); dst += q4.x * cv.x + q4.y * cv.y + q4.z * cv.z + q4.w * cv.w; }
        for (int i = 0; i < 64; ++i) { const float4 cv = c[i];
            DOT4(d0, &ql[0][4 * i]) DOT4(d1, &ql[1][4 * i]) DOT4(d2, &ql[2][4 * i]) DOT4(d3, &ql[3][4 * i]) DOT4(d4, &ql[4][4 * i]) DOT4(d5, &ql[5][4 * i]) DOT4(d6, &ql[6][4 * i]) DOT4(d7, &ql[7][4 * i]) }
        for (int i = 0; i < 16; ++i) { const float4 cv = kr[i];
            DOT4(d0, &qr[0][4 * i]) DOT4(d1, &qr[1][4 * i]) DOT4(d2, &qr[2][4 * i]) DOT4(d3, &qr[3][4 * i]) DOT4(d4, &qr[4][4 * i]) DOT4(d5, &qr[5][4 * i]) DOT4(d6, &qr[6][4 * i]) DOT4(d7, &qr[7][4 * i]) }
#undef DOT4
        d0 *= scale; d1 *= scale; d2 *= scale; d3 *= scale; d4 *= scale; d5 *= scale; d6 *= scale; d7 *= scale;
        sc[0 * SCP + s] = d0; sc[1 * SCP + s] = d1; sc[2 * SCP + s] = d2; sc[3 * SCP + s] = d3; sc[4 * SCP + s] = d4; sc[5 * SCP + s] = d5; sc[6 * SCP + s] = d6; sc[7 * SCP + s] = d7;
        mx0 = fmaxf(mx0, d0); mx1 = fmaxf(mx1, d1); mx2 = fmaxf(mx2, d2); mx3 = fmaxf(mx3, d3); mx4 = fmaxf(mx4, d4); mx5 = fmaxf(mx5, d5); mx6 = fmaxf(mx6, d6); mx7 = fmaxf(mx7, d7);
    }
#define BMAX(h, m) { float mm = m; _Pragma("unroll") for (int o = 32; o >= 1; o >>= 1) mm = fmaxf(mm, __shfl_xor(mm, o)); __syncthreads(); if ((tid & 63) == 0) red[tid >> 6] = mm; __syncthreads(); if (tid == 0) smx[h] = fmaxf(fmaxf(red[0], red[1]), fmaxf(red[2], red[3])); }
    BMAX(0, mx0) BMAX(1, mx1) BMAX(2, mx2) BMAX(3, mx3) BMAX(4, mx4) BMAX(5, mx5) BMAX(6, mx6) BMAX(7, mx7)
#undef BMAX
    __syncthreads();
    for (int h = 0; h < 8; ++h) {
        float sum = 0.f; const float m = smx[h];
        for (int s = tid; s <= PAST; s += 256) { const float p = expf(sc[(size_t)h * SCP + s] - m); sc[(size_t)h * SCP + s] = p; sum += p; }
        sum = block_sum(sum, red);
        if (tid == 0) ssum[h] = sum;
    }
    __threadfence_block();
    __syncthreads();
    float a0 = 0.f, a1 = 0.f, a2 = 0.f, a3 = 0.f, a4 = 0.f, a5 = 0.f, a6 = 0.f, a7 = 0.f;
    for (int s = 0; s <= PAST; ++s) {
        float cv;
        if (s < PAST) { const int pg = page_table[b * NPAGES + (s >> 7)]; cv = cache_c[((size_t)pg * PAGE + (s & 127)) * 256 + tid]; }
        else cv = c_s[(size_t)b * 256 + tid];
        a0 += sc[0 * SCP + s] * cv; a1 += sc[1 * SCP + s] * cv; a2 += sc[2 * SCP + s] * cv; a3 += sc[3 * SCP + s] * cv;
        a4 += sc[4 * SCP + s] * cv; a5 += sc[5 * SCP + s] * cv; a6 += sc[6 * SCP + s] * cv; a7 += sc[7 * SCP + s] * cv;
    }
    __syncthreads();
    ql[0][tid] = a0 / ssum[0]; ql[1][tid] = a1 / ssum[1]; ql[2][tid] = a2 / ssum[2]; ql[3][tid] = a3 / ssum[3];
    ql[4][tid] = a4 / ssum[4]; ql[5][tid] = a5 / ssum[5]; ql[6][tid] = a6 / ssum[6]; ql[7][tid] = a7 / ssum[7];
    __syncthreads();
    for (int idx = tid; idx < 1024; idx += 256) {
        const int h = idx >> 7, v = idx & 127;
        float a = 0.f;
        for (int c = 0; c < 256; ++c) a += ql[h][c] * w_ukv[(size_t)c * 2048 + h * 256 + 128 + v];
        O[(size_t)row * 1024 + idx] = a;
    }
}

void gemm(hipStream_t st, const float* A, const float* W, float* C, int Mm, int N, int K, int lda, int ldc) {
    k_gemm<<<dim3(N / 64, Mm / 64), 256, 0, st>>>(A, W, C, Mm, N, K, lda, ldc);
}
}

extern "C" void kernel_launch(void* const* d_in, const int* in_sizes, int n_in, void* d_out, int out_size, void* d_ws, size_t ws_size, hipStream_t stream) {
    const float* x_prompt = (const float*)d_in[0]; const float* x_sample = (const float*)d_in[1]; const float* state_hgrn = (const float*)d_in[2];
    const float* cache_c = (const float*)d_in[3]; const float* cache_kr = (const float*)d_in[4]; const int* page_table = (const int*)d_in[5];
    const float* norm_gains = (const float*)d_in[6]; const float* w_ffn_in = (const float*)d_in[7]; const float* w_ffn_out = (const float*)d_in[8];
    const float* w_in_a = (const float*)d_in[9]; const float* lb_logits = (const float*)d_in[10]; const float* g_norm_a = (const float*)d_in[11];
    const float* w_out_a = (const float*)d_in[12]; const float* kv_norm = (const float*)d_in[13]; const float* w_dkv = (const float*)d_in[14];
    const float* kv_a_norm = (const float*)d_in[15]; const float* w_ukv = (const float*)d_in[16]; const float* w_dq = (const float*)d_in[17];
    const float* q_a_norm = (const float*)d_in[18]; const float* w_uq = (const float*)d_in[19]; const float* w_out_b = (const float*)d_in[20];
    float* out = (float*)d_out;
    float* X = out;
    float* st_p = out + (size_t)M * D;
    float* c_p = st_p + (size_t)NA * BATCH * HA * DK * DV;
    float* kr_p = c_p + (size_t)MP * KVL;
    float* st_s = kr_p + (size_t)MP * ROPE;
    float* c_s = st_s + (size_t)NA * DB * HA * DK * DV;
    float* kr_s = c_s + (size_t)DB * KVL;
    float* ws = (float*)d_ws;
    float* Hn = ws;
    float* P = Hn + (size_t)M * 1024;
    float* T1 = P + (size_t)M * 5632;
    float* T2 = T1 + (size_t)M * 2816;
    float* T3 = T2 + (size_t)M * 1024;
    float* KVb = T3 + (size_t)M * 1024;
    float* SC = KVb + (size_t)MP * 2048;

    k_copy<<<2048, 256, 0, stream>>>(x_prompt, X, (size_t)MP * D);
    k_copy<<<256, 256, 0, stream>>>(x_sample, X + (size_t)MP * D, (size_t)DB * D);
    for (int l = 0; l < 4; ++l) {
        const float* g = norm_gains + (size_t)l * 4 * D;
        if (l == 2) {
            k_rmsnorm<<<M, 256, 0, stream>>>(X, D, kv_norm, Hn, D, D, 0);
            gemm(stream, Hn, w_dkv, T2, M, 320, D, D, 320);
            k_kv_finish<<<M, 256, 0, stream>>>(T2, kv_a_norm, c_p, kr_p, c_s, kr_s);
            gemm(stream, c_p, w_ukv, KVb, MP, 2048, KVL, KVL, 2048);
        }
        k_rmsnorm<<<M, 256, 0, stream>>>(X, D, g, Hn, D, D, 0);
        if (l < 2) {
            gemm(stream, Hn, w_in_a + (size_t)l * D * 4096, P, M, 4096, D, D, 4096);
            k_hgrn_prep<<<4096, 256, 0, stream>>>(P, lb_logits, l);
            k_hgrn_rec<<<BATCH * HA, 128, 0, stream>>>(P, 0, SEQ, nullptr, st_p + (size_t)l * BATCH * HA * DK * DV, T2);
            k_hgrn_rec<<<DB * HA, 128, 0, stream>>>(P, MP, 1, state_hgrn + (size_t)l * DB * HA * DK * DV, st_s + (size_t)l * DB * HA * DK * DV, T2);
            k_hgrn_post<<<M * HA, 128, 0, stream>>>(T2, P, g_norm_a + (size_t)l * D, T3);
            gemm(stream, T3, w_out_a + (size_t)l * D * D, T2, M, D, D, D, D);
        } else {
            const int j = l - 2;
            gemm(stream, Hn, w_dq + (size_t)j * D * QL, T2, M, QL, D, D, QL);
            k_rmsnorm<<<M, 256, 0, stream>>>(T2, QL, q_a_norm + (size_t)j * QL, T3, QL, QL, 0);
            gemm(stream, T3, w_uq + (size_t)j * QL * 1536, P, M, 1536, QL, QL, 1536);
            k_q_rope<<<2048, 256, 0, stream>>>(P);
            k_attn_prompt<<<BATCH * HB * SEQ, 256, 0, stream>>>(P, KVb, kr_p, T3);
            k_attn_sample<<<DB, 256, 0, stream>>>(P, w_ukv, cache_c, cache_kr, page_table, c_s, kr_s, SC, T3);
            gemm(stream, T3, w_out_b + (size_t)j * D * D, T2, M, D, D, D, D);
        }
        k_rmsnorm<<<M, 256, 0, stream>>>(T2, D, g + D, X, D, D, 1);
        k_rmsnorm<<<M, 256, 0, stream>>>(X, D, g + 2 * D, Hn, D, D, 0);
        gemm(stream, Hn, w_ffn_in + (size_t)l * D * 2 * DFF, P, M, 2 * DFF, D, D, 2 * DFF);
        k_swiglu<<<4096, 256, 0, stream>>>(P, T1);
        gemm(stream, T1, w_ffn_out + (size_t)l * DFF * D, T2, M, D, DFF, DFF, D);
        k_rmsnorm<<<M, 256, 0, stream>>>(T2, D, g + 3 * D, X, D, D, 1);
    }
}
```

```cpp
#include <hip/hip_runtime.h>
#include <cstdio>
#include <cstdint>
#include <math.h>
#define GAS __attribute__((address_space(1)))
#define LAS __attribute__((address_space(3)))
typedef unsigned short bf16;
typedef unsigned v4u __attribute__((ext_vector_type(4)));
typedef unsigned v2u __attribute__((ext_vector_type(2)));
typedef float f32x4 __attribute__((ext_vector_type(4)));
typedef short bf16x8 __attribute__((ext_vector_type(8)));
constexpr int NWAVES = 8, NTHR = 512;
constexpr int D = 1024, BATCH = 8, SEQ = 2048, MP = BATCH * SEQ, DB = 128, M = MP + DB;
constexpr int HA = 8, DK = 128, DV = 128;
constexpr int QL = 384, KVL = 256;
constexpr int PAST = 8192, PAGE = 128, NPAGES = PAST / PAGE;
constexpr int DFF = 2816;
constexpr float EPS = 1e-6f;
constexpr float QSCALE = 0.07216878364870322f * 1.4426950408889634f;
constexpr int QCP = 768;
constexpr int SCP = PAST + 64;

constexpr size_t MiB = 1u << 20;
constexpr size_t WS_CTL = 0, CTL_BYTES = 1 * MiB;
constexpr size_t WS_WIN   = 1 * MiB;
constexpr size_t WS_WOUTA = WS_WIN + 2 * (size_t)4096 * 1024 * 2;
constexpr size_t WS_WFIN  = WS_WOUTA + 2 * (size_t)1024 * 1024 * 2;
constexpr size_t WS_WFOUT = WS_WFIN + 4 * (size_t)5632 * 1024 * 2;
constexpr size_t WS_WDQ0  = WS_WFOUT + 4 * (size_t)1024 * 2816 * 2;
constexpr size_t WS_WDQ1  = WS_WDQ0 + (size_t)768 * 1024 * 2;
constexpr size_t WS_WUQ   = WS_WDQ1 + (size_t)512 * 1024 * 2;
constexpr size_t WS_WUKV  = WS_WUQ + 2 * (size_t)1536 * 384 * 2;
constexpr size_t WS_WUKVN = WS_WUKV + (size_t)2048 * 256 * 2;
constexpr size_t WS_WOUTB = WS_WUKVN + (size_t)256 * 2048 * 2;
constexpr size_t WS_CS    = WS_WOUTB + 2 * (size_t)1024 * 1024 * 2;
constexpr size_t WS_LBT   = WS_CS + (size_t)2049 * 64 * 4 + 256;
constexpr size_t WS_HN    = ((WS_LBT + 2 * 1024 * 2 * 4 + 4095) / 4096) * 4096;
constexpr size_t WS_QB    = WS_HN + (size_t)M * 1024 * 2;
constexpr size_t WS_VB    = WS_QB + (size_t)M * 1024 * 2;
constexpr size_t WS_GATE  = WS_VB + (size_t)M * 1024 * 2;
constexpr size_t WS_GB    = WS_GATE + (size_t)M * 1024 * 2;
constexpr size_t WS_OG    = WS_GB + (size_t)M * 1024 * 4;
constexpr size_t WS_MIX   = WS_OG + (size_t)M * 1024 * 2;
constexpr size_t WS_ACT   = WS_MIX + (size_t)M * 1024 * 4;
constexpr size_t WS_QC    = WS_ACT + (size_t)M * 2816 * 2;
constexpr size_t WS_QAN   = WS_QC + (size_t)M * QCP * 4;
constexpr size_t WS_CB    = WS_QAN + (size_t)M * 384 * 2;
constexpr size_t WS_KRB   = WS_CB + (size_t)M * 256 * 2;
constexpr size_t WS_QN    = WS_KRB + (size_t)MP * 64 * 2;
constexpr size_t WS_QR    = WS_QN + (size_t)M * 1024 * 2;
constexpr size_t WS_KN    = WS_QR + (size_t)M * 512 * 2;
constexpr size_t WS_VV    = WS_KN + (size_t)MP * 1024 * 2;
constexpr size_t WS_SC    = WS_VV + (size_t)MP * 1024 * 2;
constexpr size_t WS_END   = WS_SC + (size_t)DB * 8 * SCP * 4;
constexpr int CW_BAR = 4096;
constexpr int RING_BYTES = 131072, MISC_OFF = RING_BYTES + 320, LDS_BYTES = 147456;

__device__ __forceinline__ float bf2f(unsigned b) { return __uint_as_float(b << 16); }
__device__ __forceinline__ unsigned f2bf(float f) { unsigned u = __float_as_uint(f); return (u + 0x7fffu + ((u >> 16) & 1u)) >> 16; }
__device__ __forceinline__ unsigned pk2(float lo, float hi) { return f2bf(lo) | (f2bf(hi) << 16); }
#define LDS_WAIT() asm volatile("s_waitcnt lgkmcnt(0)" ::: "memory")
__device__ __forceinline__ int lane_id_v() { int l; asm volatile("v_mbcnt_lo_u32_b32 %0, -1, 0\n\tv_mbcnt_hi_u32_b32 %0, -1, %0" : "=v"(l)); return l; }
__device__ __forceinline__ float shx(float v, int mask, int lane) { return __int_as_float(__builtin_amdgcn_ds_bpermute((lane ^ mask) << 2, __float_as_int(v))); }
__device__ __forceinline__ float wave_sum(float v) {
    const int lane = lane_id_v();
#pragma unroll
    for (int o = 1; o < 64; o <<= 1) v += shx(v, o, lane);
    return v;
}
__device__ __forceinline__ float wave_max(float v) {
    const int lane = lane_id_v();
#pragma unroll
    for (int o = 1; o < 64; o <<= 1) v = fmaxf(v, shx(v, o, lane));
    return v;
}
namespace pg8 {
#define PG8_LAS __attribute__((address_space(3)))
typedef unsigned short bf16_t;
typedef short bf16x8 __attribute__((ext_vector_type(8)));
typedef float f32x4 __attribute__((ext_vector_type(4)));
typedef unsigned u32x4 __attribute__((ext_vector_type(4)));
constexpr int BM = 256, BK = 64, HALF = 128, HTB = HALF * BK * 2  , STAGE_BYTES = 8 * HTB, NXCD = 8, WGM = 8;

__host__ __device__ __forceinline__ int lds_byte(int r, int c) { const int st = (r >> 4) * 2 + (c >> 5), rr = r & 15, cc = c & 31, ob = rr * 64 + cc * 2; return st * 1024 + (ob ^ (((ob >> 9) & 1) << 5)); }
__host__ __device__ __forceinline__ void stage_rc(int b, int& R, int& C) { const int st = b / 1024, sb = b % 1024, swz = sb ^ (((sb >> 9) & 1) << 5); R = (st >> 1) * 16 + swz / 64; C = (st & 1) * 32 + (swz % 64) / 2; }
__host__ __device__ __forceinline__ int perm32(int rho) { const int n = rho >> 4, i = rho & 15; return 8 * (i >> 2) + 4 * n + (i & 3); }

struct Unit { int pm, pn; };
struct Gemm { const bf16_t* A; const bf16_t* Bt; int M, N, K; };

struct StaticOrder {
    int nM, nN, nwg, G, c;
    __host__ __device__ void init(int M, int N, int G_, int c_) { nM = M / BM; nN = N / BM; nwg = nM * nN; G = G_; c = c_; }
    __host__ __device__ bool next(int i, Unit& u) const {
        const long L = (long)i * G + c; if (L >= nwg) return false;
        int wgid = (int)L; { const int q = nwg / NXCD, r = nwg % NXCD, xcd = wgid % NXCD, off = wgid / NXCD; wgid = (xcd < r ? xcd * (q + 1) : r * (q + 1) + (xcd - r) * q) + off; }
        const int nig = WGM * nN, gid = wgid / nig, fm = gid * WGM, gsz = (nM - fm) < WGM ? (nM - fm) : WGM;
        u.pm = fm + ((wgid % nig) % gsz); u.pn = (wgid % nig) / gsz; return true;
    }
    __device__ __forceinline__ void a_ready(const Unit&) const {}
    __device__ __forceinline__ void done(const Unit&) const {}
};

__device__ __forceinline__ unsigned cvt_pk_bf16(float lo, float hi) { unsigned r; asm volatile("v_cvt_pk_bf16_f32 %0, %1, %2" : "=v"(r) : "v"(lo), "v"(hi)); return r; }
typedef float f32x2 __attribute__((ext_vector_type(2)));
__device__ __forceinline__ float silu_fast(float x) { return x * __builtin_amdgcn_rcpf(1.0f + __expf(-x)); }
__device__ __forceinline__ float logf_gate(float z, float log_lb, float l1p) {
    const float lsig = fminf(z, 0.f) - __logf(1.0f + __expf(-fabsf(z)));
    const float bb = l1p + lsig;
    const float mx = fmaxf(log_lb, bb), mn = fminf(log_lb, bb);
    return fminf(mx + __logf(1.0f + __expf(mn - mx)), 0.f);
}
struct EpiF32 {
    static constexpr bool PERM = false, AFTER_DRAIN = false;
    float* C; int ldc;
    __device__ __forceinline__ void operator()(const f32x4 (&acc)[2][2][4][2], const Unit& u, int wr, int wc, int fr_, int fq_) const {
        const int ln_ = lane_id_v(); const int fr = ln_ & 15, fq = ln_ >> 4;
        const int row0 = u.pm * BM + wr * 64 + fr, col0 = u.pn * BM + wc * 32 + 4 * fq;
#pragma unroll
        for (int ai = 0; ai < 2; ++ai)
#pragma unroll
            for (int m = 0; m < 4; ++m) { float* rowp = C + (size_t)(row0 + ai * HALF + m * 16) * ldc + col0;
#pragma unroll
                for (int bj = 0; bj < 2; ++bj)
#pragma unroll
                    for (int n = 0; n < 2; ++n) *(f32x4*)(rowp + bj * HALF + n * 16) = acc[ai][bj][m][n]; }
    }
};
struct EpiBf16Split {
    static constexpr bool PERM = true, AFTER_DRAIN = false;
    bf16_t* O; int ldc; int split_cols; size_t split_stride;
    __device__ __forceinline__ void operator()(const f32x4 (&acc)[2][2][4][2], const Unit& u, int wr, int wc, int fr_, int fq_) const {
        const int ln_ = lane_id_v(); const int fr = ln_ & 15, fq = ln_ >> 4;
        const int row0 = u.pm * BM + wr * 64 + fr; int colt = u.pn * BM; bf16_t* base = O;
        if (split_cols) { const int t = colt / split_cols; base += (size_t)t * split_stride; colt -= t * split_cols; }
        const int col0 = colt + wc * 32 + 8 * fq;
#pragma unroll
        for (int ai = 0; ai < 2; ++ai)
#pragma unroll
            for (int m = 0; m < 4; ++m) { bf16_t* rowp = base + (size_t)(row0 + ai * HALF + m * 16) * ldc + col0;
#pragma unroll
                for (int bj = 0; bj < 2; ++bj) { const f32x4 v0 = acc[ai][bj][m][0], v1 = acc[ai][bj][m][1];
                    u32x4 w; w.x = cvt_pk_bf16(v0[0], v0[1]); w.y = cvt_pk_bf16(v0[2], v0[3]); w.z = cvt_pk_bf16(v1[0], v1[1]); w.w = cvt_pk_bf16(v1[2], v1[3]);
                    *(u32x4*)(rowp + bj * HALF) = w; } }
    }
};
struct EpiHgrnIn {
    static constexpr bool PERM = true, AFTER_DRAIN = false;
    unsigned char* ws; int layer;
    __device__ __forceinline__ void operator()(const f32x4 (&acc)[2][2][4][2], const Unit& u, int wr, int wc, int fr_, int fq_) const {
        const int ln_ = lane_id_v(); const int fr = ln_ & 15, fq = ln_ >> 4;
        const int row0 = u.pm * BM + wr * 64 + fr; const int type = u.pn >> 2; const int cl0 = (u.pn & 3) * 256 + wc * 32 + 8 * fq;
        if (type == 1) {
            const float* lbt = (const float*)(ws + WS_LBT) + (size_t)layer * 2048; float* GB = (float*)(ws + WS_GB);
#pragma unroll
            for (int bj = 0; bj < 2; ++bj) {
                const int cl = cl0 + bj * HALF;
                f32x4 t0 = *(const f32x4*)(lbt + 2 * cl), t1 = *(const f32x4*)(lbt + 2 * cl + 4), t2 = *(const f32x4*)(lbt + 2 * cl + 8), t3 = *(const f32x4*)(lbt + 2 * cl + 12);
#pragma unroll
                for (int ai = 0; ai < 2; ++ai)
#pragma unroll
                    for (int m = 0; m < 4; ++m) {
                        const f32x4 v0 = acc[ai][bj][m][0], v1 = acc[ai][bj][m][1]; f32x4 o0, o1;
                        o0[0] = logf_gate(v0[0], t0[0], t0[1]); o0[1] = logf_gate(v0[1], t0[2], t0[3]); o0[2] = logf_gate(v0[2], t1[0], t1[1]); o0[3] = logf_gate(v0[3], t1[2], t1[3]);
                        o1[0] = logf_gate(v1[0], t2[0], t2[1]); o1[1] = logf_gate(v1[1], t2[2], t2[3]); o1[2] = logf_gate(v1[2], t3[0], t3[1]); o1[3] = logf_gate(v1[3], t3[2], t3[3]);
                        float* p = GB + (size_t)(row0 + ai * HALF + m * 16) * 1024 + cl;
                        *(f32x4*)p = o0; *(f32x4*)(p + 4) = o1;
                    }
            }
        } else {
            bf16_t* dst = (bf16_t*)(ws + (type == 0 ? WS_QB : (type == 2 ? WS_VB : WS_GATE)));
#pragma unroll
            for (int ai = 0; ai < 2; ++ai)
#pragma unroll
                for (int m = 0; m < 4; ++m)
#pragma unroll
                    for (int bj = 0; bj < 2; ++bj) {
                        f32x4 v0 = acc[ai][bj][m][0], v1 = acc[ai][bj][m][1];
                        if (type == 0) {
#pragma unroll
                            for (int j = 0; j < 4; ++j) { v0[j] = silu_fast(v0[j]) * 0.08838834764831845f; v1[j] = silu_fast(v1[j]) * 0.08838834764831845f; }
                        } else if (type == 3) {
#pragma unroll
                            for (int j = 0; j < 4; ++j) { v0[j] = silu_fast(v0[j]); v1[j] = silu_fast(v1[j]); }
                        }
                        u32x4 w; w.x = cvt_pk_bf16(v0[0], v0[1]); w.y = cvt_pk_bf16(v0[2], v0[3]); w.z = cvt_pk_bf16(v1[0], v1[1]); w.w = cvt_pk_bf16(v1[2], v1[3]);
                        *(u32x4*)(dst + (size_t)(row0 + ai * HALF + m * 16) * 1024 + cl0 + bj * HALF) = w;
                    }
        }
    }
};
struct EpiSwiglu {
    static constexpr bool PERM = true, AFTER_DRAIN = false;
    bf16_t* ACT; int ldc;
    __device__ __forceinline__ void operator()(const f32x4 (&acc)[2][2][4][2], const Unit& u, int wr, int wc, int fr_, int fq_) const {
        const int ln_ = lane_id_v(); const int fr = ln_ & 15, fq = ln_ >> 4;
        const int row0 = u.pm * BM + wr * 64 + fr, col0 = u.pn * HALF + wc * 32 + 8 * fq;
#pragma unroll
        for (int ai = 0; ai < 2; ++ai)
#pragma unroll
            for (int m = 0; m < 4; ++m) {
                f32x4 r0, r1;
#pragma unroll
                for (int j = 0; j < 4; ++j) { r0[j] = silu_fast(acc[ai][0][m][0][j]) * acc[ai][1][m][0][j]; r1[j] = silu_fast(acc[ai][0][m][1][j]) * acc[ai][1][m][1][j]; }
                u32x4 w; w.x = cvt_pk_bf16(r0[0], r0[1]); w.y = cvt_pk_bf16(r0[2], r0[3]); w.z = cvt_pk_bf16(r1[0], r1[1]); w.w = cvt_pk_bf16(r1[2], r1[3]);
                *(u32x4*)(ACT + (size_t)(row0 + ai * HALF + m * 16) * ldc + col0) = w;
            }
    }
};
struct EpiRope {
    static constexpr bool PERM = true, AFTER_DRAIN = false;
    unsigned char* ws;
    __device__ __forceinline__ void operator()(const f32x4 (&acc)[2][2][4][2], const Unit& u, int wr, int wc, int fr_, int fq_) const {
        const int ln_ = lane_id_v(); const int fr = ln_ & 15, fq = ln_ >> 4;
        const int row0 = u.pm * BM + wr * 64 + fr;
        {
            bf16_t* QR = (bf16_t*)(ws + WS_QR); const float* CS = (const float*)(ws + WS_CS);
            const int rc0 = u.pn * BM + wc * 32 + 8 * fq;
#pragma unroll
            for (int ai = 0; ai < 2; ++ai)
#pragma unroll
                for (int m = 0; m < 4; ++m) { const int row = row0 + ai * HALF + m * 16; const int pos = row & 2047;
#pragma unroll
                    for (int bj = 0; bj < 2; ++bj) { const int rc = rc0 + bj * HALF; const int i0 = (rc & 63) >> 1;
                        const float* cp = CS + (size_t)(pos * 32 + i0) * 2;
                        u32x4 w;
                        { const f32x4 cc = *(const f32x4*)cp; const f32x4 v0 = acc[ai][bj][m][0];
                          w.x = cvt_pk_bf16(v0[0] * cc[0] - v0[1] * cc[1], v0[1] * cc[0] + v0[0] * cc[1]);
                          w.y = cvt_pk_bf16(v0[2] * cc[2] - v0[3] * cc[3], v0[3] * cc[2] + v0[2] * cc[3]); }
                        asm volatile("" ::: "memory");
                        { const f32x4 cc = *(const f32x4*)(cp + 4); const f32x4 v1 = acc[ai][bj][m][1];
                          w.z = cvt_pk_bf16(v1[0] * cc[0] - v1[1] * cc[1], v1[1] * cc[0] + v1[0] * cc[1]);
                          w.w = cvt_pk_bf16(v1[2] * cc[2] - v1[3] * cc[3], v1[3] * cc[2] + v1[2] * cc[3]); }
                        *(u32x4*)(QR + (size_t)row * 512 + rc) = w;
                        asm volatile("" ::: "memory"); } }
        }
    }
};
template <class Epi, class Sched, bool ALIGN_EPI = false, bool SP2 = false>
__device__ __forceinline__ void gemm_phase(PG8_LAS unsigned char* lds, const Gemm g, const Sched& S, const Epi& E, const int tid_in) {
    int tid_o = tid_in; asm volatile("" : "+v"(tid_o));
    const int tid = tid_o, wid = __builtin_amdgcn_readfirstlane(tid >> 6), lane = tid & 63, wr = wid >> 2, wc = wid & 3, fr = lane & 15, fq = lane >> 4;
    const int K = g.K, nt = K / BK;
    unsigned voffA[2], voffB[2];
#pragma unroll
    for (int i = 0; i < 2; ++i) { int R, C; stage_rc(tid * 16 + i * 8192, R, C); const int Rb = Epi::PERM ? ((R & ~31) + perm32(R & 31)) : R;
        voffA[i] = (unsigned)(R * K + C) * 2u; voffB[i] = (unsigned)(Rb * K + C) * 2u; }
    const size_t kstep = (size_t)(BK * 2);
    const size_t hstep = (size_t)HALF * K * 2;
    const size_t tstep = 2 * hstep;
    const unsigned ldsw = (unsigned)wid * 1024u;
    const int aoff = lds_byte(wr * 64 + fr, fq * 8), boff = lds_byte(wc * 32 + fr, fq * 8);
#define PG8_SA(b, h) (((b) * 2 + (h)) * HTB)
#define PG8_SB(b, h) ((4 + (b) * 2 + (h)) * HTB)
#define PG8_STAGE(bufoff, gbase, voff) do { _Pragma("unroll") for (int _i = 0; _i < 2; ++_i) \
        __builtin_amdgcn_global_load_lds((const unsigned*)((const char*)(gbase) + (voff)[_i]), (PG8_LAS unsigned*)(lds + (bufoff) + ldsw + _i * 8192), 16, 0, 0); } while (0)
#define PG8_LDA(dst, b, h) do { _Pragma("unroll") for (int m = 0; m < 4; ++m) _Pragma("unroll") for (int k = 0; k < 2; ++k) dst[m][k] = *(const PG8_LAS bf16x8*)(lds + PG8_SA(b, h) + aoff + m * 2048 + k * 1024); } while (0)
#define PG8_LDB(dst, b, h) do { _Pragma("unroll") for (int n = 0; n < 2; ++n) _Pragma("unroll") for (int k = 0; k < 2; ++k) dst[n][k] = *(const PG8_LAS bf16x8*)(lds + PG8_SB(b, h) + boff + n * 2048 + k * 1024); } while (0)
#define PG8_MMA(ai, bj, At, Bt) do { __builtin_amdgcn_s_setprio(1); _Pragma("unroll") for (int m = 0; m < 4; ++m) _Pragma("unroll") for (int n = 0; n < 2; ++n) _Pragma("unroll") for (int k = 0; k < 2; ++k) \
        acc[ai][bj][m][n] = __builtin_amdgcn_mfma_f32_16x16x32_bf16(Bt[n][k], At[m][k], acc[ai][bj][m][n], 0, 0, 0); __builtin_amdgcn_s_setprio(0); } while (0)
#define PG8_WAIT_V(n) asm volatile("s_waitcnt vmcnt(" #n ")" ::: "memory")
#define PG8_WAIT_L(n) asm volatile("s_waitcnt lgkmcnt(" #n ")" ::: "memory")
#define PG8_BAR __builtin_amdgcn_s_barrier()
#define PG8_SCHED __builtin_amdgcn_sched_barrier(0)
    Unit cur, nxt; int ui = 0;
    if (!S.next(0, cur)) return;
    f32x4 acc[2][2][4][2];
#pragma unroll
    for (int a = 0; a < 2; ++a)
#pragma unroll
        for (int b = 0; b < 2; ++b)
#pragma unroll
            for (int m = 0; m < 4; ++m)
#pragma unroll
                for (int n = 0; n < 2; ++n) acc[a][b][m][n] = (f32x4){0.f, 0.f, 0.f, 0.f};
    bf16x8 At[4][2], B0[2][2], B1[2][2];
    const char* cA = (const char*)g.A + (size_t)cur.pm * tstep; const char* cB = (const char*)g.Bt + (size_t)cur.pn * tstep;
    S.a_ready(cur);
    if constexpr (SP2) {
        PG8_STAGE(PG8_SB(0, 0), cB, voffB); PG8_STAGE(PG8_SB(0, 1), cB + hstep, voffB); PG8_STAGE(PG8_SA(0, 0), cA, voffA); PG8_STAGE(PG8_SA(0, 1), cA + hstep, voffA);
        if (wr == 1) PG8_BAR;
        PG8_WAIT_V(2); PG8_BAR;
        PG8_STAGE(PG8_SB(1, 0), cB + kstep, voffB); PG8_STAGE(PG8_SA(1, 0), cA + kstep, voffA); PG8_STAGE(PG8_SB(1, 1), cB + hstep + kstep, voffB);
        PG8_WAIT_V(6); PG8_BAR;
    } else {
        PG8_STAGE(PG8_SB(0, 0), cB, voffB); PG8_STAGE(PG8_SA(0, 0), cA, voffA); PG8_STAGE(PG8_SB(0, 1), cB + hstep, voffB); PG8_STAGE(PG8_SA(0, 1), cA + hstep, voffA);
        if (wr == 1) PG8_BAR;
        PG8_WAIT_V(4); PG8_BAR;
        PG8_STAGE(PG8_SB(1, 0), cB + kstep, voffB); PG8_STAGE(PG8_SA(1, 0), cA + kstep, voffA); PG8_STAGE(PG8_SB(1, 1), cB + hstep + kstep, voffB);
        PG8_WAIT_V(6); PG8_BAR;
    }
    for (;;) {
        const bool has_next = S.next(ui + 1, nxt);
        const char* nA = has_next ? (const char*)g.A + (size_t)nxt.pm * tstep : cA; const char* nB = has_next ? (const char*)g.Bt + (size_t)nxt.pn * tstep : cB;
        for (int t = 0; t < nt; t += 2) {
            const bool last = (t == nt - 2);
            const char* a1 = cA + (size_t)(t + 1) * kstep;
            const char* a2 = last ? nA : cA + (size_t)(t + 2) * kstep; const char* b2 = last ? nB : cB + (size_t)(t + 2) * kstep;
            const char* a3 = a2 + kstep; const char* b3 = b2 + kstep;
            if (last && has_next) S.a_ready(nxt);
            if constexpr (SP2) {
            PG8_LDB(B0, 0, 0); PG8_LDB(B1, 0, 1); PG8_SCHED; PG8_LDA(At, 0, 0); PG8_STAGE(PG8_SA(1, 1), a1 + hstep, voffA);
            PG8_WAIT_V(8); PG8_WAIT_L(0); PG8_BAR; PG8_MMA(0, 0, At, B0); PG8_MMA(0, 1, At, B1); PG8_BAR; PG8_SCHED;
            PG8_LDA(At, 0, 1); PG8_STAGE(PG8_SB(0, 0), b2, voffB); PG8_STAGE(PG8_SB(0, 1), b2 + hstep, voffB); PG8_STAGE(PG8_SA(0, 0), a2, voffA);
            PG8_WAIT_V(8); PG8_WAIT_L(0); PG8_BAR; PG8_MMA(1, 0, At, B0); PG8_MMA(1, 1, At, B1); PG8_BAR; PG8_SCHED;
            PG8_LDB(B0, 1, 0); PG8_LDB(B1, 1, 1); PG8_SCHED; PG8_LDA(At, 1, 0); PG8_STAGE(PG8_SA(0, 1), a2 + hstep, voffA);
            PG8_WAIT_V(8); PG8_WAIT_L(0); PG8_BAR; PG8_MMA(0, 0, At, B0); PG8_MMA(0, 1, At, B1); PG8_BAR; PG8_SCHED;
            PG8_LDA(At, 1, 1); PG8_STAGE(PG8_SB(1, 0), b3, voffB); PG8_STAGE(PG8_SB(1, 1), b3 + hstep, voffB); PG8_STAGE(PG8_SA(1, 0), a3, voffA);
            PG8_WAIT_V(8); PG8_WAIT_L(0); PG8_BAR; PG8_MMA(1, 0, At, B0); PG8_MMA(1, 1, At, B1); PG8_BAR; PG8_SCHED;
            } else {
            PG8_LDB(B0, 0, 0); PG8_SCHED; PG8_LDA(At, 0, 0); PG8_STAGE(PG8_SA(1, 1), a1 + hstep, voffA);
            PG8_WAIT_L(8); PG8_BAR; PG8_WAIT_L(0); PG8_MMA(0, 0, At, B0); PG8_BAR; PG8_SCHED;
            PG8_LDB(B1, 0, 1); PG8_STAGE(PG8_SB(0, 0), b2, voffB);
            PG8_BAR; PG8_WAIT_L(0); PG8_MMA(0, 1, At, B1); PG8_BAR;
            PG8_LDA(At, 0, 1); PG8_STAGE(PG8_SA(0, 0), a2, voffA);
            PG8_BAR; PG8_WAIT_L(0); PG8_MMA(1, 0, At, B0); PG8_BAR; PG8_SCHED;
            PG8_STAGE(PG8_SB(0, 1), b2 + hstep, voffB);
            PG8_WAIT_V(6); PG8_BAR; PG8_MMA(1, 1, At, B1); PG8_BAR;
            PG8_LDB(B0, 1, 0); PG8_SCHED; PG8_LDA(At, 1, 0); PG8_STAGE(PG8_SA(0, 1), a2 + hstep, voffA);
            PG8_WAIT_L(8); PG8_BAR; PG8_WAIT_L(0); PG8_MMA(0, 0, At, B0); PG8_BAR; PG8_SCHED;
            PG8_LDB(B1, 1, 1); PG8_STAGE(PG8_SB(1, 0), b3, voffB);
            PG8_BAR; PG8_WAIT_L(0); PG8_MMA(0, 1, At, B1); PG8_BAR;
            PG8_LDA(At, 1, 1); PG8_STAGE(PG8_SA(1, 0), a3, voffA);
            PG8_BAR; PG8_WAIT_L(0); PG8_MMA(1, 0, At, B0); PG8_BAR; PG8_SCHED;
            PG8_STAGE(PG8_SB(1, 1), b3 + hstep, voffB);
            PG8_WAIT_V(6); PG8_BAR; PG8_MMA(1, 1, At, B1); PG8_BAR;
            }
        }
        if constexpr (ALIGN_EPI) { if (wr == 0) PG8_BAR; }
        if constexpr (!Epi::AFTER_DRAIN) { E(acc, cur, wr, wc, fr, fq); S.done(cur); }
        if (!has_next) break;
#pragma unroll
        for (int a = 0; a < 2; ++a)
#pragma unroll
            for (int b = 0; b < 2; ++b)
#pragma unroll
                for (int m = 0; m < 4; ++m)
#pragma unroll
                    for (int n = 0; n < 2; ++n) acc[a][b][m][n] = (f32x4){0.f, 0.f, 0.f, 0.f};
        cur = nxt; cA = nA; cB = nB; ++ui;
        if constexpr (ALIGN_EPI) { if (wr == 1) PG8_BAR; }
    }
    PG8_WAIT_V(0);
    if constexpr (!ALIGN_EPI) { if (wr == 0) PG8_BAR; }
    PG8_BAR;
    if constexpr (Epi::AFTER_DRAIN) { E.fused(acc, cur, wr, wc, fr, fq, lds, wid, lane); S.done(cur); }
#undef PG8_SA
#undef PG8_SB
#undef PG8_STAGE
#undef PG8_LDA
#undef PG8_LDB
#undef PG8_MMA
#undef PG8_WAIT_V
#undef PG8_WAIT_L
#undef PG8_BAR
#undef PG8_SCHED
}
}
#define XB_TMO      128
#define XB_XCNT(j)  (256  + 64 * (j))
#define XB_XSUB(j)  (1280 + 64 * (j))
#define XB_XGEN(j)  (2304 + 64 * (j))
#define XB_TOP      3328
#define XB_TOPGEN   3392
#define XCD_BAR_WORDS 3456
#define XB_SPIN_CAP (1u << 18)

__device__ __forceinline__ unsigned xb_ld(unsigned* p)              { return __hip_atomic_load(p, __ATOMIC_RELAXED, __HIP_MEMORY_SCOPE_AGENT); }
__device__ __forceinline__ unsigned xb_add(unsigned* p, unsigned v) { return __hip_atomic_fetch_add(p, v, __ATOMIC_RELAXED, __HIP_MEMORY_SCOPE_AGENT); }
__device__ __forceinline__ unsigned xb_xcc_id() { return (unsigned)__builtin_amdgcn_s_getreg((3 << 11) | 20) & 0xFu; }
#define XB_SPIN(cond, bar) do { unsigned _sp = 0; while (cond) { __builtin_amdgcn_s_sleep(1); \
    if ((++_sp & 255u) == 0u) { if (xb_ld(&(bar)[XB_TMO])) break; if (_sp > XB_SPIN_CAP) { atomicAdd(&(bar)[XB_TMO], 1u); break; } } } } while (0)

struct XcdBarrier {
    int wave; unsigned* bar; unsigned x;
    volatile LAS unsigned* st;
};

__device__ __forceinline__ bool xb_thread0(int wave) { return wave == 0 && lane_id_v() == 0; }
__device__ __forceinline__ XcdBarrier xcd_barrier_post(unsigned* bar, volatile LAS unsigned* st, int wave) {
    XcdBarrier b; b.wave = wave; b.bar = bar; b.x = xb_xcc_id(); b.st = st;
    if (xb_thread0(wave)) (void)xb_add(&bar[XB_XCNT(b.x)], 1u);
    return b;
}
__device__ __forceinline__ void xcd_barrier_complete(unsigned* bar, unsigned x, unsigned& nloc, unsigned& nx) {
    const unsigned G = gridDim.x * gridDim.y * gridDim.z;
    unsigned sum, cnt, mine, sp = 0u;
    for (;;) {
        sum = 0u; cnt = 0u; mine = 0u;
#pragma unroll
        for (unsigned j = 0; j < 16; ++j) { const unsigned c = xb_ld(&bar[XB_XCNT(j)]); sum += c; cnt += (c > 0u) ? 1u : 0u; mine = (j == x) ? c : mine; }
        if (sum == G) break;
        __builtin_amdgcn_s_sleep(1);
        if ((++sp & 255u) == 0u) { if (xb_ld(&bar[XB_TMO])) break; if (sp > XB_SPIN_CAP) { atomicAdd(&bar[XB_TMO], 1u); break; } }
    }
    nloc = mine > 0u ? mine : 1u; nx = cnt > 0u ? cnt : 1u;
}

__device__ __forceinline__ void xcd_barrier(const XcdBarrier& b) {
    asm volatile("s_waitcnt vmcnt(0)" ::: "memory");
    __syncthreads();
    if (xb_thread0(b.wave)) {
        unsigned* bar = b.bar; asm volatile("" : "+s"(bar));
        __builtin_amdgcn_s_waitcnt(0);
        unsigned nloc = b.st[0], nx = b.st[1];
        if (nloc == 0u) { unsigned xo = b.x; asm volatile("" : "+s"(xo)); xcd_barrier_complete(bar, xo, nloc, nx); b.st[0] = nloc; b.st[1] = nx; }
        const unsigned old = xb_add(&bar[XB_XSUB(b.x)], 1u);
        const unsigned gen = old / nloc;
        if (old + 1u == (gen + 1u) * nloc) {
            __builtin_amdgcn_fence(__ATOMIC_RELEASE, "agent");
            asm volatile("s_waitcnt vmcnt(0)" ::: "memory");
            const unsigned og = xb_add(&bar[XB_TOP], 1u);
            const unsigned tg = og / nx;
            if (og + 1u == (tg + 1u) * nx) xb_add(&bar[XB_TOPGEN], 1u);
            else XB_SPIN(xb_ld(&bar[XB_TOPGEN]) == tg, bar);
            __builtin_amdgcn_fence(__ATOMIC_ACQUIRE, "agent");
            xb_add(&bar[XB_XGEN(b.x)], 1u);
            asm volatile("s_waitcnt vmcnt(0)" ::: "memory");
        } else {
            XB_SPIN(xb_ld(&bar[XB_XGEN(b.x)]) == gen, bar);
            __builtin_amdgcn_fence(__ATOMIC_ACQUIRE, "agent");
            asm volatile("s_waitcnt vmcnt(0)" ::: "memory");
        }
    }
    __syncthreads();
}
template <int NT> __device__ __forceinline__ void sg_tile(const bf16* A, int r0, const bf16* Bt, const int (&nrow)[NT], int K, int lane, f32x4 (&acc)[NT]) {
    const bf16* ap = A + (size_t)(r0 + (lane & 15)) * K + 8 * (lane >> 4);
    const bf16* bp[NT];
#pragma unroll
    for (int t = 0; t < NT; ++t) bp[t] = Bt + (size_t)(nrow[t] + (lane & 15)) * K + 8 * (lane >> 4);
#pragma unroll 4
    for (int k = 0; k < K; k += 32) {
        const bf16x8 av = *(const bf16x8*)(ap + k);
#pragma unroll
        for (int t = 0; t < NT; ++t) { const bf16x8 bv = *(const bf16x8*)(bp[t] + k); acc[t] = __builtin_amdgcn_mfma_f32_16x16x32_bf16(av, bv, acc[t], 0, 0, 0); }
    }
}
__device__ __forceinline__ void sg_hgrn_in(const bf16* HN, const bf16* Wt, bf16* QB, float* GB, bf16* VB, bf16* GATE, const float* lbt, int gw, int NGW, int lane) {
    const bf16* A = HN + (size_t)MP * 1024;
    for (int tile = gw; tile < 8 * 256; tile += NGW) {
        const int mt = tile & 7, nt = tile >> 3; const int nrow[1] = {nt * 16}; f32x4 acc[1] = {{0.f, 0.f, 0.f, 0.f}};
        sg_tile<1>(A, mt * 16, Wt, nrow, 1024, lane, acc);
        const int col = nt * 16 + (lane & 15), type = col >> 10, c = col & 1023;
        const float llb = lbt[2 * c], l1p = lbt[2 * c + 1];
#pragma unroll
        for (int reg = 0; reg < 4; ++reg) {
            const size_t o = (size_t)(MP + mt * 16 + 4 * (lane >> 4) + reg) * 1024 + c; const float x = acc[0][reg];
            if (type == 0) QB[o] = (bf16)f2bf(pg8::silu_fast(x) * 0.08838834764831845f);
            else if (type == 1) GB[o] = pg8::logf_gate(x, llb, l1p);
            else if (type == 2) VB[o] = (bf16)f2bf(x);
            else GATE[o] = (bf16)f2bf(pg8::silu_fast(x));
        }
    }
}
__device__ __forceinline__ void sg_f32(const bf16* Abuf, int K, const bf16* Wt, int N, float* C, int ldc, int gw, int NGW, int lane) {
    const bf16* A = Abuf + (size_t)MP * K;
    for (int tile = gw; tile < 8 * (N / 16); tile += NGW) {
        const int mt = tile & 7, nt = tile >> 3; const int nrow[1] = {nt * 16}; f32x4 acc[1] = {{0.f, 0.f, 0.f, 0.f}};
        sg_tile<1>(A, mt * 16, Wt, nrow, K, lane, acc);
#pragma unroll
        for (int reg = 0; reg < 4; ++reg) C[(size_t)(MP + mt * 16 + 4 * (lane >> 4) + reg) * ldc + nt * 16 + (lane & 15)] = acc[0][reg];
    }
}
__device__ __forceinline__ void sg_swiglu(const bf16* HN, const bf16* Wt, bf16* ACT, int gw, int NGW, int lane) {
    const bf16* A = HN + (size_t)MP * 1024;
    for (int tile = gw; tile < 8 * (DFF / 16); tile += NGW) {
        const int mt = tile & 7, nt = tile >> 3, j0 = nt * 16; const int ng = 256 * (j0 >> 7) + (j0 & 127); const int nrow[2] = {ng, ng + 128};
        f32x4 acc[2] = {{0.f, 0.f, 0.f, 0.f}, {0.f, 0.f, 0.f, 0.f}};
        sg_tile<2>(A, mt * 16, Wt, nrow, 1024, lane, acc);
#pragma unroll
        for (int reg = 0; reg < 4; ++reg) ACT[(size_t)(MP + mt * 16 + 4 * (lane >> 4) + reg) * DFF + j0 + (lane & 15)] = (bf16)f2bf(pg8::silu_fast(acc[0][reg]) * acc[1][reg]);
    }
}
__device__ __forceinline__ void sg_uq(const bf16* QAN, const bf16* Wt, bf16* QN, bf16* QR, const float* CS, int gw, int NGW, int lane) {
    const bf16* A = QAN + (size_t)MP * QL;
    for (int tile = gw; tile < 8 * (1536 / 16); tile += NGW) {
        const int mt = tile & 7, nt = tile >> 3; const int nrow[1] = {nt * 16}; f32x4 acc[1] = {{0.f, 0.f, 0.f, 0.f}};
        sg_tile<1>(A, mt * 16, Wt, nrow, QL, lane, acc);
        const int col = nt * 16 + (lane & 15);
#pragma unroll
        for (int reg = 0; reg < 4; ++reg) {
            const int row = MP + mt * 16 + 4 * (lane >> 4) + reg; const float x = acc[0][reg]; const float partner = shx(x, 1, lane);
            if (col < 1024) QN[(size_t)row * 1024 + col] = (bf16)f2bf(x);
            else { const int rc = col - 1024, h = rc >> 6, ii = rc & 63, i = ii >> 1; const float cs = CS[(size_t)(2048 * 32 + i) * 2], sn = CS[(size_t)(2048 * 32 + i) * 2 + 1];
                float o; int ref;
                if ((ii & 1) == 0) { o = x * cs - partner * sn; ref = i; } else { o = x * cs + partner * sn; ref = 32 + i; }
                QR[(size_t)row * 512 + h * 64 + ref] = (bf16)f2bf(o); }
        }
    }
}

__device__ __forceinline__ int maprow(int kind, int j) {
    if (kind == 1) { if (j < DFF) return 256 * (j >> 7) + (j & 127); const int jj = j - DFF; return 256 * (jj >> 7) + 128 + (jj & 127); }
    if (kind == 2) return 384 + j;
    if (kind == 3) { const int h = j / 192, n = j - h * 192; if (n < 128) return h * 128 + n; const int i = n - 128; return 1024 + h * 64 + (i < 32 ? 2 * i : 2 * (i - 32) + 1); }
    if (kind == 4) { const int h = j >> 8, n = j & 255; return n < 128 ? h * 128 + n : 1024 + h * 128 + (n - 128); }
    return j;
}
__device__ __forceinline__ void cvt_item(const float* W, int K, int N, bf16* WT, int kind, const float* gain, float scale, LAS float* scr, int item, int lane) {
    const int nblk = N / 32, kb = item / nblk, nb = item - kb * nblk, k0 = 64 * kb, n0 = 32 * nb;
#pragma unroll 8
    for (int i = 0; i < 32; ++i) { const int kk = 2 * i + (lane >> 5); const float g = gain ? gain[k0 + kk] * scale : scale;
        scr[kk * 33 + (lane & 31)] = W[(size_t)(k0 + kk) * N + n0 + (lane & 31)] * g; }
    LDS_WAIT(); asm volatile("" ::: "memory");
    const int c = lane & 7;
#pragma unroll
    for (int j = 0; j < 4; ++j) { const int n = (lane >> 3) + 8 * j; const LAS float* s = scr + (8 * c) * 33 + n;
        v4u o; o.x = pk2(s[0 * 33], s[1 * 33]); o.y = pk2(s[2 * 33], s[3 * 33]); o.z = pk2(s[4 * 33], s[5 * 33]); o.w = pk2(s[6 * 33], s[7 * 33]);
        *(v4u*)(WT + (size_t)maprow(kind, n0 + n) * K + k0 + 8 * c) = o; }
    LDS_WAIT(); asm volatile("" ::: "memory");
}
__device__ __forceinline__ void row_resid_norm(const float* mix, float* X, const float* gain, bf16* HN, int lane) {
    const f32x4* mr = (const f32x4*)mix + lane; f32x4* xr = (f32x4*)X + lane; const f32x4* gr = (const f32x4*)gain + lane;
    f32x4 v[4]; float s = 0.f;
#pragma unroll
    for (int j = 0; j < 4; ++j) { v[j] = mr[64 * j]; s += (v[j][0] * v[j][0] + v[j][1] * v[j][1]) + (v[j][2] * v[j][2] + v[j][3] * v[j][3]); }
    const float r = rsqrtf(wave_sum(s) * (1.f / 1024.f) + EPS); float s2 = 0.f;
#pragma unroll
    for (int j = 0; j < 4; ++j) { const f32x4 x = xr[64 * j] + v[j] * r * gr[64 * j]; xr[64 * j] = x; v[j] = x; s2 += (x[0] * x[0] + x[1] * x[1]) + (x[2] * x[2] + x[3] * x[3]); }
    const float r2 = rsqrtf(wave_sum(s2) * (1.f / 1024.f) + EPS);
    v2u* o8 = (v2u*)HN + lane;
#pragma unroll
    for (int j = 0; j < 4; ++j) { v2u w; w.x = pk2(v[j][0] * r2, v[j][1] * r2); w.y = pk2(v[j][2] * r2, v[j][3] * r2); o8[64 * j] = w; }
}
__device__ __forceinline__ void hgrn_naive_phase(const bf16* QB, const float* GB, const bf16* VB, const bf16* GATE, const float* gnorm, const float* s0, float* st_p, float* st_s, bf16* OG,
                                                 LAS unsigned char* lds, int wg, int G, int tid) {
    LAS float* sq = (LAS float*)lds; LAS float* sf = sq + 128; LAS float* sk = sf + 128; LAS float* red = sk + 128;
    const int dv = tid & 127; const bool active = tid < 128;
    for (int unit = wg; unit < 64 + DB * HA; unit += G) {
        const bool prompt = unit < 64; const int uu = prompt ? unit : unit - 64; const int seq = uu >> 3, h = uu & 7;
        const int T = prompt ? SEQ : 1; const int row0 = prompt ? seq * SEQ : MP + seq;
        const size_t sb = ((size_t)seq * HA + h) * DK * DV;
        float S[128];
#pragma unroll
        for (int k = 0; k < 128; ++k) S[k] = (!prompt && active) ? s0[sb + (size_t)k * DV + dv] : 0.f;
        for (int t = 0; t < T; ++t) {
            const size_t o = (size_t)(row0 + t) * 1024 + h * 128 + dv;
            __syncthreads();
            float v = 0.f;
            if (active) { sq[dv] = bf2f(QB[o]); const float lf = GB[o]; sf[dv] = expf(lf); sk[dv] = -expm1f(lf); v = bf2f(VB[o]); }
            __syncthreads();
            float ov = 0.f;
            if (active) {
#pragma unroll
                for (int k = 0; k < 128; ++k) { S[k] = sf[k] * S[k] + sk[k] * v; ov += sq[k] * S[k]; }
            }
            const float ss = wave_sum(ov * ov);
            if (active && (tid & 63) == 0) red[tid >> 6] = ss;
            __syncthreads();
            if (active) { const float r = rsqrtf((red[0] + red[1]) * (1.f / 128.f) + EPS); OG[o] = (bf16)f2bf(ov * r * gnorm[h * 128 + dv] * bf2f(GATE[o])); }
        }
        if (active) { float* so = (prompt ? st_p : st_s) + sb;
#pragma unroll
            for (int k = 0; k < 128; ++k) so[(size_t)k * DV + dv] = S[k]; }
    }
}
__device__ __forceinline__ void attn_naive_phase(const bf16* QN, const bf16* QR, const bf16* KN, const bf16* KRB, const bf16* VV, bf16* O, LAS unsigned char* lds, int wg, int G, int tid) {
    LAS float* sc = (LAS float*)lds;
    LAS float* red = sc + SEQ;
    LAS float* part = red + 16;
    const int g16 = tid >> 4, l16 = tid & 15, wave = tid >> 6;
    for (int unit = wg; unit < BATCH * 8 * SEQ; unit += G) {
        const int t = unit & (SEQ - 1), h = (unit >> 11) & 7, b = unit >> 14; const size_t row = (size_t)b * SEQ + t;
        const v4u qa = *(const v4u*)(QN + row * 1024 + h * 128 + 8 * l16); const v2u qb = *(const v2u*)(QR + row * 512 + h * 64 + 4 * l16);
        float qf[12];
        qf[0] = bf2f(qa.x & 0xffff); qf[1] = bf2f(qa.x >> 16); qf[2] = bf2f(qa.y & 0xffff); qf[3] = bf2f(qa.y >> 16); qf[4] = bf2f(qa.z & 0xffff); qf[5] = bf2f(qa.z >> 16); qf[6] = bf2f(qa.w & 0xffff); qf[7] = bf2f(qa.w >> 16);
        qf[8] = bf2f(qb.x & 0xffff); qf[9] = bf2f(qb.x >> 16); qf[10] = bf2f(qb.y & 0xffff); qf[11] = bf2f(qb.y >> 16);
        __syncthreads();
        float mx = -1e30f;
        for (int s = g16; s <= t; s += 32) {
            const size_t kr = (size_t)b * SEQ + s;
            const v4u ka = *(const v4u*)(KN + kr * 1024 + h * 128 + 8 * l16); const v2u kb = *(const v2u*)(KRB + kr * 64 + 4 * l16);
            float d = qf[0] * bf2f(ka.x & 0xffff) + qf[1] * bf2f(ka.x >> 16) + qf[2] * bf2f(ka.y & 0xffff) + qf[3] * bf2f(ka.y >> 16) + qf[4] * bf2f(ka.z & 0xffff) + qf[5] * bf2f(ka.z >> 16) + qf[6] * bf2f(ka.w & 0xffff) + qf[7] * bf2f(ka.w >> 16)
                    + qf[8] * bf2f(kb.x & 0xffff) + qf[9] * bf2f(kb.x >> 16) + qf[10] * bf2f(kb.y & 0xffff) + qf[11] * bf2f(kb.y >> 16);
            { const int ln = tid & 63; d += shx(d, 1, ln); d += shx(d, 2, ln); d += shx(d, 4, ln); d += shx(d, 8, ln); }
            if (l16 == 0) sc[s] = d;
            mx = fmaxf(mx, d);
        }
        mx = wave_max(mx);
        if ((tid & 63) == 0) red[wave] = mx;
        __syncthreads();
        mx = fmaxf(fmaxf(fmaxf(red[0], red[1]), fmaxf(red[2], red[3])), fmaxf(fmaxf(red[4], red[5]), fmaxf(red[6], red[7])));
        float sum = 0.f;
        for (int s = tid; s <= t; s += NTHR) { const float p = exp2f(sc[s] - mx); sc[s] = p; sum += p; }
        sum = wave_sum(sum);
        if ((tid & 63) == 0) red[8 + wave] = sum;
        __syncthreads();
        sum = ((red[8] + red[9]) + (red[10] + red[11])) + ((red[12] + red[13]) + (red[14] + red[15]));
        const int d = tid & 127, pt = tid >> 7;
        float o = 0.f;
        for (int s = pt; s <= t; s += 4) o += sc[s] * bf2f(VV[((size_t)b * SEQ + s) * 1024 + h * 128 + d]);
        part[pt * 128 + d] = o;
        __syncthreads();
        if (pt == 0) O[row * 1024 + h * 128 + d] = (bf16)f2bf(((part[d] + part[128 + d]) + (part[256 + d] + part[384 + d])) / sum);
    }
}
__device__ __forceinline__ void decode_naive_phase(const bf16* QN, const bf16* QR, const bf16* WUKVN, const bf16* WUKV, const float* cache_c, const float* cache_kr, const int* page_table,
                                                   const float* c_s, const float* kr_s, float* SC, bf16* O, LAS unsigned char* lds, int wg, int G, int tid) {
    LAS float* ql = (LAS float*)lds;
    LAS float* qr = ql + 8 * 256;
    LAS float* red = qr + 8 * 64;
    LAS float* smx = red + 64;
    LAS float* ssum = smx + 8;
    LAS float* part = ssum + 8;
    const int lane = tid & 63, wave = tid >> 6;
    for (int b = wg; b < DB; b += G) {
        const size_t row = (size_t)MP + b;
        __syncthreads();
        { const int c = tid & 255, hh = tid >> 8;
            for (int h = hh * 4; h < hh * 4 + 4; ++h) { float a = 0.f;
                for (int n = 0; n < 128; ++n) a += bf2f(QN[row * 1024 + h * 128 + n]) * bf2f(WUKVN[(size_t)c * 2048 + h * 256 + n]);
                ql[h * 256 + c] = a; } }
        qr[tid] = bf2f(QR[row * 512 + tid]);
        __syncthreads();
        float* sc = SC + (size_t)b * 8 * SCP;
        float mx[8];
#pragma unroll
        for (int h = 0; h < 8; ++h) mx[h] = -1e30f;
        for (int s = wave; s <= PAST; s += NWAVES) {
            const float* cp; const float* kp;
            if (s < PAST) { const int pg = page_table[b * NPAGES + (s >> 7)]; cp = cache_c + ((size_t)pg * PAGE + (s & 127)) * 256; kp = cache_kr + ((size_t)pg * PAGE + (s & 127)) * 64; }
            else { cp = c_s + (size_t)b * 256; kp = kr_s + (size_t)b * 64; }
            const f32x4 cv = *(const f32x4*)(cp + 4 * lane); const float kv = kp[lane];
#pragma unroll
            for (int h = 0; h < 8; ++h) {
                const f32x4 q4 = *(const LAS f32x4*)(ql + h * 256 + 4 * lane);
                float d = (q4[0] * cv[0] + q4[1] * cv[1]) + (q4[2] * cv[2] + q4[3] * cv[3]) + qr[h * 64 + lane] * kv;
                d = wave_sum(d);
                if (lane == 0) sc[(size_t)h * SCP + s] = d;
                mx[h] = fmaxf(mx[h], d);
            }
        }
#pragma unroll
        for (int h = 0; h < 8; ++h) if (lane == 0) red[h * 8 + wave] = mx[h];
        asm volatile("s_waitcnt vmcnt(0)" ::: "memory");
        __syncthreads();
        if (tid < 8) { float m = red[tid * 8]; for (int w = 1; w < 8; ++w) m = fmaxf(m, red[tid * 8 + w]); smx[tid] = m; }
        __syncthreads();
#pragma unroll
        for (int h = 0; h < 8; ++h) {
            float sum = 0.f; const float m = smx[h];
            for (int s = tid; s <= PAST; s += NTHR) { const float p = exp2f(sc[(size_t)h * SCP + s] - m); sc[(size_t)h * SCP + s] = p; sum += p; }
            sum = wave_sum(sum);
            if (lane == 0) red[h * 8 + wave] = sum;
        }
        asm volatile("s_waitcnt vmcnt(0)" ::: "memory");
        __syncthreads();
        if (tid < 8) { float m = 0.f; for (int w = 0; w < 8; ++w) m += red[tid * 8 + w]; ssum[tid] = m; }
        __syncthreads();
        { const int c = tid & 255, pt = tid >> 8;
            float a[8];
#pragma unroll
            for (int h = 0; h < 8; ++h) a[h] = 0.f;
            for (int s = pt; s <= PAST; s += 2) {
                float cv;
                if (s < PAST) { const int pg = page_table[b * NPAGES + (s >> 7)]; cv = cache_c[((size_t)pg * PAGE + (s & 127)) * 256 + c]; }
                else cv = c_s[(size_t)b * 256 + c];
#pragma unroll
                for (int h = 0; h < 8; ++h) a[h] += sc[(size_t)h * SCP + s] * cv;
            }
#pragma unroll
            for (int h = 0; h < 8; ++h) part[(pt * 8 + h) * 256 + c] = a[h];
        }
        __syncthreads();
        for (int i = tid; i < 8 * 256; i += NTHR) { const int h = i >> 8; ql[i] = (part[i] + part[8 * 256 + i]) / ssum[h]; }
        __syncthreads();
        for (int idx = tid; idx < 1024; idx += NTHR) {
            const int h = idx >> 7; const bf16* w = WUKV + (size_t)(1024 + idx) * 256; float a = 0.f;
            for (int c = 0; c < 256; ++c) a += ql[h * 256 + c] * bf2f(w[c]);
            O[row * 1024 + idx] = (bf16)f2bf(a);
        }
    }
}
constexpr int NPH = 1 + 4 * 10;
__host__ __device__ constexpr bool phase_exists(int k) {
    if (k == 0) return true;
    const int l = (k - 1) / 10, s = (k - 1) % 10;
    if (l < 2) return !(s == 2 || s == 3 || s == 4);
    return s != 3 || l == 2;
}
struct Args { const float* in[21]; float* out; unsigned char* ws; int ph_lo, ph_hi, li, pad; };


__device__ __forceinline__ unsigned long long karg64(int byte_off) {
    unsigned long long v;
    asm volatile("s_load_dwordx2 %0, %1, %2\n\ts_waitcnt lgkmcnt(0)" : "=s"(v) : "s"(__builtin_amdgcn_kernarg_segment_ptr()), "i"(byte_off) : "memory");
    return v;
}
__device__ __forceinline__ int karg32(int byte_off) {
    int v;
    asm volatile("s_load_dword %0, %1, %2\n\ts_waitcnt lgkmcnt(0)" : "=s"(v) : "s"(__builtin_amdgcn_kernarg_segment_ptr()), "i"(byte_off) : "memory");
    return v;
}
#define ARG_IN(i) ((const float*)karg64(8 * (i)))
#define ARG_OUT() ((float*)karg64(8 * 21))
#define ARG_WS() ((unsigned char*)karg64(8 * 22))
struct Ctx { LAS unsigned char* lds; int tid, lane, wave, wg, G, gw, NGW; };
__device__ __forceinline__ Ctx fresh(const Ctx& c0) {
    Ctx c; c.lds = c0.lds; int wv = c0.wave; asm volatile("" : "+s"(wv)); int t = wv * 64 + lane_id_v(); int w = blockIdx.x; asm volatile("" : "+s"(w)); int g = gridDim.x; asm volatile("" : "+s"(g));
    c.tid = t; c.lane = t & 63; c.wave = __builtin_amdgcn_readfirstlane(t >> 6); c.wg = w; c.G = g; c.gw = w * NWAVES + c.wave; c.NGW = g * NWAVES; return c;
}

__device__ __forceinline__ void ph_prologue(const Ctx& c0) {
    const Ctx c = fresh(c0);
    unsigned char* ws = ARG_WS();
    const float* norm_gains = ARG_IN(6);
    LAS float* scr = (LAS float*)(c.lds + c.wave * 16384);
    constexpr int NITEMS = 4096 + 1024 + 11264 + 5632 + 192 + 160 + 192 + 576 + 256 + 1024;
    for (int it = c.gw; it < NITEMS; it += c.NGW) {
        int r = it, l; const float* W; int K, N, kind = 0; bf16* WT; const float* gain = nullptr; float scale = 1.f;
        if (r < 4096) { l = r / 2048; r -= l * 2048; W = ARG_IN(9) + (size_t)l * 1024 * 4096; K = 1024; N = 4096; WT = (bf16*)(ws + WS_WIN) + (size_t)l * 4096 * 1024; gain = norm_gains + (l * 4 + 0) * 1024; }
        else if ((r -= 4096) < 1024) { l = r / 512; r -= l * 512; W = ARG_IN(12) + (size_t)l * 1024 * 1024; K = 1024; N = 1024; WT = (bf16*)(ws + WS_WOUTA) + (size_t)l * 1024 * 1024; }
        else if ((r -= 1024) < 11264) { l = r / 2816; r -= l * 2816; W = ARG_IN(7) + (size_t)l * 1024 * 5632; K = 1024; N = 5632; WT = (bf16*)(ws + WS_WFIN) + (size_t)l * 5632 * 1024; kind = 1; gain = norm_gains + (l * 4 + 2) * 1024; }
        else if ((r -= 11264) < 5632) { l = r / 1408; r -= l * 1408; W = ARG_IN(8) + (size_t)l * 2816 * 1024; K = 2816; N = 1024; WT = (bf16*)(ws + WS_WFOUT) + (size_t)l * 1024 * 2816; }
        else if ((r -= 5632) < 192) { W = ARG_IN(17); K = 1024; N = 384; WT = (bf16*)(ws + WS_WDQ0); gain = norm_gains + (2 * 4 + 0) * 1024; }
        else if ((r -= 192) < 160) { W = ARG_IN(14); K = 1024; N = 320; WT = (bf16*)(ws + WS_WDQ0); kind = 2; gain = ARG_IN(13); }
        else if ((r -= 160) < 192) { W = ARG_IN(17) + (size_t)1024 * 384; K = 1024; N = 384; WT = (bf16*)(ws + WS_WDQ1); gain = norm_gains + (3 * 4 + 0) * 1024; }
        else if ((r -= 192) < 576) { l = r / 288; r -= l * 288; W = ARG_IN(19) + (size_t)l * 384 * 1536; K = 384; N = 1536; WT = (bf16*)(ws + WS_WUQ) + (size_t)l * 1536 * 384; kind = 3; gain = ARG_IN(18) + l * 384; scale = QSCALE; }
        else if ((r -= 576) < 256) { W = ARG_IN(16); K = 256; N = 2048; WT = (bf16*)(ws + WS_WUKV); kind = 4; }
        else { r -= 256; l = r / 512; r -= l * 512; W = ARG_IN(20) + (size_t)l * 1024 * 1024; K = 1024; N = 1024; WT = (bf16*)(ws + WS_WOUTB) + (size_t)l * 1024 * 1024; }
        cvt_item(W, K, N, WT, kind, gain, scale, scr, r, c.lane);
    }
    const size_t gt = (size_t)c.wg * NTHR + c.tid, NT = (size_t)c.G * NTHR;
    { bf16* WDQ0 = (bf16*)(ws + WS_WDQ0); bf16* WDQ1 = (bf16*)(ws + WS_WDQ1);
      for (size_t i = gt; i < (size_t)64 * 1024 / 8; i += NT) ((v4u*)(WDQ0 + (size_t)704 * 1024))[i] = (v4u){0u, 0u, 0u, 0u};
      for (size_t i = gt; i < (size_t)128 * 1024 / 8; i += NT) ((v4u*)(WDQ1 + (size_t)384 * 1024))[i] = (v4u){0u, 0u, 0u, 0u}; }
    { const float* w_ukv = ARG_IN(16); bf16* WUKVN = (bf16*)(ws + WS_WUKVN);
      for (size_t i = gt; i < (size_t)256 * 2048 / 4; i += NT) { const f32x4 v = ((const f32x4*)w_ukv)[i]; v2u w; w.x = pk2(v[0], v[1]); w.y = pk2(v[2], v[3]); ((v2u*)WUKVN)[i] = w; } }
    { float* CS = (float*)(ws + WS_CS);
      for (size_t i = gt; i < (size_t)2049 * 32; i += NT) { const int p = (int)(i >> 5), fi = (int)(i & 31); const double pos = p < 2048 ? (double)p : (double)PAST;
        const double ang = pos * pow(10000.0, -(double)fi / 32.0); CS[2 * i] = (float)cos(ang); CS[2 * i + 1] = (float)sin(ang); } }
    { float* LBT = (float*)(ws + WS_LBT); const float* lb_logits = ARG_IN(10);
      for (size_t i = gt; i < 2048; i += NT) { const int l = (int)(i >> 10), d = (int)(i & 1023); float lb = 0.f;
        if (l == 1) lb = 1.f / (1.f + expf(lb_logits[d] - lb_logits[1024 + d]));
        LBT[2 * i] = logf(fmaxf(lb, 1e-30f)); LBT[2 * i + 1] = log1pf(-lb); } }
    { const float* x_prompt = ARG_IN(0); const float* x_sample = ARG_IN(1); float* X = ARG_OUT(); bf16* HN = (bf16*)(ws + WS_HN);
      for (int m = c.gw; m < M; m += c.NGW) {
        const f32x4* xr = (const f32x4*)(m < MP ? x_prompt + (size_t)m * D : x_sample + (size_t)(m - MP) * D) + c.lane; f32x4* xo = (f32x4*)(X + (size_t)m * D) + c.lane;
        f32x4 v[4]; float s = 0.f;
#pragma unroll
        for (int j = 0; j < 4; ++j) { v[j] = xr[64 * j]; xo[64 * j] = v[j]; s += (v[j][0] * v[j][0] + v[j][1] * v[j][1]) + (v[j][2] * v[j][2] + v[j][3] * v[j][3]); }
        const float r = rsqrtf(wave_sum(s) * (1.f / 1024.f) + EPS);
        v2u* o8 = (v2u*)(HN + (size_t)m * D) + c.lane;
#pragma unroll
        for (int j = 0; j < 4; ++j) { v2u w; w.x = pk2(v[j][0] * r, v[j][1] * r); w.y = pk2(v[j][2] * r, v[j][3] * r); o8[64 * j] = w; }
      } }
}
__device__ __forceinline__ void ph_hgrn_in(const Ctx& c0, int l) {
    const Ctx c = fresh(c0);
    unsigned char* ws = ARG_WS();
    const bf16* HN = (const bf16*)(ws + WS_HN); const bf16* Wt = (const bf16*)(ws + WS_WIN) + (size_t)l * 4096 * 1024; const float* lbt = (const float*)(ws + WS_LBT) + (size_t)l * 2048;
    bf16* QB = (bf16*)(ws + WS_QB); float* GB = (float*)(ws + WS_GB); bf16* VB = (bf16*)(ws + WS_VB); bf16* GATE = (bf16*)(ws + WS_GATE);
    pg8::Gemm g{HN, Wt, MP, 4096, 1024}; pg8::StaticOrder S; S.init(MP, 4096, c.G, c.wg);
    pg8::EpiHgrnIn E{ws, l};
    pg8::gemm_phase<pg8::EpiHgrnIn, pg8::StaticOrder, true, true>(c.lds, g, S, E, c.tid);
    const Ctx c2 = fresh(c0);
    sg_hgrn_in(HN, Wt, QB, GB, VB, GATE, lbt, c2.gw, c2.NGW, c2.lane);
}
__device__ __forceinline__ void ph_hgrn_rec(const Ctx& c0, int l) {
    const Ctx c = fresh(c0);
    unsigned char* ws = ARG_WS(); float* X = ARG_OUT();
    float* st_p = X + (size_t)M * D; float* st_s = st_p + (size_t)2 * BATCH * HA * DK * DV + (size_t)MP * KVL + (size_t)MP * 64;
    hgrn_naive_phase((const bf16*)(ws + WS_QB), (const float*)(ws + WS_GB), (const bf16*)(ws + WS_VB), (const bf16*)(ws + WS_GATE), ARG_IN(11) + (size_t)l * D, ARG_IN(2) + (size_t)l * DB * HA * DK * DV,
                     st_p + (size_t)l * BATCH * HA * DK * DV, st_s + (size_t)l * DB * HA * DK * DV, (bf16*)(ws + WS_OG), c.lds, c.wg, c.G, c.tid);
}
__device__ __forceinline__ void ph_dq(const Ctx& c0, int j) {
    const Ctx c = fresh(c0);
    unsigned char* ws = ARG_WS();
    const int N = (j == 0) ? 768 : 512; const bf16* Wt = (const bf16*)(ws + ((j == 0) ? WS_WDQ0 : WS_WDQ1)); const bf16* HN = (const bf16*)(ws + WS_HN); float* QC = (float*)(ws + WS_QC);
    pg8::Gemm g{HN, Wt, MP, N, 1024}; pg8::StaticOrder S; S.init(MP, N, c.G, c.wg);
    pg8::EpiF32 E{QC, QCP};
    pg8::gemm_phase<pg8::EpiF32, pg8::StaticOrder, true, true>(c.lds, g, S, E, c.tid);
    const Ctx c2 = fresh(c0);
    sg_f32(HN, 1024, Wt, N, QC, QCP, c2.gw, c2.NGW, c2.lane);
}
__device__ __forceinline__ void ph_qnorm(const Ctx& c0, int j) {
    const Ctx c = fresh(c0);
    unsigned char* ws = ARG_WS(); float* X = ARG_OUT();
    float* c_p = X + (size_t)M * D + (size_t)2 * BATCH * HA * DK * DV; float* kr_p = c_p + (size_t)MP * KVL; float* c_s = kr_p + (size_t)MP * 64 + (size_t)2 * DB * HA * DK * DV; float* kr_s = c_s + (size_t)DB * KVL;
    const float* QC = (const float*)(ws + WS_QC); bf16* QAN = (bf16*)(ws + WS_QAN); bf16* CB = (bf16*)(ws + WS_CB); bf16* KRB = (bf16*)(ws + WS_KRB); const float* CS = (const float*)(ws + WS_CS);
    const float* kv_a_norm = ARG_IN(15); const int lane = c.lane;
    for (int m = c.gw; m < M; m += c.NGW) {
        const float* qc = QC + (size_t)m * QCP;
        float v[6]; float s = 0.f;
#pragma unroll
        for (int i = 0; i < 6; ++i) { v[i] = qc[lane + 64 * i]; s += v[i] * v[i]; }
        const float r = rsqrtf(wave_sum(s) * (1.f / 384.f) + EPS);
#pragma unroll
        for (int i = 0; i < 6; ++i) QAN[(size_t)m * QL + lane + 64 * i] = (bf16)f2bf(v[i] * r);
        if (j == 0) {
            float cc[4]; float s2 = 0.f;
#pragma unroll
            for (int i = 0; i < 4; ++i) { cc[i] = qc[384 + lane + 64 * i]; s2 += cc[i] * cc[i]; }
            const float r2 = rsqrtf(wave_sum(s2) * (1.f / 256.f) + EPS);
            float* co = m < MP ? c_p + (size_t)m * KVL : c_s + (size_t)(m - MP) * KVL;
#pragma unroll
            for (int i = 0; i < 4; ++i) { const float o = cc[i] * r2 * kv_a_norm[lane + 64 * i]; co[lane + 64 * i] = o; CB[(size_t)m * KVL + lane + 64 * i] = (bf16)f2bf(o); }
            if (lane < 32) {
                const float x1 = qc[640 + lane], x2 = qc[672 + lane]; const int p = m < MP ? (m & (SEQ - 1)) : 2048;
                const float cs = CS[(size_t)(p * 32 + lane) * 2], sn = CS[(size_t)(p * 32 + lane) * 2 + 1];
                const float o1 = x1 * cs - x2 * sn, o2 = x2 * cs + x1 * sn;
                float* ko = m < MP ? kr_p + (size_t)m * 64 : kr_s + (size_t)(m - MP) * 64;
                ko[lane] = o1; ko[32 + lane] = o2;
                if (m < MP) ((unsigned*)(KRB + (size_t)m * 64))[lane] = pk2(o1, o2);
            }
        }
    }
}
__device__ __forceinline__ void ph_uq(const Ctx& c0, int j) {
    const Ctx c = fresh(c0);
    unsigned char* ws = ARG_WS();
    const bf16* QAN = (const bf16*)(ws + WS_QAN); const bf16* Wt = (const bf16*)(ws + WS_WUQ) + (size_t)j * 1536 * 384; bf16* QN = (bf16*)(ws + WS_QN); bf16* QR = (bf16*)(ws + WS_QR); const float* CS = (const float*)(ws + WS_CS);
    { pg8::Gemm g{QAN, Wt, MP, 1024, QL}; pg8::StaticOrder S; S.init(MP, 1024, c.G, c.wg);
      pg8::EpiBf16Split E{QN, 1024, 0, 0};
      pg8::gemm_phase<pg8::EpiBf16Split, pg8::StaticOrder, true, true>(c.lds, g, S, E, c.tid); }
    { const Ctx c1 = fresh(c0);
      pg8::Gemm g{QAN, Wt + (size_t)1024 * QL, MP, 512, QL}; pg8::StaticOrder S; S.init(MP, 512, c1.G, c1.wg);
      pg8::EpiRope E{ws};
      pg8::gemm_phase<pg8::EpiRope, pg8::StaticOrder, true, true>(c1.lds, g, S, E, c1.tid); }
    const Ctx c2 = fresh(c0);
    sg_uq(QAN, Wt, QN, QR, CS, c2.gw, c2.NGW, c2.lane);
}
__device__ __forceinline__ void ph_kvup(const Ctx& c0) {
    const Ctx c = fresh(c0);
    unsigned char* ws = ARG_WS();
    pg8::Gemm g{(const bf16*)(ws + WS_CB), (const bf16*)(ws + WS_WUKV), MP, 2048, KVL}; pg8::StaticOrder S; S.init(MP, 2048, c.G, c.wg);
    pg8::EpiBf16Split E{(bf16*)(ws + WS_KN), 1024, 1024, (size_t)(WS_VV - WS_KN) / 2};
    pg8::gemm_phase<pg8::EpiBf16Split, pg8::StaticOrder, true, true>(c.lds, g, S, E, c.tid);
}
__device__ __forceinline__ void ph_attn(const Ctx& c0) {
    const Ctx c = fresh(c0);
    unsigned char* ws = ARG_WS(); float* X = ARG_OUT();
    float* c_s = X + (size_t)M * D + (size_t)2 * BATCH * HA * DK * DV + (size_t)MP * KVL + (size_t)MP * 64 + (size_t)2 * DB * HA * DK * DV; float* kr_s = c_s + (size_t)DB * KVL;
    attn_naive_phase((const bf16*)(ws + WS_QN), (const bf16*)(ws + WS_QR), (const bf16*)(ws + WS_KN), (const bf16*)(ws + WS_KRB), (const bf16*)(ws + WS_VV), (bf16*)(ws + WS_OG), c.lds, c.wg, c.G, c.tid);
    decode_naive_phase((const bf16*)(ws + WS_QN), (const bf16*)(ws + WS_QR), (const bf16*)(ws + WS_WUKVN), (const bf16*)(ws + WS_WUKV), ARG_IN(3), ARG_IN(4), (const int*)ARG_IN(5), c_s, kr_s,
                       (float*)(ws + WS_SC), (bf16*)(ws + WS_OG), c.lds, c.wg, c.G, c.tid);
}
__device__ __forceinline__ void ph_mixout(const Ctx& c0, int l) {
    const Ctx c = fresh(c0);
    unsigned char* ws = ARG_WS();
    const bf16* Wt = (l < 2) ? (const bf16*)(ws + WS_WOUTA) + (size_t)l * 1024 * 1024 : (const bf16*)(ws + WS_WOUTB) + (size_t)(l - 2) * 1024 * 1024;
    const bf16* OG = (const bf16*)(ws + WS_OG); float* MIX = (float*)(ws + WS_MIX);
    pg8::Gemm g{OG, Wt, MP, 1024, 1024}; pg8::StaticOrder S; S.init(MP, 1024, c.G, c.wg);
    pg8::EpiF32 E{MIX, 1024};
    pg8::gemm_phase<pg8::EpiF32, pg8::StaticOrder, true, true>(c.lds, g, S, E, c.tid);
    const Ctx c2 = fresh(c0);
    sg_f32(OG, 1024, Wt, 1024, MIX, 1024, c2.gw, c2.NGW, c2.lane);
}
__device__ __forceinline__ void ph_resid(const Ctx& c0, int l, int which) {
    const Ctx c = fresh(c0);
    unsigned char* ws = ARG_WS(); float* X = ARG_OUT(); const float* gain = ARG_IN(6) + (size_t)(l * 4 + which) * D;
    const float* MIX = (const float*)(ws + WS_MIX); bf16* HN = (bf16*)(ws + WS_HN);
    for (int m = c.gw; m < M; m += c.NGW) row_resid_norm(MIX + (size_t)m * D, X + (size_t)m * D, gain, HN + (size_t)m * D, c.lane);
}
__device__ __forceinline__ void ph_ffn_in(const Ctx& c0, int l) {
    const Ctx c = fresh(c0);
    unsigned char* ws = ARG_WS();
    const bf16* HN = (const bf16*)(ws + WS_HN); const bf16* Wt = (const bf16*)(ws + WS_WFIN) + (size_t)l * 5632 * 1024; bf16* ACT = (bf16*)(ws + WS_ACT);
    pg8::Gemm g{HN, Wt, MP, 5632, 1024}; pg8::StaticOrder S; S.init(MP, 5632, c.G, c.wg);
    pg8::EpiSwiglu E{ACT, DFF};
    pg8::gemm_phase<pg8::EpiSwiglu, pg8::StaticOrder, true, true>(c.lds, g, S, E, c.tid);
    const Ctx c2 = fresh(c0);
    sg_swiglu(HN, Wt, ACT, c2.gw, c2.NGW, c2.lane);
}
__device__ __forceinline__ void ph_ffn_out(const Ctx& c0, int l) {
    const Ctx c = fresh(c0);
    unsigned char* ws = ARG_WS();
    const bf16* ACT = (const bf16*)(ws + WS_ACT); const bf16* Wt = (const bf16*)(ws + WS_WFOUT) + (size_t)l * 1024 * 2816; float* MIX = (float*)(ws + WS_MIX);
    pg8::Gemm g{ACT, Wt, MP, 1024, DFF}; pg8::StaticOrder S; S.init(MP, 1024, c.G, c.wg);
    pg8::EpiF32 E{MIX, 1024};
    pg8::gemm_phase<pg8::EpiF32, pg8::StaticOrder, true, true>(c.lds, g, S, E, c.tid);
    const Ctx c2 = fresh(c0);
    sg_f32(ACT, DFF, Wt, 1024, MIX, 1024, c2.gw, c2.NGW, c2.lane);
}

__global__ void __launch_bounds__(NTHR, 2) mk_fwd(Args args) {
    extern __shared__ __attribute__((aligned(16))) unsigned char lds_raw[];
    Ctx c;
    c.lds = (LAS unsigned char*)lds_raw;
    c.tid = 0; c.lane = 0; c.wave = __builtin_amdgcn_readfirstlane((int)threadIdx.x >> 6);
    c.wg = blockIdx.x; c.G = gridDim.x; c.gw = c.wg * NWAVES + c.wave; c.NGW = c.G * NWAVES;
    for (int u = threadIdx.x; u < (LDS_BYTES - RING_BYTES) / 4; u += NTHR) ((LAS unsigned*)(c.lds + RING_BYTES))[u] = 0u;
    __syncthreads();
#define MAKE_BAR(b) XcdBarrier b; b.wave = c.wave; b.bar = (unsigned*)(ARG_WS() + WS_CTL) + CW_BAR + karg32(192) * XCD_BAR_WORDS; b.x = xb_xcc_id(); b.st = (volatile LAS unsigned*)(c.lds + MISC_OFF) + 8
    { MAKE_BAR(b0); if (xb_thread0(c.wave)) (void)xb_add(&b0.bar[XB_XCNT(b0.x)], 1u); }
#define PH_BEGIN(k) { const int lo_ = karg32(184), hi_ = karg32(188); if (lo_ <= (k) && (k) < hi_) { if ((k) > lo_) { MAKE_BAR(bb); xcd_barrier(bb); }
#define PH_END } }
    PH_BEGIN(0) ph_prologue(c); PH_END
    for (int l = 0; l < 4; ++l) {
        const int pb = 1 + l * 10;
        if (l < 2) {
            PH_BEGIN(pb + 0) ph_hgrn_in(c, l); PH_END
            PH_BEGIN(pb + 1) ph_hgrn_rec(c, l); PH_END
        } else {
            PH_BEGIN(pb + 0) ph_dq(c, l - 2); PH_END
            PH_BEGIN(pb + 1) ph_qnorm(c, l - 2); PH_END
            PH_BEGIN(pb + 2) ph_uq(c, l - 2); PH_END
            if (l == 2) { PH_BEGIN(pb + 3) ph_kvup(c); PH_END }
            PH_BEGIN(pb + 4) ph_attn(c); PH_END
        }
        PH_BEGIN(pb + 5) ph_mixout(c, l); PH_END
        PH_BEGIN(pb + 6) ph_resid(c, l, 1); PH_END
        PH_BEGIN(pb + 7) ph_ffn_in(c, l); PH_END
        PH_BEGIN(pb + 8) ph_ffn_out(c, l); PH_END
        PH_BEGIN(pb + 9) ph_resid(c, l, 3); PH_END
    }
#undef PH_BEGIN
#undef PH_END
}

#ifndef MK_PER_PHASE
#define MK_PER_PHASE 0
#endif
extern "C" void kernel_launch(void* const* d_in, const int* in_sizes, int n_in, void* d_out, int out_size, void* d_ws, size_t ws_size, hipStream_t stream) {
    static int grid = 0;
    if (grid == 0) {
        int dev = 0, cus = 0, per_cu = 0;
        if (n_in != 21 || ws_size < WS_END) { fprintf(stderr, "kernel_launch: unexpected arguments (n_in %d, ws %zu < %zu)\n", n_in, ws_size, (size_t)WS_END); grid = -1; return; }
        if (hipGetDevice(&dev) != hipSuccess || hipDeviceGetAttribute(&cus, hipDeviceAttributeMultiprocessorCount, dev) != hipSuccess) { grid = -1; return; }
        if (hipFuncSetAttribute((const void*)mk_fwd, hipFuncAttributeMaxDynamicSharedMemorySize, LDS_BYTES) != hipSuccess) { fprintf(stderr, "kernel_launch: hipFuncSetAttribute failed\n"); grid = -1; return; }
        if (hipOccupancyMaxActiveBlocksPerMultiprocessor(&per_cu, (const void*)mk_fwd, NTHR, LDS_BYTES) != hipSuccess || per_cu < 1) fprintf(stderr, "kernel_launch: occupancy query reports %d\n", per_cu);
        (void)hipGetLastError();
        grid = cus;
    }
    if (grid < 0) return;
    (void)hipMemsetAsync((char*)d_ws + WS_CTL, 0, CTL_BYTES, stream);
    Args a{};
    for (int i = 0; i < 21; ++i) a.in[i] = (const float*)d_in[i];
    a.out = (float*)d_out; a.ws = (unsigned char*)d_ws;
#if MK_PER_PHASE
    int li = 0;
    for (int k = 0; k < NPH; ++k) { if (!phase_exists(k)) continue; a.ph_lo = k; a.ph_hi = k + 1; a.li = li++; hipLaunchKernelGGL(mk_fwd, dim3(grid), dim3(NTHR), LDS_BYTES, stream, a); }
#else
    a.ph_lo = 0; a.ph_hi = NPH; a.li = 0;
    hipLaunchKernelGGL(mk_fwd, dim3(grid), dim3(NTHR), LDS_BYTES, stream, a);
#endif
    const hipError_t le = hipPeekAtLastError();
    if (le != hipSuccess) fprintf(stderr, "kernel_launch: launch failed: %s\n", hipGetErrorName(le));
}
```

```cpp
#include <hip/hip_runtime.h>
#include <cstdio>
#include <cstdint>
#include <math.h>
#define GAS __attribute__((address_space(1)))
#define LAS __attribute__((address_space(3)))
typedef unsigned short bf16;
typedef unsigned v4u __attribute__((ext_vector_type(4)));
typedef unsigned v2u __attribute__((ext_vector_type(2)));
typedef float f32x4 __attribute__((ext_vector_type(4)));
typedef short bf16x8 __attribute__((ext_vector_type(8)));
constexpr int NWAVES = 8, NTHR = 512;
constexpr int D = 1024, BATCH = 8, SEQ = 2048, MP = BATCH * SEQ, DB = 128, M = MP + DB;
constexpr int HA = 8, DK = 128, DV = 128;
constexpr int QL = 384, KVL = 256;
constexpr int PAST = 8192, PAGE = 128, NPAGES = PAST / PAGE;
constexpr int DFF = 2816;
constexpr float EPS = 1e-6f;
constexpr float QSCALE = 0.07216878364870322f * 1.4426950408889634f;
constexpr int QCP = 768;
constexpr int SCP = PAST + 64;

constexpr size_t MiB = 1u << 20;
constexpr size_t WS_CTL = 0, CTL_BYTES = 1 * MiB;
constexpr size_t WS_WIN   = 1 * MiB;
constexpr size_t WS_WOUTA = WS_WIN + 2 * (size_t)4096 * 1024 * 2;
constexpr size_t WS_WFIN  = WS_WOUTA + 2 * (size_t)1024 * 1024 * 2;
constexpr size_t WS_WFOUT = WS_WFIN + 4 * (size_t)5632 * 1024 * 2;
constexpr size_t WS_WDQ0  = WS_WFOUT + 4 * (size_t)1024 * 2816 * 2;
constexpr size_t WS_WDQ1  = WS_WDQ0 + (size_t)768 * 1024 * 2;
constexpr size_t WS_WUQ   = WS_WDQ1 + (size_t)512 * 1024 * 2;
constexpr size_t WS_WUKV  = WS_WUQ + 2 * (size_t)1536 * 384 * 2;
constexpr size_t WS_WUKVN = WS_WUKV + (size_t)2048 * 256 * 2;
constexpr size_t WS_WOUTB = WS_WUKVN + (size_t)256 * 2048 * 2;
constexpr size_t WS_CS    = WS_WOUTB + 2 * (size_t)1024 * 1024 * 2;
constexpr size_t WS_LBT   = WS_CS + (size_t)2049 * 64 * 4 + 256;
constexpr size_t WS_HN    = ((WS_LBT + 2 * 1024 * 2 * 4 + 4095) / 4096) * 4096;
constexpr size_t WS_QB    = WS_HN + (size_t)M * 1024 * 2;
constexpr size_t WS_VB    = WS_QB + (size_t)M * 1024 * 2;
constexpr size_t WS_GATE  = WS_VB + (size_t)M * 1024 * 2;
constexpr size_t WS_GB    = WS_GATE + (size_t)M * 1024 * 2;
constexpr size_t WS_OG    = WS_GB + (size_t)M * 1024 * 4;
constexpr size_t WS_MIX   = WS_OG + (size_t)M * 1024 * 2;
constexpr size_t WS_ACT   = WS_MIX + (size_t)M * 1024 * 4;
constexpr size_t WS_QC    = WS_ACT + (size_t)M * 2816 * 2;
constexpr size_t WS_QAN   = WS_QC + (size_t)M * QCP * 4;
constexpr size_t WS_CB    = WS_QAN + (size_t)M * 384 * 2;
constexpr size_t WS_KRB   = WS_CB + (size_t)M * 256 * 2;
constexpr size_t WS_QN    = WS_KRB + (size_t)MP * 64 * 2;
constexpr size_t WS_QR    = WS_QN + (size_t)M * 1024 * 2;
constexpr size_t WS_KN    = WS_QR + (size_t)M * 512 * 2;
constexpr size_t WS_VV    = WS_KN + (size_t)MP * 1024 * 2;
constexpr size_t WS_SC    = WS_VV + (size_t)MP * 1024 * 2;
constexpr size_t WS_END   = WS_SC + (size_t)DB * 8 * SCP * 4;
constexpr int CW_BAR = 4096;
constexpr int RING_BYTES = 131072, MISC_OFF = RING_BYTES + 320, LDS_BYTES = 147456;

__device__ __forceinline__ float bf2f(unsigned b) { return __uint_as_float(b << 16); }
__device__ __forceinline__ unsigned f2bf(float f) { unsigned u = __float_as_uint(f); return (u + 0x7fffu + ((u >> 16) & 1u)) >> 16; }
__device__ __forceinline__ unsigned pk2(float lo, float hi) { return f2bf(lo) | (f2bf(hi) << 16); }
#define LDS_WAIT() asm volatile("s_waitcnt lgkmcnt(0)" ::: "memory")
__device__ __forceinline__ int lane_id_v() { int l; asm volatile("v_mbcnt_lo_u32_b32 %0, -1, 0\n\tv_mbcnt_hi_u32_b32 %0, -1, %0" : "=v"(l)); return l; }
__device__ __forceinline__ float shx(float v, int mask, int lane) { return __int_as_float(__builtin_amdgcn_ds_bpermute((lane ^ mask) << 2, __float_as_int(v))); }
__device__ __forceinline__ float wave_sum(float v) {
    const int lane = lane_id_v();
#pragma unroll
    for (int o = 1; o < 64; o <<= 1) v += shx(v, o, lane);
    return v;
}
__device__ __forceinline__ float wave_max(float v) {
    const int lane = lane_id_v();
#pragma unroll
    for (int o = 1; o < 64; o <<= 1) v = fmaxf(v, shx(v, o, lane));
    return v;
}
namespace pg8 {
#define PG8_LAS __attribute__((address_space(3)))
typedef unsigned short bf16_t;
typedef short bf16x8 __attribute__((ext_vector_type(8)));
typedef float f32x4 __attribute__((ext_vector_type(4)));
typedef unsigned u32x4 __attribute__((ext_vector_type(4)));
constexpr int BM = 256, BK = 64, HALF = 128, HTB = HALF * BK * 2  , STAGE_BYTES = 8 * HTB, NXCD = 8, WGM = 8;

__host__ __device__ __forceinline__ int lds_byte(int r, int c) { const int st = (r >> 4) * 2 + (c >> 5), rr = r & 15, cc = c & 31, ob = rr * 64 + cc * 2; return st * 1024 + (ob ^ (((ob >> 9) & 1) << 5)); }
__host__ __device__ __forceinline__ void stage_rc(int b, int& R, int& C) { const int st = b / 1024, sb = b % 1024, swz = sb ^ (((sb >> 9) & 1) << 5); R = (st >> 1) * 16 + swz / 64; C = (st & 1) * 32 + (swz % 64) / 2; }
__host__ __device__ __forceinline__ int perm32(int rho) { const int n = rho >> 4, i = rho & 15; return 8 * (i >> 2) + 4 * n + (i & 3); }

struct Unit { int pm, pn; };
struct Gemm { const bf16_t* A; const bf16_t* Bt; int M, N, K; };

struct StaticOrder {
    int nM, nN, nwg, G, c;
    __host__ __device__ void init(int M, int N, int G_, int c_) { nM = M / BM; nN = N / BM; nwg = nM * nN; G = G_; c = c_; }
    __host__ __device__ bool next(int i, Unit& u) const {
        const long L = (long)i * G + c; if (L >= nwg) return false;
        int wgid = (int)L; { const int q = nwg / NXCD, r = nwg % NXCD, xcd = wgid % NXCD, off = wgid / NXCD; wgid = (xcd < r ? xcd * (q + 1) : r * (q + 1) + (xcd - r) * q) + off; }
        const int nig = WGM * nN, gid = wgid / nig, fm = gid * WGM, gsz = (nM - fm) < WGM ? (nM - fm) : WGM;
        u.pm = fm + ((wgid % nig) % gsz); u.pn = (wgid % nig) / gsz; return true;
    }
    __device__ __forceinline__ void a_ready(const Unit&) const {}
    __device__ __forceinline__ void done(const Unit&) const {}
};

__device__ __forceinline__ unsigned cvt_pk_bf16(float lo, float hi) { unsigned r; asm volatile("v_cvt_pk_bf16_f32 %0, %1, %2" : "=v"(r) : "v"(lo), "v"(hi)); return r; }
typedef float f32x2 __attribute__((ext_vector_type(2)));
__device__ __forceinline__ float silu_fast(float x) { return x * __builtin_amdgcn_rcpf(1.0f + __expf(-x)); }
__device__ __forceinline__ float logf_gate(float z, float log_lb, float l1p) {
    const float lsig = fminf(z, 0.f) - __logf(1.0f + __expf(-fabsf(z)));
    const float bb = l1p + lsig;
    const float mx = fmaxf(log_lb, bb), mn = fminf(log_lb, bb);
    return fminf(mx + __logf(1.0f + __expf(mn - mx)), 0.f);
}
struct EpiF32 {
    static constexpr bool PERM = false, AFTER_DRAIN = false;
    float* C; int ldc;
    __device__ __forceinline__ void operator()(const f32x4 (&acc)[2][2][4][2], const Unit& u, int wr, int wc, int fr_, int fq_) const {
        const int ln_ = lane_id_v(); const int fr = ln_ & 15, fq = ln_ >> 4;
        const int row0 = u.pm * BM + wr * 64 + fr, col0 = u.pn * BM + wc * 32 + 4 * fq;
#pragma unroll
        for (int ai = 0; ai < 2; ++ai)
#pragma unroll
            for (int m = 0; m < 4; ++m) { float* rowp = C + (size_t)(row0 + ai * HALF + m * 16) * ldc + col0;
#pragma unroll
                for (int bj = 0; bj < 2; ++bj)
#pragma unroll
                    for (int n = 0; n < 2; ++n) *(f32x4*)(rowp + bj * HALF + n * 16) = acc[ai][bj][m][n]; }
    }
};
struct EpiBf16Split {
    static constexpr bool PERM = true, AFTER_DRAIN = false;
    bf16_t* O; int ldc; int split_cols; size_t split_stride;
    __device__ __forceinline__ void operator()(const f32x4 (&acc)[2][2][4][2], const Unit& u, int wr, int wc, int fr_, int fq_) const {
        const int ln_ = lane_id_v(); const int fr = ln_ & 15, fq = ln_ >> 4;
        const int row0 = u.pm * BM + wr * 64 + fr; int colt = u.pn * BM; bf16_t* base = O;
        if (split_cols) { const int t = colt / split_cols; base += (size_t)t * split_stride; colt -= t * split_cols; }
        const int col0 = colt + wc * 32 + 8 * fq;
#pragma unroll
        for (int ai = 0; ai < 2; ++ai)
#pragma unroll
            for (int m = 0; m < 4; ++m) { bf16_t* rowp = base + (size_t)(row0 + ai * HALF + m * 16) * ldc + col0;
#pragma unroll
                for (int bj = 0; bj < 2; ++bj) { const f32x4 v0 = acc[ai][bj][m][0], v1 = acc[ai][bj][m][1];
                    u32x4 w; w.x = cvt_pk_bf16(v0[0], v0[1]); w.y = cvt_pk_bf16(v0[2], v0[3]); w.z = cvt_pk_bf16(v1[0], v1[1]); w.w = cvt_pk_bf16(v1[2], v1[3]);
                    *(u32x4*)(rowp + bj * HALF) = w; } }
    }
};
struct EpiHgrnIn {
    static constexpr bool PERM = true, AFTER_DRAIN = false;
    unsigned char* ws; int layer;
    __device__ __forceinline__ void operator()(const f32x4 (&acc)[2][2][4][2], const Unit& u, int wr, int wc, int fr_, int fq_) const {
        const int ln_ = lane_id_v(); const int fr = ln_ & 15, fq = ln_ >> 4;
        const int row0 = u.pm * BM + wr * 64 + fr; const int type = u.pn >> 2; const int cl0 = (u.pn & 3) * 256 + wc * 32 + 8 * fq;
        if (type == 1) {
            const float* lbt = (const float*)(ws + WS_LBT) + (size_t)layer * 2048; float* GB = (float*)(ws + WS_GB);
#pragma unroll
            for (int bj = 0; bj < 2; ++bj) {
                const int cl = cl0 + bj * HALF;
                f32x4 t0 = *(const f32x4*)(lbt + 2 * cl), t1 = *(const f32x4*)(lbt + 2 * cl + 4), t2 = *(const f32x4*)(lbt + 2 * cl + 8), t3 = *(const f32x4*)(lbt + 2 * cl + 12);
#pragma unroll
                for (int ai = 0; ai < 2; ++ai)
#pragma unroll
                    for (int m = 0; m < 4; ++m) {
                        const f32x4 v0 = acc[ai][bj][m][0], v1 = acc[ai][bj][m][1]; f32x4 o0, o1;
                        o0[0] = logf_gate(v0[0], t0[0], t0[1]); o0[1] = logf_gate(v0[1], t0[2], t0[3]); o0[2] = logf_gate(v0[2], t1[0], t1[1]); o0[3] = logf_gate(v0[3], t1[2], t1[3]);
                        o1[0] = logf_gate(v1[0], t2[0], t2[1]); o1[1] = logf_gate(v1[1], t2[2], t2[3]); o1[2] = logf_gate(v1[2], t3[0], t3[1]); o1[3] = logf_gate(v1[3], t3[2], t3[3]);
                        float* p = GB + (size_t)(row0 + ai * HALF + m * 16) * 1024 + cl;
                        *(f32x4*)p = o0; *(f32x4*)(p + 4) = o1;
                    }
            }
        } else {
            bf16_t* dst = (bf16_t*)(ws + (type == 0 ? WS_QB : (type == 2 ? WS_VB : WS_GATE)));
#pragma unroll
            for (int ai = 0; ai < 2; ++ai)
#pragma unroll
                for (int m = 0; m < 4; ++m)
#pragma unroll
                    for (int bj = 0; bj < 2; ++bj) {
                        f32x4 v0 = acc[ai][bj][m][0], v1 = acc[ai][bj][m][1];
                        if (type == 0) {
#pragma unroll
                            for (int j = 0; j < 4; ++j) { v0[j] = silu_fast(v0[j]) * 0.08838834764831845f; v1[j] = silu_fast(v1[j]) * 0.08838834764831845f; }
                        } else if (type == 3) {
#pragma unroll
                            for (int j = 0; j < 4; ++j) { v0[j] = silu_fast(v0[j]); v1[j] = silu_fast(v1[j]); }
                        }
                        u32x4 w; w.x = cvt_pk_bf16(v0[0], v0[1]); w.y = cvt_pk_bf16(v0[2], v0[3]); w.z = cvt_pk_bf16(v1[0], v1[1]); w.w = cvt_pk_bf16(v1[2], v1[3]);
                        *(u32x4*)(dst + (size_t)(row0 + ai * HALF + m * 16) * 1024 + cl0 + bj * HALF) = w;
                    }
        }
    }
};
struct EpiSwiglu {
    static constexpr bool PERM = true, AFTER_DRAIN = false;
    bf16_t* ACT; int ldc;
    __device__ __forceinline__ void operator()(const f32x4 (&acc)[2][2][4][2], const Unit& u, int wr, int wc, int fr_, int fq_) const {
        const int ln_ = lane_id_v(); const int fr = ln_ & 15, fq = ln_ >> 4;
        const int row0 = u.pm * BM + wr * 64 + fr, col0 = u.pn * HALF + wc * 32 + 8 * fq;
#pragma unroll
        for (int ai = 0; ai < 2; ++ai)
#pragma unroll
            for (int m = 0; m < 4; ++m) {
                f32x4 r0, r1;
#pragma unroll
                for (int j = 0; j < 4; ++j) { r0[j] = silu_fast(acc[ai][0][m][0][j]) * acc[ai][1][m][0][j]; r1[j] = silu_fast(acc[ai][0][m][1][j]) * acc[ai][1][m][1][j]; }
                u32x4 w; w.x = cvt_pk_bf16(r0[0], r0[1]); w.y = cvt_pk_bf16(r0[2], r0[3]); w.z = cvt_pk_bf16(r1[0], r1[1]); w.w = cvt_pk_bf16(r1[2], r1[3]);
                *(u32x4*)(ACT + (size_t)(row0 + ai * HALF + m * 16) * ldc + col0) = w;
            }
    }
};
struct EpiRope {
    static constexpr bool PERM = true, AFTER_DRAIN = false;
    unsigned char* ws;
    __device__ __forceinline__ void operator()(const f32x4 (&acc)[2][2][4][2], const Unit& u, int wr, int wc, int fr_, int fq_) const {
        const int ln_ = lane_id_v(); const int fr = ln_ & 15, fq = ln_ >> 4;
        const int row0 = u.pm * BM + wr * 64 + fr;
        {
            bf16_t* QR = (bf16_t*)(ws + WS_QR); const float* CS = (const float*)(ws + WS_CS);
            const int rc0 = u.pn * BM + wc * 32 + 8 * fq;
#pragma unroll
            for (int ai = 0; ai < 2; ++ai)
#pragma unroll
                for (int m = 0; m < 4; ++m) { const int row = row0 + ai * HALF + m * 16; const int pos = row & 2047;
#pragma unroll
                    for (int bj = 0; bj < 2; ++bj) { const int rc = rc0 + bj * HALF; const int i0 = (rc & 63) >> 1;
                        const float* cp = CS + (size_t)(pos * 32 + i0) * 2;
                        u32x4 w;
                        { const f32x4 cc = *(const f32x4*)cp; const f32x4 v0 = acc[ai][bj][m][0];
                          w.x = cvt_pk_bf16(v0[0] * cc[0] - v0[1] * cc[1], v0[1] * cc[0] + v0[0] * cc[1]);
                          w.y = cvt_pk_bf16(v0[2] * cc[2] - v0[3] * cc[3], v0[3] * cc[2] + v0[2] * cc[3]); }
                        asm volatile("" ::: "memory");
                        { const f32x4 cc = *(const f32x4*)(cp + 4); const f32x4 v1 = acc[ai][bj][m][1];
                          w.z = cvt_pk_bf16(v1[0] * cc[0] - v1[1] * cc[1], v1[1] * cc[0] + v1[0] * cc[1]);
                          w.w = cvt_pk_bf16(v1[2] * cc[2] - v1[3] * cc[3], v1[3] * cc[2] + v1[2] * cc[3]); }
                        *(u32x4*)(QR + (size_t)row * 512 + rc) = w;
                        asm volatile("" ::: "memory"); } }
        }
    }
};
template <class Epi, class Sched, bool ALIGN_EPI = false, bool SP2 = false>
__device__ __forceinline__ void gemm_phase(PG8_LAS unsigned char* lds, const Gemm g, const Sched& S, const Epi& E, const int tid_in) {
    int tid_o = tid_in; asm volatile("" : "+v"(tid_o));
    const int tid = tid_o, wid = __builtin_amdgcn_readfirstlane(tid >> 6), lane = tid & 63, wr = wid >> 2, wc = wid & 3, fr = lane & 15, fq = lane >> 4;
    const int K = g.K, nt = K / BK;
    unsigned voffA[2], voffB[2];
#pragma unroll
    for (int i = 0; i < 2; ++i) { int R, C; stage_rc(tid * 16 + i * 8192, R, C); const int Rb = Epi::PERM ? ((R & ~31) + perm32(R & 31)) : R;
        voffA[i] = (unsigned)(R * K + C) * 2u; voffB[i] = (unsigned)(Rb * K + C) * 2u; }
    const size_t kstep = (size_t)(BK * 2);
    const size_t hstep = (size_t)HALF * K * 2;
    const size_t tstep = 2 * hstep;
    const unsigned ldsw = (unsigned)wid * 1024u;
    const int aoff = lds_byte(wr * 64 + fr, fq * 8), boff = lds_byte(wc * 32 + fr, fq * 8);
#define PG8_SA(b, h) (((b) * 2 + (h)) * HTB)
#define PG8_SB(b, h) ((4 + (b) * 2 + (h)) * HTB)
#define PG8_STAGE(bufoff, gbase, voff) do { _Pragma("unroll") for (int _i = 0; _i < 2; ++_i) \
        __builtin_amdgcn_global_load_lds((const unsigned*)((const char*)(gbase) + (voff)[_i]), (PG8_LAS unsigned*)(lds + (bufoff) + ldsw + _i * 8192), 16, 0, 0); } while (0)
#define PG8_LDA(dst, b, h) do { _Pragma("unroll") for (int m = 0; m < 4; ++m) _Pragma("unroll") for (int k = 0; k < 2; ++k) dst[m][k] = *(const PG8_LAS bf16x8*)(lds + PG8_SA(b, h) + aoff + m * 2048 + k * 1024); } while (0)
#define PG8_LDB(dst, b, h) do { _Pragma("unroll") for (int n = 0; n < 2; ++n) _Pragma("unroll") for (int k = 0; k < 2; ++k) dst[n][k] = *(const PG8_LAS bf16x8*)(lds + PG8_SB(b, h) + boff + n * 2048 + k * 1024); } while (0)
#define PG8_MMA(ai, bj, At, Bt) do { __builtin_amdgcn_s_setprio(1); _Pragma("unroll") for (int m = 0; m < 4; ++m) _Pragma("unroll") for (int n = 0; n < 2; ++n) _Pragma("unroll") for (int k = 0; k < 2; ++k) \
        acc[ai][bj][m][n] = __builtin_amdgcn_mfma_f32_16x16x32_bf16(Bt[n][k], At[m][k], acc[ai][bj][m][n], 0, 0, 0); __builtin_amdgcn_s_setprio(0); } while (0)
#define PG8_WAIT_V(n) asm volatile("s_waitcnt vmcnt(" #n ")" ::: "memory")
#define PG8_WAIT_L(n) asm volatile("s_waitcnt lgkmcnt(" #n ")" ::: "memory")
#define PG8_BAR __builtin_amdgcn_s_barrier()
#define PG8_SCHED __builtin_amdgcn_sched_barrier(0)
    Unit cur, nxt; int ui = 0;
    if (!S.next(0, cur)) return;
    f32x4 acc[2][2][4][2];
#pragma unroll
    for (int a = 0; a < 2; ++a)
#pragma unroll
        for (int b = 0; b < 2; ++b)
#pragma unroll
            for (int m = 0; m < 4; ++m)
#pragma unroll
                for (int n = 0; n < 2; ++n) acc[a][b][m][n] = (f32x4){0.f, 0.f, 0.f, 0.f};
    bf16x8 At[4][2], B0[2][2], B1[2][2];
    const char* cA = (const char*)g.A + (size_t)cur.pm * tstep; const char* cB = (const char*)g.Bt + (size_t)cur.pn * tstep;
    S.a_ready(cur);
    if constexpr (SP2) {
        PG8_STAGE(PG8_SB(0, 0), cB, voffB); PG8_STAGE(PG8_SB(0, 1), cB + hstep, voffB); PG8_STAGE(PG8_SA(0, 0), cA, voffA); PG8_STAGE(PG8_SA(0, 1), cA + hstep, voffA);
        if (wr == 1) PG8_BAR;
        PG8_WAIT_V(2); PG8_BAR;
        PG8_STAGE(PG8_SB(1, 0), cB + kstep, voffB); PG8_STAGE(PG8_SA(1, 0), cA + kstep, voffA); PG8_STAGE(PG8_SB(1, 1), cB + hstep + kstep, voffB);
        PG8_WAIT_V(6); PG8_BAR;
    } else {
        PG8_STAGE(PG8_SB(0, 0), cB, voffB); PG8_STAGE(PG8_SA(0, 0), cA, voffA); PG8_STAGE(PG8_SB(0, 1), cB + hstep, voffB); PG8_STAGE(PG8_SA(0, 1), cA + hstep, voffA);
        if (wr == 1) PG8_BAR;
        PG8_WAIT_V(4); PG8_BAR;
        PG8_STAGE(PG8_SB(1, 0), cB + kstep, voffB); PG8_STAGE(PG8_SA(1, 0), cA + kstep, voffA); PG8_STAGE(PG8_SB(1, 1), cB + hstep + kstep, voffB);
        PG8_WAIT_V(6); PG8_BAR;
    }
    for (;;) {
        const bool has_next = S.next(ui + 1, nxt);
        const char* nA = has_next ? (const char*)g.A + (size_t)nxt.pm * tstep : cA; const char* nB = has_next ? (const char*)g.Bt + (size_t)nxt.pn * tstep : cB;
        for (int t = 0; t < nt; t += 2) {
            const bool last = (t == nt - 2);
            const char* a1 = cA + (size_t)(t + 1) * kstep;
            const char* a2 = last ? nA : cA + (size_t)(t + 2) * kstep; const char* b2 = last ? nB : cB + (size_t)(t + 2) * kstep;
            const char* a3 = a2 + kstep; const char* b3 = b2 + kstep;
            if (last && has_next) S.a_ready(nxt);
            if constexpr (SP2) {
            PG8_LDB(B0, 0, 0); PG8_LDB(B1, 0, 1); PG8_SCHED; PG8_LDA(At, 0, 0); PG8_STAGE(PG8_SA(1, 1), a1 + hstep, voffA);
            PG8_WAIT_V(8); PG8_WAIT_L(0); PG8_BAR; PG8_MMA(0, 0, At, B0); PG8_MMA(0, 1, At, B1); PG8_BAR; PG8_SCHED;
            PG8_LDA(At, 0, 1); PG8_STAGE(PG8_SB(0, 0), b2, voffB); PG8_STAGE(PG8_SB(0, 1), b2 + hstep, voffB); PG8_STAGE(PG8_SA(0, 0), a2, voffA);
            PG8_WAIT_V(8); PG8_WAIT_L(0); PG8_BAR; PG8_MMA(1, 0, At, B0); PG8_MMA(1, 1, At, B1); PG8_BAR; PG8_SCHED;
            PG8_LDB(B0, 1, 0); PG8_LDB(B1, 1, 1); PG8_SCHED; PG8_LDA(At, 1, 0); PG8_STAGE(PG8_SA(0, 1), a2 + hstep, voffA);
            PG8_WAIT_V(8); PG8_WAIT_L(0); PG8_BAR; PG8_MMA(0, 0, At, B0); PG8_MMA(0, 1, At, B1); PG8_BAR; PG8_SCHED;
            PG8_LDA(At, 1, 1); PG8_STAGE(PG8_SB(1, 0), b3, voffB); PG8_STAGE(PG8_SB(1, 1), b3 + hstep, voffB); PG8_STAGE(PG8_SA(1, 0), a3, voffA);
            PG8_WAIT_V(8); PG8_WAIT_L(0); PG8_BAR; PG8_MMA(1, 0, At, B0); PG8_MMA(1, 1, At, B1); PG8_BAR; PG8_SCHED;
            } else {
            PG8_LDB(B0, 0, 0); PG8_SCHED; PG8_LDA(At, 0, 0); PG8_STAGE(PG8_SA(1, 1), a1 + hstep, voffA);
            PG8_WAIT_L(8); PG8_BAR; PG8_WAIT_L(0); PG8_MMA(0, 0, At, B0); PG8_BAR; PG8_SCHED;
            PG8_LDB(B1, 0, 1); PG8_STAGE(PG8_SB(0, 0), b2, voffB);
            PG8_BAR; PG8_WAIT_L(0); PG8_MMA(0, 1, At, B1); PG8_BAR;
            PG8_LDA(At, 0, 1); PG8_STAGE(PG8_SA(0, 0), a2, voffA);
            PG8_BAR; PG8_WAIT_L(0); PG8_MMA(1, 0, At, B0); PG8_BAR; PG8_SCHED;
            PG8_STAGE(PG8_SB(0, 1), b2 + hstep, voffB);
            PG8_WAIT_V(6); PG8_BAR; PG8_MMA(1, 1, At, B1); PG8_BAR;
            PG8_LDB(B0, 1, 0); PG8_SCHED; PG8_LDA(At, 1, 0); PG8_STAGE(PG8_SA(0, 1), a2 + hstep, voffA);
            PG8_WAIT_L(8); PG8_BAR; PG8_WAIT_L(0); PG8_MMA(0, 0, At, B0); PG8_BAR; PG8_SCHED;
            PG8_LDB(B1, 1, 1); PG8_STAGE(PG8_SB(1, 0), b3, voffB);
            PG8_BAR; PG8_WAIT_L(0); PG8_MMA(0, 1, At, B1); PG8_BAR;
            PG8_LDA(At, 1, 1); PG8_STAGE(PG8_SA(1, 0), a3, voffA);
            PG8_BAR; PG8_WAIT_L(0); PG8_MMA(1, 0, At, B0); PG8_BAR; PG8_SCHED;
            PG8_STAGE(PG8_SB(1, 1), b3 + hstep, voffB);
            PG8_WAIT_V(6); PG8_BAR; PG8_MMA(1, 1, At, B1); PG8_BAR;
            }
        }
        if constexpr (ALIGN_EPI) { if (wr == 0) PG8_BAR; }
        if constexpr (!Epi::AFTER_DRAIN) { E(acc, cur, wr, wc, fr, fq); S.done(cur); }
        if (!has_next) break;
#pragma unroll
        for (int a = 0; a < 2; ++a)
#pragma unroll
            for (int b = 0; b < 2; ++b)
#pragma unroll
                for (int m = 0; m < 4; ++m)
#pragma unroll
                    for (int n = 0; n < 2; ++n) acc[a][b][m][n] = (f32x4){0.f, 0.f, 0.f, 0.f};
        cur = nxt; cA = nA; cB = nB; ++ui;
        if constexpr (ALIGN_EPI) { if (wr == 1) PG8_BAR; }
    }
    PG8_WAIT_V(0);
    if constexpr (!ALIGN_EPI) { if (wr == 0) PG8_BAR; }
    PG8_BAR;
    if constexpr (Epi::AFTER_DRAIN) { E.fused(acc, cur, wr, wc, fr, fq, lds, wid, lane); S.done(cur); }
#undef PG8_SA
#undef PG8_SB
#undef PG8_STAGE
#undef PG8_LDA
#undef PG8_LDB
#undef PG8_MMA
#undef PG8_WAIT_V
#undef PG8_WAIT_L
#undef PG8_BAR
#undef PG8_SCHED
}
}
#define XB_TMO      128
#define XB_XCNT(j)  (256  + 64 * (j))
#define XB_XSUB(j)  (1280 + 64 * (j))
#define XB_XGEN(j)  (2304 + 64 * (j))
#define XB_TOP      3328
#define XB_TOPGEN   3392
#define XCD_BAR_WORDS 3456
#define XB_SPIN_CAP (1u << 18)

__device__ __forceinline__ unsigned xb_ld(unsigned* p)              { return __hip_atomic_load(p, __ATOMIC_RELAXED, __HIP_MEMORY_SCOPE_AGENT); }
__device__ __forceinline__ unsigned xb_add(unsigned* p, unsigned v) { return __hip_atomic_fetch_add(p, v, __ATOMIC_RELAXED, __HIP_MEMORY_SCOPE_AGENT); }
__device__ __forceinline__ unsigned xb_xcc_id() { return (unsigned)__builtin_amdgcn_s_getreg((3 << 11) | 20) & 0xFu; }
#define XB_SPIN(cond, bar) do { unsigned _sp = 0; while (cond) { __builtin_amdgcn_s_sleep(1); \
    if ((++_sp & 255u) == 0u) { if (xb_ld(&(bar)[XB_TMO])) break; if (_sp > XB_SPIN_CAP) { atomicAdd(&(bar)[XB_TMO], 1u); break; } } } } while (0)

struct XcdBarrier {
    int wave; unsigned* bar; unsigned x;
    volatile LAS unsigned* st;
};

__device__ __forceinline__ bool xb_thread0(int wave) { return wave == 0 && lane_id_v() == 0; }
__device__ __forceinline__ XcdBarrier xcd_barrier_post(unsigned* bar, volatile LAS unsigned* st, int wave) {
    XcdBarrier b; b.wave = wave; b.bar = bar; b.x = xb_xcc_id(); b.st = st;
    if (xb_thread0(wave)) (void)xb_add(&bar[XB_XCNT(b.x)], 1u);
    return b;
}
__device__ __forceinline__ void xcd_barrier_complete(unsigned* bar, unsigned x, unsigned& nloc, unsigned& nx) {
    const unsigned G = gridDim.x * gridDim.y * gridDim.z;
    unsigned sum, cnt, mine, sp = 0u;
    for (;;) {
        sum = 0u; cnt = 0u; mine = 0u;
#pragma unroll
        for (unsigned j = 0; j < 16; ++j) { const unsigned c = xb_ld(&bar[XB_XCNT(j)]); sum += c; cnt += (c > 0u) ? 1u : 0u; mine = (j == x) ? c : mine; }
        if (sum == G) break;
        __builtin_amdgcn_s_sleep(1);
        if ((++sp & 255u) == 0u) { if (xb_ld(&bar[XB_TMO])) break; if (sp > XB_SPIN_CAP) { atomicAdd(&bar[XB_TMO], 1u); break; } }
    }
    nloc = mine > 0u ? mine : 1u; nx = cnt > 0u ? cnt : 1u;
}

__device__ __forceinline__ void xcd_barrier(const XcdBarrier& b) {
    asm volatile("s_waitcnt vmcnt(0)" ::: "memory");
    __syncthreads();
    if (xb_thread0(b.wave)) {
        unsigned* bar = b.bar; asm volatile("" : "+s"(bar));
        __builtin_amdgcn_s_waitcnt(0);
        unsigned nloc = b.st[0], nx = b.st[1];
        if (nloc == 0u) { unsigned xo = b.x; asm volatile("" : "+s"(xo)); xcd_barrier_complete(bar, xo, nloc, nx); b.st[0] = nloc; b.st[1] = nx; }
        const unsigned old = xb_add(&bar[XB_XSUB(b.x)], 1u);
        const unsigned gen = old / nloc;
        if (old + 1u == (gen + 1u) * nloc) {
            __builtin_amdgcn_fence(__ATOMIC_RELEASE, "agent");
            asm volatile("s_waitcnt vmcnt(0)" ::: "memory");
            const unsigned og = xb_add(&bar[XB_TOP], 1u);
            const unsigned tg = og / nx;
            if (og + 1u == (tg + 1u) * nx) xb_add(&bar[XB_TOPGEN], 1u);
            else XB_SPIN(xb_ld(&bar[XB_TOPGEN]) == tg, bar);
            __builtin_amdgcn_fence(__ATOMIC_ACQUIRE, "agent");
            xb_add(&bar[XB_XGEN(b.x)], 1u);
            asm volatile("s_waitcnt vmcnt(0)" ::: "memory");
        } else {
            XB_SPIN(xb_ld(&bar[XB_XGEN(b.x)]) == gen, bar);
            __builtin_amdgcn_fence(__ATOMIC_ACQUIRE, "agent");
            asm volatile("s_waitcnt vmcnt(0)" ::: "memory");
        }
    }
    __syncthreads();
}
template <int NT> __device__ __forceinline__ void sg_tile(const bf16* A, int r0, const bf16* Bt, const int (&nrow)[NT], int K, int lane, f32x4 (&acc)[NT]) {
    const bf16* ap = A + (size_t)(r0 + (lane & 15)) * K + 8 * (lane >> 4);
    const bf16* bp[NT];
#pragma unroll
    for (int t = 0; t < NT; ++t) bp[t] = Bt + (size_t)(nrow[t] + (lane & 15)) * K + 8 * (lane >> 4);
#pragma unroll 4
    for (int k = 0; k < K; k += 32) {
        const bf16x8 av = *(const bf16x8*)(ap + k);
#pragma unroll
        for (int t = 0; t < NT; ++t) { const bf16x8 bv = *(const bf16x8*)(bp[t] + k); acc[t] = __builtin_amdgcn_mfma_f32_16x16x32_bf16(av, bv, acc[t], 0, 0, 0); }
    }
}
__device__ __forceinline__ void sg_hgrn_in(const bf16* HN, const bf16* Wt, bf16* QB, float* GB, bf16* VB, bf16* GATE, const float* lbt, int gw, int NGW, int lane) {
    const bf16* A = HN + (size_t)MP * 1024;
    for (int tile = gw; tile < 8 * 256; tile += NGW) {
        const int mt = tile & 7, nt = tile >> 3; const int nrow[1] = {nt * 16}; f32x4 acc[1] = {{0.f, 0.f, 0.f, 0.f}};
        sg_tile<1>(A, mt * 16, Wt, nrow, 1024, lane, acc);
        const int col = nt * 16 + (lane & 15), type = col >> 10, c = col & 1023;
        const float llb = lbt[2 * c], l1p = lbt[2 * c + 1];
#pragma unroll
        for (int reg = 0; reg < 4; ++reg) {
            const size_t o = (size_t)(MP + mt * 16 + 4 * (lane >> 4) + reg) * 1024 + c; const float x = acc[0][reg];
            if (type == 0) QB[o] = (bf16)f2bf(pg8::silu_fast(x) * 0.08838834764831845f);
            else if (type == 1) GB[o] = pg8::logf_gate(x, llb, l1p);
            else if (type == 2) VB[o] = (bf16)f2bf(x);
            else GATE[o] = (bf16)f2bf(pg8::silu_fast(x));
        }
    }
}
__device__ __forceinline__ void sg_f32(const bf16* Abuf, int K, const bf16* Wt, int N, float* C, int ldc, int gw, int NGW, int lane) {
    const bf16* A = Abuf + (size_t)MP * K;
    for (int tile = gw; tile < 8 * (N / 16); tile += NGW) {
        const int mt = tile & 7, nt = tile >> 3; const int nrow[1] = {nt * 16}; f32x4 acc[1] = {{0.f, 0.f, 0.f, 0.f}};
        sg_tile<1>(A, mt * 16, Wt, nrow, K, lane, acc);
#pragma unroll
        for (int reg = 0; reg < 4; ++reg) C[(size_t)(MP + mt * 16 + 4 * (lane >> 4) + reg) * ldc + nt * 16 + (lane & 15)] = acc[0][reg];
    }
}
__device__ __forceinline__ void sg_swiglu(const bf16* HN, const bf16* Wt, bf16* ACT, int gw, int NGW, int lane) {
    const bf16* A = HN + (size_t)MP * 1024;
    for (int tile = gw; tile < 8 * (DFF / 16); tile += NGW) {
        const int mt = tile & 7, nt = tile >> 3, j0 = nt * 16; const int ng = 256 * (j0 >> 7) + (j0 & 127); const int nrow[2] = {ng, ng + 128};
        f32x4 acc[2] = {{0.f, 0.f, 0.f, 0.f}, {0.f, 0.f, 0.f, 0.f}};
        sg_tile<2>(A, mt * 16, Wt, nrow, 1024, lane, acc);
#pragma unroll
        for (int reg = 0; reg < 4; ++reg) ACT[(size_t)(MP + mt * 16 + 4 * (lane >> 4) + reg) * DFF + j0 + (lane & 15)] = (bf16)f2bf(pg8::silu_fast(acc[0][reg]) * acc[1][reg]);
    }
}
__device__ __forceinline__ void sg_uq(const bf16* QAN, const bf16* Wt, bf16* QN, bf16* QR, const float* CS, int gw, int NGW, int lane) {
    const bf16* A = QAN + (size_t)MP * QL;
    for (int tile = gw; tile < 8 * (1536 / 16); tile += NGW) {
        const int mt = tile & 7, nt = tile >> 3; const int nrow[1] = {nt * 16}; f32x4 acc[1] = {{0.f, 0.f, 0.f, 0.f}};
        sg_tile<1>(A, mt * 16, Wt, nrow, QL, lane, acc);
        const int col = nt * 16 + (lane & 15);
#pragma unroll
        for (int reg = 0; reg < 4; ++reg) {
            const int row = MP + mt * 16 + 4 * (lane >> 4) + reg; const float x = acc[0][reg]; const float partner = shx(x, 1, lane);
            if (col < 1024) QN[(size_t)row * 1024 + col] = (bf16)f2bf(x);
            else { const int rc = col - 1024, h = rc >> 6, ii = rc & 63, i = ii >> 1; const float cs = CS[(size_t)(2048 * 32 + i) * 2], sn = CS[(size_t)(2048 * 32 + i) * 2 + 1];
                float o; int ref;
                if ((ii & 1) == 0) { o = x * cs - partner * sn; ref = i; } else { o = x * cs + partner * sn; ref = 32 + i; }
                QR[(size_t)row * 512 + h * 64 + ref] = (bf16)f2bf(o); }
        }
    }
}

__device__ __forceinline__ int maprow(int kind, int j) {
    if (kind == 1) { if (j < DFF) return 256 * (j >> 7) + (j & 127); const int jj = j - DFF; return 256 * (jj >> 7) + 128 + (jj & 127); }
    if (kind == 2) return 384 + j;
    if (kind == 3) { const int h = j / 192, n = j - h * 192; if (n < 128) return h * 128 + n; const int i = n - 128; return 1024 + h * 64 + (i < 32 ? 2 * i : 2 * (i - 32) + 1); }
    if (kind == 4) { const int h = j >> 8, n = j & 255; return n < 128 ? h * 128 + n : 1024 + h * 128 + (n - 128); }
    return j;
}
__device__ __forceinline__ void cvt_item(const float* W, int K, int N, bf16* WT, int kind, const float* gain, float scale, LAS float* scr, int item, int lane) {
    const int nblk = N / 32, kb = item / nblk, nb = item - kb * nblk, k0 = 64 * kb, n0 = 32 * nb;
#pragma unroll 8
    for (int i = 0; i < 32; ++i) { const int kk = 2 * i + (lane >> 5); const float g = gain ? gain[k0 + kk] * scale : scale;
        scr[kk * 33 + (lane & 31)] = W[(size_t)(k0 + kk) * N + n0 + (lane & 31)] * g; }
    LDS_WAIT(); asm volatile("" ::: "memory");
    const int c = lane & 7;
#pragma unroll
    for (int j = 0; j < 4; ++j) { const int n = (lane >> 3) + 8 * j; const LAS float* s = scr + (8 * c) * 33 + n;
        v4u o; o.x = pk2(s[0 * 33], s[1 * 33]); o.y = pk2(s[2 * 33], s[3 * 33]); o.z = pk2(s[4 * 33], s[5 * 33]); o.w = pk2(s[6 * 33], s[7 * 33]);
        *(v4u*)(WT + (size_t)maprow(kind, n0 + n) * K + k0 + 8 * c) = o; }
    LDS_WAIT(); asm volatile("" ::: "memory");
}
__device__ __forceinline__ void row_resid_norm(const float* mix, float* X, const float* gain, bf16* HN, int lane) {
    const f32x4* mr = (const f32x4*)mix + lane; f32x4* xr = (f32x4*)X + lane; const f32x4* gr = (const f32x4*)gain + lane;
    f32x4 v[4]; float s = 0.f;
#pragma unroll
    for (int j = 0; j < 4; ++j) { v[j] = mr[64 * j]; s += (v[j][0] * v[j][0] + v[j][1] * v[j][1]) + (v[j][2] * v[j][2] + v[j][3] * v[j][3]); }
    const float r = rsqrtf(wave_sum(s) * (1.f / 1024.f) + EPS); float s2 = 0.f;
#pragma unroll
    for (int j = 0; j < 4; ++j) { const f32x4 x = xr[64 * j] + v[j] * r * gr[64 * j]; xr[64 * j] = x; v[j] = x; s2 += (x[0] * x[0] + x[1] * x[1]) + (x[2] * x[2] + x[3] * x[3]); }
    const float r2 = rsqrtf(wave_sum(s2) * (1.f / 1024.f) + EPS);
    v2u* o8 = (v2u*)HN + lane;
#pragma unroll
    for (int j = 0; j < 4; ++j) { v2u w; w.x = pk2(v[j][0] * r2, v[j][1] * r2); w.y = pk2(v[j][2] * r2, v[j][3] * r2); o8[64 * j] = w; }
}
__device__ __forceinline__ void hgrn_naive_phase(const bf16* QB, const float* GB, const bf16* VB, const bf16* GATE, const float* gnorm, const float* s0, float* st_p, float* st_s, bf16* OG,
                                                 LAS unsigned char* lds, int wg, int G, int tid) {
    LAS float* sq = (LAS float*)lds; LAS float* sf = sq + 128; LAS float* sk = sf + 128; LAS float* red = sk + 128;
    const int dv = tid & 127; const bool active = tid < 128;
    for (int unit = wg; unit < 64 + DB * HA; unit += G) {
        const bool prompt = unit < 64; const int uu = prompt ? unit : unit - 64; const int seq = uu >> 3, h = uu & 7;
        const int T = prompt ? SEQ : 1; const int row0 = prompt ? seq * SEQ : MP + seq;
        const size_t sb = ((size_t)seq * HA + h) * DK * DV;
        float S[128];
#pragma unroll
        for (int k = 0; k < 128; ++k) S[k] = (!prompt && active) ? s0[sb + (size_t)k * DV + dv] : 0.f;
        for (int t = 0; t < T; ++t) {
            const size_t o = (size_t)(row0 + t) * 1024 + h * 128 + dv;
            __syncthreads();
            float v = 0.f;
            if (active) { sq[dv] = bf2f(QB[o]); const float lf = GB[o]; sf[dv] = expf(lf); sk[dv] = -expm1f(lf); v = bf2f(VB[o]); }
            __syncthreads();
            float ov = 0.f;
            if (active) {
#pragma unroll
                for (int k = 0; k < 128; ++k) { S[k] = sf[k] * S[k] + sk[k] * v; ov += sq[k] * S[k]; }
            }
            const float ss = wave_sum(ov * ov);
            if (active && (tid & 63) == 0) red[tid >> 6] = ss;
            __syncthreads();
            if (active) { const float r = rsqrtf((red[0] + red[1]) * (1.f / 128.f) + EPS); OG[o] = (bf16)f2bf(ov * r * gnorm[h * 128 + dv] * bf2f(GATE[o])); }
        }
        if (active) { float* so = (prompt ? st_p : st_s) + sb;
#pragma unroll
            for (int k = 0; k < 128; ++k) so[(size_t)k * DV + dv] = S[k]; }
    }
}
__device__ __forceinline__ void attn_naive_phase(const bf16* QN, const bf16* QR, const bf16* KN, const bf16* KRB, const bf16* VV, bf16* O, LAS unsigned char* lds, int wg, int G, int tid) {
    LAS float* sc = (LAS float*)lds;
    LAS float* red = sc + SEQ;
    LAS float* part = red + 16;
    const int g16 = tid >> 4, l16 = tid & 15, wave = tid >> 6;
    for (int unit = wg; unit < BATCH * 8 * SEQ; unit += G) {
        const int t = unit & (SEQ - 1), h = (unit >> 11) & 7, b = unit >> 14; const size_t row = (size_t)b * SEQ + t;
        const v4u qa = *(const v4u*)(QN + row * 1024 + h * 128 + 8 * l16); const v2u qb = *(const v2u*)(QR + row * 512 + h * 64 + 4 * l16);
        float qf[12];
        qf[0] = bf2f(qa.x & 0xffff); qf[1] = bf2f(qa.x >> 16); qf[2] = bf2f(qa.y & 0xffff); qf[3] = bf2f(qa.y >> 16); qf[4] = bf2f(qa.z & 0xffff); qf[5] = bf2f(qa.z >> 16); qf[6] = bf2f(qa.w & 0xffff); qf[7] = bf2f(qa.w >> 16);
        qf[8] = bf2f(qb.x & 0xffff); qf[9] = bf2f(qb.x >> 16); qf[10] = bf2f(qb.y & 0xffff); qf[11] = bf2f(qb.y >> 16);
        __syncthreads();
        float mx = -1e30f;
        for (int s = g16; s <= t; s += 32) {
            const size_t kr = (size_t)b * SEQ + s;
            const v4u ka = *(const v4u*)(KN + kr * 1024 + h * 128 + 8 * l16); const v2u kb = *(const v2u*)(KRB + kr * 64 + 4 * l16);
            float d = qf[0] * bf2f(ka.x & 0xffff) + qf[1] * bf2f(ka.x >> 16) + qf[2] * bf2f(ka.y & 0xffff) + qf[3] * bf2f(ka.y >> 16) + qf[4] * bf2f(ka.z & 0xffff) + qf[5] * bf2f(ka.z >> 16) + qf[6] * bf2f(ka.w & 0xffff) + qf[7] * bf2f(ka.w >> 16)
                    + qf[8] * bf2f(kb.x & 0xffff) + qf[9] * bf2f(kb.x >> 16) + qf[10] * bf2f(kb.y & 0xffff) + qf[11] * bf2f(kb.y >> 16);
            { const int ln = tid & 63; d += shx(d, 1, ln); d += shx(d, 2, ln); d += shx(d, 4, ln); d += shx(d, 8, ln); }
            if (l16 == 0) sc[s] = d;
            mx = fmaxf(mx, d);
        }
        mx = wave_max(mx);
        if ((tid & 63) == 0) red[wave] = mx;
        __syncthreads();
        mx = fmaxf(fmaxf(fmaxf(red[0], red[1]), fmaxf(red[2], red[3])), fmaxf(fmaxf(red[4], red[5]), fmaxf(red[6], red[7])));
        float sum = 0.f;
        for (int s = tid; s <= t; s += NTHR) { const float p = exp2f(sc[s] - mx); sc[s] = p; sum += p; }
        sum = wave_sum(sum);
        if ((tid & 63) == 0) red[8 + wave] = sum;
        __syncthreads();
        sum = ((red[8] + red[9]) + (red[10] + red[11])) + ((red[12] + red[13]) + (red[14] + red[15]));
        const int d = tid & 127, pt = tid >> 7;
        float o = 0.f;
        for (int s = pt; s <= t; s += 4) o += sc[s] * bf2f(VV[((size_t)b * SEQ + s) * 1024 + h * 128 + d]);
        part[pt * 128 + d] = o;
        __syncthreads();
        if (pt == 0) O[row * 1024 + h * 128 + d] = (bf16)f2bf(((part[d] + part[128 + d]) + (part[256 + d] + part[384 + d])) / sum);
    }
}
__device__ __forceinline__ void decode_naive_phase(const bf16* QN, const bf16* QR, const bf16* WUKVN, const bf16* WUKV, const float* cache_c, const float* cache_kr, const int* page_table,
                                                   const float* c_s, const float* kr_s, float* SC, bf16* O, LAS unsigned char* lds, int wg, int G, int tid) {
    LAS float* ql = (LAS float*)lds;
    LAS float* qr = ql + 8 * 256;
    LAS float* red = qr + 8 * 64;
    LAS float* smx = red + 64;
    LAS float* ssum = smx + 8;
    LAS float* part = ssum + 8;
    const int lane = tid & 63, wave = tid >> 6;
    for (int b = wg; b < DB; b += G) {
        const size_t row = (size_t)MP + b;
        __syncthreads();
        { const int c = tid & 255, hh = tid >> 8;
            for (int h = hh * 4; h < hh * 4 + 4; ++h) { float a = 0.f;
                for (int n = 0; n < 128; ++n) a += bf2f(QN[row * 1024 + h * 128 + n]) * bf2f(WUKVN[(size_t)c * 2048 + h * 256 + n]);
                ql[h * 256 + c] = a; } }
        qr[tid] = bf2f(QR[row * 512 + tid]);
        __syncthreads();
        float* sc = SC + (size_t)b * 8 * SCP;
        float mx[8];
#pragma unroll
        for (int h = 0; h < 8; ++h) mx[h] = -1e30f;
        for (int s = wave; s <= PAST; s += NWAVES) {
            const float* cp; const float* kp;
            if (s < PAST) { const int pg = page_table[b * NPAGES + (s >> 7)]; cp = cache_c + ((size_t)pg * PAGE + (s & 127)) * 256; kp = cache_kr + ((size_t)pg * PAGE + (s & 127)) * 64; }
            else { cp = c_s + (size_t)b * 256; kp = kr_s + (size_t)b * 64; }
            const f32x4 cv = *(const f32x4*)(cp + 4 * lane); const float kv = kp[lane];
#pragma unroll
            for (int h = 0; h < 8; ++h) {
                const f32x4 q4 = *(const LAS f32x4*)(ql + h * 256 + 4 * lane);
                float d = (q4[0] * cv[0] + q4[1] * cv[1]) + (q4[2] * cv[2] + q4[3] * cv[3]) + qr[h * 64 + lane] * kv;
                d = wave_sum(d);
                if (lane == 0) sc[(size_t)h * SCP + s] = d;
                mx[h] = fmaxf(mx[h], d);
            }
        }
#pragma unroll
        for (int h = 0; h < 8; ++h) if (lane == 0) red[h * 8 + wave] = mx[h];
        asm volatile("s_waitcnt vmcnt(0)" ::: "memory");
        __syncthreads();
        if (tid < 8) { float m = red[tid * 8]; for (int w = 1; w < 8; ++w) m = fmaxf(m, red[tid * 8 + w]); smx[tid] = m; }
        __syncthreads();
#pragma unroll
        for (int h = 0; h < 8; ++h) {
            float sum = 0.f; const float m = smx[h];
            for (int s = tid; s <= PAST; s += NTHR) { const float p = exp2f(sc[(size_t)h * SCP + s] - m); sc[(size_t)h * SCP + s] = p; sum += p; }
            sum = wave_sum(sum);
            if (lane == 0) red[h * 8 + wave] = sum;
        }
        asm volatile("s_waitcnt vmcnt(0)" ::: "memory");
        __syncthreads();
        if (tid < 8) { float m = 0.f; for (int w = 0; w < 8; ++w) m += red[tid * 8 + w]; ssum[tid] = m; }
        __syncthreads();
        { const int c = tid & 255, pt = tid >> 8;
            float a[8];
#pragma unroll
            for (int h = 0; h < 8; ++h) a[h] = 0.f;
            for (int s = pt; s <= PAST; s += 2) {
                float cv;
                if (s < PAST) { const int pg = page_table[b * NPAGES + (s >> 7)]; cv = cache_c[((size_t)pg * PAGE + (s & 127)) * 256 + c]; }
                else cv = c_s[(size_t)b * 256 + c];
#pragma unroll
                for (int h = 0; h < 8; ++h) a[h] += sc[(size_t)h * SCP + s] * cv;
            }
#pragma unroll
            for (int h = 0; h < 8; ++h) part[(pt * 8 + h) * 256 + c] = a[h];
        }
        __syncthreads();
        for (int i = tid; i < 8 * 256; i += NTHR) { const int h = i >> 8; ql[i] = (part[i] + part[8 * 256 + i]) / ssum[h]; }
        __syncthreads();
        for (int idx = tid; idx < 1024; idx += NTHR) {
            const int h = idx >> 7; const bf16* w = WUKV + (size_t)(1024 + idx) * 256; float a = 0.f;
            for (int c = 0; c < 256; ++c) a += ql[h * 256 + c] * bf2f(w[c]);
            O[row * 1024 + idx] = (bf16)f2bf(a);
        }
    }
}
typedef float f32x16 __attribute__((ext_vector_type(16)));
__device__ __forceinline__ void attn_prompt_phase(const bf16* QN, const bf16* QR, const bf16* KN, const bf16* KRB, const bf16* VT, bf16* O, LAS unsigned char* lds, int wg, int G, int tid) {
    constexpr int KP = 400, VP = 136, KTB = 64 * KP, VTB = 128 * VP, BUFB = KTB + VTB;
    const int lane = tid & 63, wave = __builtin_amdgcn_readfirstlane(tid >> 6), r32 = lane & 31, hh = lane >> 5;
    const int c0 = tid, c1 = tid + 512;
    for (int unit = wg; unit < 256; unit += G) {
        const int bh = unit >> 2, pr = unit & 3, b = bh >> 3, h = bh & 7;
        for (int half = 0; half < 2; ++half) {
            const int qb = half ? 7 - pr : pr; const int ntiles = 4 * (qb + 1); const int q0 = 256 * qb + 32 * wave;
            const size_t qrow = (size_t)b * SEQ + q0 + r32;
            bf16x8 Qf[12];
#pragma unroll
            for (int ks = 0; ks < 8; ++ks) Qf[ks] = *(const bf16x8*)(QN + qrow * 1024 + h * 128 + 16 * ks + 8 * hh);
#pragma unroll
            for (int ks = 0; ks < 4; ++ks) Qf[8 + ks] = *(const bf16x8*)(QR + qrow * 512 + h * 64 + 16 * ks + 8 * hh);
            f32x16 Oa[4];
#pragma unroll
            for (int nb = 0; nb < 4; ++nb)
#pragma unroll
                for (int i = 0; i < 16; ++i) Oa[nb][i] = 0.f;
            float m = -1e30f, l = 0.f;
            v4u sk0, sk1, skr, sv0, sv1;
#define ATT_LOAD(kt) do { const size_t key0 = (size_t)b * SEQ + 64 * (kt); \
                sk0 = *(const v4u*)(KN + (key0 + (c0 >> 4)) * 1024 + h * 128 + (c0 & 15) * 8); sk1 = *(const v4u*)(KN + (key0 + (c1 >> 4)) * 1024 + h * 128 + (c1 & 15) * 8); \
                skr = *(const v4u*)(KRB + (key0 + (tid >> 3)) * 64 + (tid & 7) * 8); \
                sv0 = *(const v4u*)(VT + (size_t)(h * 128 + (c0 >> 3)) * MP + key0 + (c0 & 7) * 8); sv1 = *(const v4u*)(VT + (size_t)(h * 128 + (c1 >> 3)) * MP + key0 + (c1 & 7) * 8); } while (0)
#define ATT_WRITE(bi) do { LAS unsigned char* base = lds + (bi) * BUFB; \
                *(LAS v4u*)(base + (c0 >> 4) * KP + (c0 & 15) * 16) = sk0; *(LAS v4u*)(base + (c1 >> 4) * KP + (c1 & 15) * 16) = sk1; *(LAS v4u*)(base + (tid >> 3) * KP + 256 + (tid & 7) * 16) = skr; \
                { LAS v2u* p = (LAS v2u*)(base + KTB + (c0 >> 3) * VP + (c0 & 7) * 16); p[0] = (v2u){sv0.x, sv0.y}; p[1] = (v2u){sv0.z, sv0.w}; } \
                { LAS v2u* p = (LAS v2u*)(base + KTB + (c1 >> 3) * VP + (c1 & 7) * 16); p[0] = (v2u){sv1.x, sv1.y}; p[1] = (v2u){sv1.z, sv1.w}; } } while (0)
            ATT_LOAD(0); ATT_WRITE(0);
            __syncthreads();
            for (int kt = 0; kt < ntiles; ++kt) {
                if (kt + 1 < ntiles) ATT_LOAD(kt + 1);
                if (64 * kt <= q0 + 31) {
                    const LAS unsigned char* kb_ = lds + (kt & 1) * BUFB; const LAS unsigned char* vb_ = kb_ + KTB;
                    for (int kb = 0; kb < 2; ++kb) {
                        if (64 * kt + 32 * kb > q0 + 31) break;
                        f32x16 X;
#pragma unroll
                        for (int i = 0; i < 16; ++i) X[i] = 0.f;
                        const LAS unsigned char* kp = kb_ + (32 * kb + r32) * KP + hh * 16;
#pragma unroll
                        for (int ks = 0; ks < 12; ++ks) {
                            const bf16x8 kf = *(const LAS bf16x8*)(kp + ks * 32);
                            X = __builtin_amdgcn_mfma_f32_32x32x16_bf16(kf, Qf[ks], X, 0, 0, 0);
                            if ((ks & 3) == 3) asm volatile("" ::: "memory");
                        }
                        if (64 * kt + 32 * kb + 31 > q0) {
                            const int qi = q0 + r32, kbase = 64 * kt + 32 * kb + 4 * hh;
#pragma unroll
                            for (int i = 0; i < 16; ++i) { const int kr = kbase + (i & 3) + 8 * (i >> 2); if (kr > qi) X[i] = -1e30f; }
                        }
                        float mx = X[0];
#pragma unroll
                        for (int i = 1; i < 16; ++i) mx = fmaxf(mx, X[i]);
                        mx = fmaxf(mx, shx(mx, 32, lane));
                        const float mn = fmaxf(m, mx), alpha = __builtin_amdgcn_exp2f(m - mn); m = mn;
                        float ls = 0.f;
#pragma unroll
                        for (int i = 0; i < 16; ++i) { X[i] = __builtin_amdgcn_exp2f(X[i] - mn); ls += X[i]; }
                        l = l * alpha + ls;
                        if (__any(alpha != 1.0f)) {
#pragma unroll
                            for (int nb = 0; nb < 4; ++nb)
#pragma unroll
                                for (int i = 0; i < 16; ++i) Oa[nb][i] *= alpha;
                        }
                        bf16x8 Pf[2];
#pragma unroll
                        for (int s = 0; s < 2; ++s) {
                            v4u w0;
                            w0.x = pg8::cvt_pk_bf16(X[8 * s + 0], X[8 * s + 1]); w0.y = pg8::cvt_pk_bf16(X[8 * s + 2], X[8 * s + 3]); w0.z = pg8::cvt_pk_bf16(X[8 * s + 4], X[8 * s + 5]); w0.w = pg8::cvt_pk_bf16(X[8 * s + 6], X[8 * s + 7]);
                            Pf[s] = __builtin_bit_cast(bf16x8, w0);
                        }
                        const LAS unsigned char* vp0 = vb_ + r32 * VP + (32 * kb + 4 * hh) * 2;
#pragma unroll
                        for (int nb = 0; nb < 4; ++nb) {
#pragma unroll
                            for (int s = 0; s < 2; ++s) {
                                const LAS unsigned char* vp = vp0 + 32 * nb * VP + 32 * s;
                                const v2u a0 = *(const LAS v2u*)vp, a1 = *(const LAS v2u*)(vp + 16);
                                const v4u av = (v4u){a0.x, a0.y, a1.x, a1.y};
                                Oa[nb] = __builtin_amdgcn_mfma_f32_32x32x16_bf16(__builtin_bit_cast(bf16x8, av), Pf[s], Oa[nb], 0, 0, 0);
                            }
                            if (nb & 1) asm volatile("" ::: "memory");
                        }
                    }
                }
                if (kt + 1 < ntiles) ATT_WRITE((kt + 1) & 1);
                __syncthreads();
            }
#undef ATT_LOAD
#undef ATT_WRITE
            l += shx(l, 32, lane);
            const float inv = 1.0f / l;
            bf16* orow = O + qrow * 1024 + h * 128;
#pragma unroll
            for (int nb = 0; nb < 4; ++nb)
#pragma unroll
                for (int g = 0; g < 4; ++g) {
                    v2u w; w.x = pk2(Oa[nb][4 * g + 0] * inv, Oa[nb][4 * g + 1] * inv); w.y = pk2(Oa[nb][4 * g + 2] * inv, Oa[nb][4 * g + 3] * inv);
                    *(v2u*)(orow + 32 * nb + 8 * g + 4 * hh) = w;
                }
        }
    }
}
constexpr int NPH = 1 + 4 * 10;
__host__ __device__ constexpr bool phase_exists(int k) {
    if (k == 0) return true;
    const int l = (k - 1) / 10, s = (k - 1) % 10;
    if (l < 2) return !(s == 2 || s == 3 || s == 4);
    return s != 3 || l == 2;
}
struct Args { const float* in[21]; float* out; unsigned char* ws; int ph_lo, ph_hi, li, pad; };


__device__ __forceinline__ unsigned long long karg64(int byte_off) {
    unsigned long long v;
    asm volatile("s_load_dwordx2 %0, %1, %2\n\ts_waitcnt lgkmcnt(0)" : "=s"(v) : "s"(__builtin_amdgcn_kernarg_segment_ptr()), "i"(byte_off) : "memory");
    return v;
}
__device__ __forceinline__ int karg32(int byte_off) {
    int v;
    asm volatile("s_load_dword %0, %1, %2\n\ts_waitcnt lgkmcnt(0)" : "=s"(v) : "s"(__builtin_amdgcn_kernarg_segment_ptr()), "i"(byte_off) : "memory");
    return v;
}
#define ARG_IN(i) ((const float*)karg64(8 * (i)))
#define ARG_OUT() ((float*)karg64(8 * 21))
#define ARG_WS() ((unsigned char*)karg64(8 * 22))
struct Ctx { LAS unsigned char* lds; int tid, lane, wave, wg, G, gw, NGW; };
__device__ __forceinline__ Ctx fresh(const Ctx& c0) {
    Ctx c; c.lds = c0.lds; int wv = c0.wave; asm volatile("" : "+s"(wv)); int t = wv * 64 + lane_id_v(); int w = blockIdx.x; asm volatile("" : "+s"(w)); int g = gridDim.x; asm volatile("" : "+s"(g));
    c.tid = t; c.lane = t & 63; c.wave = __builtin_amdgcn_readfirstlane(t >> 6); c.wg = w; c.G = g; c.gw = w * NWAVES + c.wave; c.NGW = g * NWAVES; return c;
}

__device__ __forceinline__ void ph_prologue(const Ctx& c0) {
    const Ctx c = fresh(c0);
    unsigned char* ws = ARG_WS();
    const float* norm_gains = ARG_IN(6);
    LAS float* scr = (LAS float*)(c.lds + c.wave * 16384);
    constexpr int NITEMS = 4096 + 1024 + 11264 + 5632 + 192 + 160 + 192 + 576 + 256 + 1024;
    for (int it = c.gw; it < NITEMS; it += c.NGW) {
        int r = it, l; const float* W; int K, N, kind = 0; bf16* WT; const float* gain = nullptr; float scale = 1.f;
        if (r < 4096) { l = r / 2048; r -= l * 2048; W = ARG_IN(9) + (size_t)l * 1024 * 4096; K = 1024; N = 4096; WT = (bf16*)(ws + WS_WIN) + (size_t)l * 4096 * 1024; gain = norm_gains + (l * 4 + 0) * 1024; }
        else if ((r -= 4096) < 1024) { l = r / 512; r -= l * 512; W = ARG_IN(12) + (size_t)l * 1024 * 1024; K = 1024; N = 1024; WT = (bf16*)(ws + WS_WOUTA) + (size_t)l * 1024 * 1024; }
        else if ((r -= 1024) < 11264) { l = r / 2816; r -= l * 2816; W = ARG_IN(7) + (size_t)l * 1024 * 5632; K = 1024; N = 5632; WT = (bf16*)(ws + WS_WFIN) + (size_t)l * 5632 * 1024; kind = 1; gain = norm_gains + (l * 4 + 2) * 1024; }
        else if ((r -= 11264) < 5632) { l = r / 1408; r -= l * 1408; W = ARG_IN(8) + (size_t)l * 2816 * 1024; K = 2816; N = 1024; WT = (bf16*)(ws + WS_WFOUT) + (size_t)l * 1024 * 2816; }
        else if ((r -= 5632) < 192) { W = ARG_IN(17); K = 1024; N = 384; WT = (bf16*)(ws + WS_WDQ0); gain = norm_gains + (2 * 4 + 0) * 1024; }
        else if ((r -= 192) < 160) { W = ARG_IN(14); K = 1024; N = 320; WT = (bf16*)(ws + WS_WDQ0); kind = 2; gain = ARG_IN(13); }
        else if ((r -= 160) < 192) { W = ARG_IN(17) + (size_t)1024 * 384; K = 1024; N = 384; WT = (bf16*)(ws + WS_WDQ1); gain = norm_gains + (3 * 4 + 0) * 1024; }
        else if ((r -= 192) < 576) { l = r / 288; r -= l * 288; W = ARG_IN(19) + (size_t)l * 384 * 1536; K = 384; N = 1536; WT = (bf16*)(ws + WS_WUQ) + (size_t)l * 1536 * 384; kind = 3; gain = ARG_IN(18) + l * 384; scale = QSCALE; }
        else if ((r -= 576) < 256) { W = ARG_IN(16); K = 256; N = 2048; WT = (bf16*)(ws + WS_WUKV); kind = 4; }
        else { r -= 256; l = r / 512; r -= l * 512; W = ARG_IN(20) + (size_t)l * 1024 * 1024; K = 1024; N = 1024; WT = (bf16*)(ws + WS_WOUTB) + (size_t)l * 1024 * 1024; }
        cvt_item(W, K, N, WT, kind, gain, scale, scr, r, c.lane);
    }
    const size_t gt = (size_t)c.wg * NTHR + c.tid, NT = (size_t)c.G * NTHR;
    { bf16* WDQ0 = (bf16*)(ws + WS_WDQ0); bf16* WDQ1 = (bf16*)(ws + WS_WDQ1);
      for (size_t i = gt; i < (size_t)64 * 1024 / 8; i += NT) ((v4u*)(WDQ0 + (size_t)704 * 1024))[i] = (v4u){0u, 0u, 0u, 0u};
      for (size_t i = gt; i < (size_t)128 * 1024 / 8; i += NT) ((v4u*)(WDQ1 + (size_t)384 * 1024))[i] = (v4u){0u, 0u, 0u, 0u}; }
    { const float* w_ukv = ARG_IN(16); bf16* WUKVN = (bf16*)(ws + WS_WUKVN);
      for (size_t i = gt; i < (size_t)256 * 2048 / 4; i += NT) { const f32x4 v = ((const f32x4*)w_ukv)[i]; v2u w; w.x = pk2(v[0], v[1]); w.y = pk2(v[2], v[3]); ((v2u*)WUKVN)[i] = w; } }
    { float* CS = (float*)(ws + WS_CS);
      for (size_t i = gt; i < (size_t)2049 * 32; i += NT) { const int p = (int)(i >> 5), fi = (int)(i & 31); const double pos = p < 2048 ? (double)p : (double)PAST;
        const double ang = pos * pow(10000.0, -(double)fi / 32.0); CS[2 * i] = (float)cos(ang); CS[2 * i + 1] = (float)sin(ang); } }
    { float* LBT = (float*)(ws + WS_LBT); const float* lb_logits = ARG_IN(10);
      for (size_t i = gt; i < 2048; i += NT) { const int l = (int)(i >> 10), d = (int)(i & 1023); float lb = 0.f;
        if (l == 1) lb = 1.f / (1.f + expf(lb_logits[d] - lb_logits[1024 + d]));
        LBT[2 * i] = logf(fmaxf(lb, 1e-30f)); LBT[2 * i + 1] = log1pf(-lb); } }
    { const float* x_prompt = ARG_IN(0); const float* x_sample = ARG_IN(1); float* X = ARG_OUT(); bf16* HN = (bf16*)(ws + WS_HN);
      for (int m = c.gw; m < M; m += c.NGW) {
        const f32x4* xr = (const f32x4*)(m < MP ? x_prompt + (size_t)m * D : x_sample + (size_t)(m - MP) * D) + c.lane; f32x4* xo = (f32x4*)(X + (size_t)m * D) + c.lane;
        f32x4 v[4]; float s = 0.f;
#pragma unroll
        for (int j = 0; j < 4; ++j) { v[j] = xr[64 * j]; xo[64 * j] = v[j]; s += (v[j][0] * v[j][0] + v[j][1] * v[j][1]) + (v[j][2] * v[j][2] + v[j][3] * v[j][3]); }
        const float r = rsqrtf(wave_sum(s) * (1.f / 1024.f) + EPS);
        v2u* o8 = (v2u*)(HN + (size_t)m * D) + c.lane;
#pragma unroll
        for (int j = 0; j < 4; ++j) { v2u w; w.x = pk2(v[j][0] * r, v[j][1] * r); w.y = pk2(v[j][2] * r, v[j][3] * r); o8[64 * j] = w; }
      } }
}
__device__ __forceinline__ void ph_hgrn_in(const Ctx& c0, int l) {
    const Ctx c = fresh(c0);
    unsigned char* ws = ARG_WS();
    const bf16* HN = (const bf16*)(ws + WS_HN); const bf16* Wt = (const bf16*)(ws + WS_WIN) + (size_t)l * 4096 * 1024; const float* lbt = (const float*)(ws + WS_LBT) + (size_t)l * 2048;
    bf16* QB = (bf16*)(ws + WS_QB); float* GB = (float*)(ws + WS_GB); bf16* VB = (bf16*)(ws + WS_VB); bf16* GATE = (bf16*)(ws + WS_GATE);
    pg8::Gemm g{HN, Wt, MP, 4096, 1024}; pg8::StaticOrder S; S.init(MP, 4096, c.G, c.wg);
    pg8::EpiHgrnIn E{ws, l};
    pg8::gemm_phase<pg8::EpiHgrnIn, pg8::StaticOrder, true, true>(c.lds, g, S, E, c.tid);
    const Ctx c2 = fresh(c0);
    sg_hgrn_in(HN, Wt, QB, GB, VB, GATE, lbt, c2.gw, c2.NGW, c2.lane);
}
__device__ __forceinline__ void ph_hgrn_rec(const Ctx& c0, int l) {
    const Ctx c = fresh(c0);
    unsigned char* ws = ARG_WS(); float* X = ARG_OUT();
    float* st_p = X + (size_t)M * D; float* st_s = st_p + (size_t)2 * BATCH * HA * DK * DV + (size_t)MP * KVL + (size_t)MP * 64;
    hgrn_naive_phase((const bf16*)(ws + WS_QB), (const float*)(ws + WS_GB), (const bf16*)(ws + WS_VB), (const bf16*)(ws + WS_GATE), ARG_IN(11) + (size_t)l * D, ARG_IN(2) + (size_t)l * DB * HA * DK * DV,
                     st_p + (size_t)l * BATCH * HA * DK * DV, st_s + (size_t)l * DB * HA * DK * DV, (bf16*)(ws + WS_OG), c.lds, c.wg, c.G, c.tid);
}
__device__ __forceinline__ void ph_dq(const Ctx& c0, int j) {
    const Ctx c = fresh(c0);
    unsigned char* ws = ARG_WS();
    const int N = (j == 0) ? 768 : 512; const bf16* Wt = (const bf16*)(ws + ((j == 0) ? WS_WDQ0 : WS_WDQ1)); const bf16* HN = (const bf16*)(ws + WS_HN); float* QC = (float*)(ws + WS_QC);
    pg8::Gemm g{HN, Wt, MP, N, 1024}; pg8::StaticOrder S; S.init(MP, N, c.G, c.wg);
    pg8::EpiF32 E{QC, QCP};
    pg8::gemm_phase<pg8::EpiF32, pg8::StaticOrder, true, true>(c.lds, g, S, E, c.tid);
    const Ctx c2 = fresh(c0);
    sg_f32(HN, 1024, Wt, N, QC, QCP, c2.gw, c2.NGW, c2.lane);
}
__device__ __forceinline__ void ph_qnorm(const Ctx& c0, int j) {
    const Ctx c = fresh(c0);
    unsigned char* ws = ARG_WS(); float* X = ARG_OUT();
    float* c_p = X + (size_t)M * D + (size_t)2 * BATCH * HA * DK * DV; float* kr_p = c_p + (size_t)MP * KVL; float* c_s = kr_p + (size_t)MP * 64 + (size_t)2 * DB * HA * DK * DV; float* kr_s = c_s + (size_t)DB * KVL;
    const float* QC = (const float*)(ws + WS_QC); bf16* QAN = (bf16*)(ws + WS_QAN); bf16* CB = (bf16*)(ws + WS_CB); bf16* KRB = (bf16*)(ws + WS_KRB); const float* CS = (const float*)(ws + WS_CS);
    const float* kv_a_norm = ARG_IN(15); const int lane = c.lane;
    for (int m = c.gw; m < M; m += c.NGW) {
        const float* qc = QC + (size_t)m * QCP;
        float v[6]; float s = 0.f;
#pragma unroll
        for (int i = 0; i < 6; ++i) { v[i] = qc[lane + 64 * i]; s += v[i] * v[i]; }
        const float r = rsqrtf(wave_sum(s) * (1.f / 384.f) + EPS);
#pragma unroll
        for (int i = 0; i < 6; ++i) QAN[(size_t)m * QL + lane + 64 * i] = (bf16)f2bf(v[i] * r);
        if (j == 0) {
            float cc[4]; float s2 = 0.f;
#pragma unroll
            for (int i = 0; i < 4; ++i) { cc[i] = qc[384 + lane + 64 * i]; s2 += cc[i] * cc[i]; }
            const float r2 = rsqrtf(wave_sum(s2) * (1.f / 256.f) + EPS);
            float* co = m < MP ? c_p + (size_t)m * KVL : c_s + (size_t)(m - MP) * KVL;
#pragma unroll
            for (int i = 0; i < 4; ++i) { const float o = cc[i] * r2 * kv_a_norm[lane + 64 * i]; co[lane + 64 * i] = o; CB[(size_t)m * KVL + lane + 64 * i] = (bf16)f2bf(o); }
            if (lane < 32) {
                const float x1 = qc[640 + lane], x2 = qc[672 + lane]; const int p = m < MP ? (m & (SEQ - 1)) : 2048;
                const float cs = CS[(size_t)(p * 32 + lane) * 2], sn = CS[(size_t)(p * 32 + lane) * 2 + 1];
                const float o1 = x1 * cs - x2 * sn, o2 = x2 * cs + x1 * sn;
                float* ko = m < MP ? kr_p + (size_t)m * 64 : kr_s + (size_t)(m - MP) * 64;
                ko[lane] = o1; ko[32 + lane] = o2;
                if (m < MP) ((unsigned*)(KRB + (size_t)m * 64))[lane] = pk2(o1, o2);
            }
        }
    }
}
__device__ __forceinline__ void ph_uq(const Ctx& c0, int j) {
    const Ctx c = fresh(c0);
    unsigned char* ws = ARG_WS();
    const bf16* QAN = (const bf16*)(ws + WS_QAN); const bf16* Wt = (const bf16*)(ws + WS_WUQ) + (size_t)j * 1536 * 384; bf16* QN = (bf16*)(ws + WS_QN); bf16* QR = (bf16*)(ws + WS_QR); const float* CS = (const float*)(ws + WS_CS);
    { pg8::Gemm g{QAN, Wt, MP, 1024, QL}; pg8::StaticOrder S; S.init(MP, 1024, c.G, c.wg);
      pg8::EpiBf16Split E{QN, 1024, 0, 0};
      pg8::gemm_phase<pg8::EpiBf16Split, pg8::StaticOrder, true, true>(c.lds, g, S, E, c.tid); }
    { const Ctx c1 = fresh(c0);
      pg8::Gemm g{QAN, Wt + (size_t)1024 * QL, MP, 512, QL}; pg8::StaticOrder S; S.init(MP, 512, c1.G, c1.wg);
      pg8::EpiRope E{ws};
      pg8::gemm_phase<pg8::EpiRope, pg8::StaticOrder, true, true>(c1.lds, g, S, E, c1.tid); }
    const Ctx c2 = fresh(c0);
    sg_uq(QAN, Wt, QN, QR, CS, c2.gw, c2.NGW, c2.lane);
}
__device__ __forceinline__ void ph_kvup(const Ctx& c0) {
    const Ctx c = fresh(c0);
    unsigned char* ws = ARG_WS();
    {
        pg8::Gemm g{(const bf16*)(ws + WS_CB), (const bf16*)(ws + WS_WUKV), MP, 1024, KVL}; pg8::StaticOrder S; S.init(MP, 1024, c.G, c.wg);
        pg8::EpiBf16Split E{(bf16*)(ws + WS_KN), 1024, 0, 0};
        pg8::gemm_phase<pg8::EpiBf16Split, pg8::StaticOrder, true, true>(c.lds, g, S, E, c.tid); }
    {
        const Ctx c1 = fresh(c0);
        pg8::Gemm g{(const bf16*)(ws + WS_WUKV) + (size_t)1024 * KVL, (const bf16*)(ws + WS_CB), 1024, MP, KVL}; pg8::StaticOrder S; S.init(1024, MP, c1.G, c1.wg);
        pg8::EpiBf16Split E{(bf16*)(ws + WS_VV), MP, 0, 0};
        pg8::gemm_phase<pg8::EpiBf16Split, pg8::StaticOrder, true, true>(c1.lds, g, S, E, c1.tid); }
}
__device__ __forceinline__ void ph_attn(const Ctx& c0) {
    const Ctx c = fresh(c0);
    unsigned char* ws = ARG_WS(); float* X = ARG_OUT();
    float* c_s = X + (size_t)M * D + (size_t)2 * BATCH * HA * DK * DV + (size_t)MP * KVL + (size_t)MP * 64 + (size_t)2 * DB * HA * DK * DV; float* kr_s = c_s + (size_t)DB * KVL;
    attn_prompt_phase((const bf16*)(ws + WS_QN), (const bf16*)(ws + WS_QR), (const bf16*)(ws + WS_KN), (const bf16*)(ws + WS_KRB), (const bf16*)(ws + WS_VV), (bf16*)(ws + WS_OG), c.lds, c.wg, c.G, c.tid);
    decode_naive_phase((const bf16*)(ws + WS_QN), (const bf16*)(ws + WS_QR), (const bf16*)(ws + WS_WUKVN), (const bf16*)(ws + WS_WUKV), ARG_IN(3), ARG_IN(4), (const int*)ARG_IN(5), c_s, kr_s,
                       (float*)(ws + WS_SC), (bf16*)(ws + WS_OG), c.lds, c.wg, c.G, c.tid);
}
__device__ __forceinline__ void ph_mixout(const Ctx& c0, int l) {
    const Ctx c = fresh(c0);
    unsigned char* ws = ARG_WS();
    const bf16* Wt = (l < 2) ? (const bf16*)(ws + WS_WOUTA) + (size_t)l * 1024 * 1024 : (const bf16*)(ws + WS_WOUTB) + (size_t)(l - 2) * 1024 * 1024;
    const bf16* OG = (const bf16*)(ws + WS_OG); float* MIX = (float*)(ws + WS_MIX);
    pg8::Gemm g{OG, Wt, MP, 1024, 1024}; pg8::StaticOrder S; S.init(MP, 1024, c.G, c.wg);
    pg8::EpiF32 E{MIX, 1024};
    pg8::gemm_phase<pg8::EpiF32, pg8::StaticOrder, true, true>(c.lds, g, S, E, c.tid);
    const Ctx c2 = fresh(c0);
    sg_f32(OG, 1024, Wt, 1024, MIX, 1024, c2.gw, c2.NGW, c2.lane);
}
__device__ __forceinline__ void ph_resid(const Ctx& c0, int l, int which) {
    const Ctx c = fresh(c0);
    unsigned char* ws = ARG_WS(); float* X = ARG_OUT(); const float* gain = ARG_IN(6) + (size_t)(l * 4 + which) * D;
    const float* MIX = (const float*)(ws + WS_MIX); bf16* HN = (bf16*)(ws + WS_HN);
    for (int m = c.gw; m < M; m += c.NGW) row_resid_norm(MIX + (size_t)m * D, X + (size_t)m * D, gain, HN + (size_t)m * D, c.lane);
}
__device__ __forceinline__ void ph_ffn_in(const Ctx& c0, int l) {
    const Ctx c = fresh(c0);
    unsigned char* ws = ARG_WS();
    const bf16* HN = (const bf16*)(ws + WS_HN); const bf16* Wt = (const bf16*)(ws + WS_WFIN) + (size_t)l * 5632 * 1024; bf16* ACT = (bf16*)(ws + WS_ACT);
    pg8::Gemm g{HN, Wt, MP, 5632, 1024}; pg8::StaticOrder S; S.init(MP, 5632, c.G, c.wg);
    pg8::EpiSwiglu E{ACT, DFF};
    pg8::gemm_phase<pg8::EpiSwiglu, pg8::StaticOrder, true, true>(c.lds, g, S, E, c.tid);
    const Ctx c2 = fresh(c0);
    sg_swiglu(HN, Wt, ACT, c2.gw, c2.NGW, c2.lane);
}
__device__ __forceinline__ void ph_ffn_out(const Ctx& c0, int l) {
    const Ctx c = fresh(c0);
    unsigned char* ws = ARG_WS();
    const bf16* ACT = (const bf16*)(ws + WS_ACT); const bf16* Wt = (const bf16*)(ws + WS_WFOUT) + (size_t)l * 1024 * 2816; float* MIX = (float*)(ws + WS_MIX);
    pg8::Gemm g{ACT, Wt, MP, 1024, DFF}; pg8::StaticOrder S; S.init(MP, 1024, c.G, c.wg);
    pg8::EpiF32 E{MIX, 1024};
    pg8::gemm_phase<pg8::EpiF32, pg8::StaticOrder, true, true>(c.lds, g, S, E, c.tid);
    const Ctx c2 = fresh(c0);
    sg_f32(ACT, DFF, Wt, 1024, MIX, 1024, c2.gw, c2.NGW, c2.lane);
}

__global__ void __launch_bounds__(NTHR, 2) mk_fwd(Args args) {
    extern __shared__ __attribute__((aligned(16))) unsigned char lds_raw[];
    Ctx c;
    c.lds = (LAS unsigned char*)lds_raw;
    c.tid = 0; c.lane = 0; c.wave = __builtin_amdgcn_readfirstlane((int)threadIdx.x >> 6);
    c.wg = blockIdx.x; c.G = gridDim.x; c.gw = c.wg * NWAVES + c.wave; c.NGW = c.G * NWAVES;
    for (int u = threadIdx.x; u < (LDS_BYTES - RING_BYTES) / 4; u += NTHR) ((LAS unsigned*)(c.lds + RING_BYTES))[u] = 0u;
    __syncthreads();
#define MAKE_BAR(b) XcdBarrier b; b.wave = c.wave; b.bar = (unsigned*)(ARG_WS() + WS_CTL) + CW_BAR + karg32(192) * XCD_BAR_WORDS; b.x = xb_xcc_id(); b.st = (volatile LAS unsigned*)(c.lds + MISC_OFF) + 8
    { MAKE_BAR(b0); if (xb_thread0(c.wave)) (void)xb_add(&b0.bar[XB_XCNT(b0.x)], 1u); }
#define PH_BEGIN(k) { const int lo_ = karg32(184), hi_ = karg32(188); if (lo_ <= (k) && (k) < hi_) { if ((k) > lo_) { MAKE_BAR(bb); xcd_barrier(bb); }
#define PH_END } }
    PH_BEGIN(0) ph_prologue(c); PH_END
    for (int l = 0; l < 4; ++l) {
        const int pb = 1 + l * 10;
        if (l < 2) {
            PH_BEGIN(pb + 0) ph_hgrn_in(c, l); PH_END
            PH_BEGIN(pb + 1) ph_hgrn_rec(c, l); PH_END
        } else {
            PH_BEGIN(pb + 0) ph_dq(c, l - 2); PH_END
            PH_BEGIN(pb + 1) ph_qnorm(c, l - 2); PH_END
            PH_BEGIN(pb + 2) ph_uq(c, l - 2); PH_END
            if (l == 2) { PH_BEGIN(pb + 3) ph_kvup(c); PH_END }
            PH_BEGIN(pb + 4) ph_attn(c); PH_END
        }
        PH_BEGIN(pb + 5) ph_mixout(c, l); PH_END
        PH_BEGIN(pb + 6) ph_resid(c, l, 1); PH_END
        PH_BEGIN(pb + 7) ph_ffn_in(c, l); PH_END
        PH_BEGIN(pb + 8) ph_ffn_out(c, l); PH_END
        PH_BEGIN(pb + 9) ph_resid(c, l, 3); PH_END
    }
#undef PH_BEGIN
#undef PH_END
}

#ifndef MK_PER_PHASE
#define MK_PER_PHASE 0
#endif
extern "C" void kernel_launch(void* const* d_in, const int* in_sizes, int n_in, void* d_out, int out_size, void* d_ws, size_t ws_size, hipStream_t stream) {
    static int grid = 0;
    if (grid == 0) {
        int dev = 0, cus = 0, per_cu = 0;
        if (n_in != 21 || ws_size < WS_END) { fprintf(stderr, "kernel_launch: unexpected arguments (n_in %d, ws %zu < %zu)\n", n_in, ws_size, (size_t)WS_END); grid = -1; return; }
        if (hipGetDevice(&dev) != hipSuccess || hipDeviceGetAttribute(&cus, hipDeviceAttributeMultiprocessorCount, dev) != hipSuccess) { grid = -1; return; }
        if (hipFuncSetAttribute((const void*)mk_fwd, hipFuncAttributeMaxDynamicSharedMemorySize, LDS_BYTES) != hipSuccess) { fprintf(stderr, "kernel_launch: hipFuncSetAttribute failed\n"); grid = -1; return; }
        if (hipOccupancyMaxActiveBlocksPerMultiprocessor(&per_cu, (const void*)mk_fwd, NTHR, LDS_BYTES) != hipSuccess || per_cu < 1) fprintf(stderr, "kernel_launch: occupancy query reports %d\n", per_cu);
        (void)hipGetLastError();
        grid = cus;
    }
    if (grid < 0) return;
    (void)hipMemsetAsync((char*)d_ws + WS_CTL, 0, CTL_BYTES, stream);
    Args a{};
    for (int i = 0; i < 21; ++i) a.in[i] = (const float*)d_in[i];
    a.out = (float*)d_out; a.ws = (unsigned char*)d_ws;
#if MK_PER_PHASE
    int li = 0;
    for (int k = 0; k < NPH; ++k) { if (!phase_exists(k)) continue; a.ph_lo = k; a.ph_hi = k + 1; a.li = li++; hipLaunchKernelGGL(mk_fwd, dim3(grid), dim3(NTHR), LDS_BYTES, stream, a); }
#else
    a.ph_lo = 0; a.ph_hi = NPH; a.li = 0;
    hipLaunchKernelGGL(mk_fwd, dim3(grid), dim3(NTHR), LDS_BYTES, stream, a);
#endif
    const hipError_t le = hipPeekAtLastError();
    if (le != hipSuccess) fprintf(stderr, "kernel_launch: launch failed: %s\n", hipGetErrorName(le));
}
```

```cpp
#include <hip/hip_runtime.h>
#include <cstdio>
#include <cstdint>
#include <math.h>
#define GAS __attribute__((address_space(1)))
#define LAS __attribute__((address_space(3)))
typedef unsigned short bf16;
typedef unsigned v4u __attribute__((ext_vector_type(4)));
typedef unsigned v2u __attribute__((ext_vector_type(2)));
typedef float f32x4 __attribute__((ext_vector_type(4)));
typedef short bf16x8 __attribute__((ext_vector_type(8)));
constexpr int NWAVES = 8, NTHR = 512;
constexpr int D = 1024, BATCH = 8, SEQ = 2048, MP = BATCH * SEQ, DB = 128, M = MP + DB;
constexpr int HA = 8, DK = 128, DV = 128;
constexpr int QL = 384, KVL = 256;
constexpr int PAST = 8192, PAGE = 128, NPAGES = PAST / PAGE;
constexpr int DFF = 2816;
constexpr float EPS = 1e-6f;
constexpr float QSCALE = 0.07216878364870322f * 1.4426950408889634f;
constexpr int QCP = 768;
constexpr int SCP = PAST + 64;

constexpr size_t MiB = 1u << 20;
constexpr size_t WS_CTL = 0, CTL_BYTES = 1 * MiB;
constexpr size_t WS_WIN   = 1 * MiB;
constexpr size_t WS_WOUTA = WS_WIN + 2 * (size_t)4096 * 1024 * 2;
constexpr size_t WS_WFIN  = WS_WOUTA + 2 * (size_t)1024 * 1024 * 2;
constexpr size_t WS_WFOUT = WS_WFIN + 4 * (size_t)5632 * 1024 * 2;
constexpr size_t WS_WDQ0  = WS_WFOUT + 4 * (size_t)1024 * 2816 * 2;
constexpr size_t WS_WDQ1  = WS_WDQ0 + (size_t)768 * 1024 * 2;
constexpr size_t WS_WUQ   = WS_WDQ1 + (size_t)512 * 1024 * 2;
constexpr size_t WS_WUKV  = WS_WUQ + 2 * (size_t)1536 * 384 * 2;
constexpr size_t WS_WUKVN = WS_WUKV + (size_t)2048 * 256 * 2;
constexpr size_t WS_WOUTB = WS_WUKVN + (size_t)256 * 2048 * 2;
constexpr size_t WS_CS    = WS_WOUTB + 2 * (size_t)1024 * 1024 * 2;
constexpr size_t WS_LBT   = WS_CS + (size_t)2049 * 64 * 4 + 256;
constexpr size_t WS_HN    = ((WS_LBT + 2 * 1024 * 2 * 4 + 4095) / 4096) * 4096;
constexpr size_t WS_QB    = WS_HN + (size_t)M * 1024 * 2;
constexpr size_t WS_VB    = WS_QB + (size_t)M * 1024 * 2;
constexpr size_t WS_GATE  = WS_VB + (size_t)M * 1024 * 2;
constexpr size_t WS_GB    = WS_GATE + (size_t)M * 1024 * 2;
constexpr size_t WS_OG    = WS_GB + (size_t)M * 1024 * 4;
constexpr size_t WS_MIX   = WS_OG + (size_t)M * 1024 * 2;
constexpr size_t WS_ACT   = WS_MIX + (size_t)M * 1024 * 4;
constexpr size_t WS_QC    = WS_ACT + (size_t)M * 2816 * 2;
constexpr size_t WS_QAN   = WS_QC + (size_t)M * QCP * 4;
constexpr size_t WS_CB    = WS_QAN + (size_t)M * 384 * 2;
constexpr size_t WS_KRB   = WS_CB + (size_t)M * 256 * 2;
constexpr size_t WS_QN    = WS_KRB + (size_t)MP * 64 * 2;
constexpr size_t WS_QR    = WS_QN + (size_t)M * 1024 * 2;
constexpr size_t WS_KN    = WS_QR + (size_t)M * 512 * 2;
constexpr size_t WS_VV    = WS_KN + (size_t)MP * 1024 * 2;
constexpr size_t WS_SC    = WS_VV + (size_t)MP * 1024 * 2;
constexpr size_t WS_END   = WS_SC + (size_t)DB * 8 * SCP * 4;
constexpr int CW_BAR = 4096;
constexpr int RING_BYTES = 131072, MISC_OFF = RING_BYTES + 320, LDS_BYTES = 147456;

__device__ __forceinline__ float bf2f(unsigned b) { return __uint_as_float(b << 16); }
__device__ __forceinline__ unsigned f2bf(float f) { unsigned u = __float_as_uint(f); return (u + 0x7fffu + ((u >> 16) & 1u)) >> 16; }
__device__ __forceinline__ unsigned pk2(float lo, float hi) { return f2bf(lo) | (f2bf(hi) << 16); }
#define LDS_WAIT() asm volatile("s_waitcnt lgkmcnt(0)" ::: "memory")
__device__ __forceinline__ int lane_id_v() { int l; asm volatile("v_mbcnt_lo_u32_b32 %0, -1, 0\n\tv_mbcnt_hi_u32_b32 %0, -1, %0" : "=v"(l)); return l; }
__device__ __forceinline__ float shx(float v, int mask, int lane) { return __int_as_float(__builtin_amdgcn_ds_bpermute((lane ^ mask) << 2, __float_as_int(v))); }
__device__ __forceinline__ float wave_sum(float v) {
    const int lane = lane_id_v();
#pragma unroll
    for (int o = 1; o < 64; o <<= 1) v += shx(v, o, lane);
    return v;
}
__device__ __forceinline__ float wave_max(float v) {
    const int lane = lane_id_v();
#pragma unroll
    for (int o = 1; o < 64; o <<= 1) v = fmaxf(v, shx(v, o, lane));
    return v;
}
namespace pg8 {
#define PG8_LAS __attribute__((address_space(3)))
typedef unsigned short bf16_t;
typedef short bf16x8 __attribute__((ext_vector_type(8)));
typedef float f32x4 __attribute__((ext_vector_type(4)));
typedef unsigned u32x4 __attribute__((ext_vector_type(4)));
constexpr int BM = 256, BK = 64, HALF = 128, HTB = HALF * BK * 2  , STAGE_BYTES = 8 * HTB, NXCD = 8, WGM = 8;

__host__ __device__ __forceinline__ int lds_byte(int r, int c) { const int st = (r >> 4) * 2 + (c >> 5), rr = r & 15, cc = c & 31, ob = rr * 64 + cc * 2; return st * 1024 + (ob ^ (((ob >> 9) & 1) << 5)); }
__host__ __device__ __forceinline__ void stage_rc(int b, int& R, int& C) { const int st = b / 1024, sb = b % 1024, swz = sb ^ (((sb >> 9) & 1) << 5); R = (st >> 1) * 16 + swz / 64; C = (st & 1) * 32 + (swz % 64) / 2; }
__host__ __device__ __forceinline__ int perm32(int rho) { const int n = rho >> 4, i = rho & 15; return 8 * (i >> 2) + 4 * n + (i & 3); }

struct Unit { int pm, pn; };
struct Gemm { const bf16_t* A; const bf16_t* Bt; int M, N, K; };

struct StaticOrder {
    int nM, nN, nwg, G, c;
    __host__ __device__ void init(int M, int N, int G_, int c_) { nM = M / BM; nN = N / BM; nwg = nM * nN; G = G_; c = c_; }
    __host__ __device__ bool next(int i, Unit& u) const {
        const long L = (long)i * G + c; if (L >= nwg) return false;
        int wgid = (int)L; { const int q = nwg / NXCD, r = nwg % NXCD, xcd = wgid % NXCD, off = wgid / NXCD; wgid = (xcd < r ? xcd * (q + 1) : r * (q + 1) + (xcd - r) * q) + off; }
        const int nig = WGM * nN, gid = wgid / nig, fm = gid * WGM, gsz = (nM - fm) < WGM ? (nM - fm) : WGM;
        u.pm = fm + ((wgid % nig) % gsz); u.pn = (wgid % nig) / gsz; return true;
    }
    __device__ __forceinline__ void a_ready(const Unit&) const {}
    __device__ __forceinline__ void done(const Unit&) const {}
};

__device__ __forceinline__ unsigned cvt_pk_bf16(float lo, float hi) { unsigned r; asm volatile("v_cvt_pk_bf16_f32 %0, %1, %2" : "=v"(r) : "v"(lo), "v"(hi)); return r; }
typedef float f32x2 __attribute__((ext_vector_type(2)));
__device__ __forceinline__ float silu_fast(float x) { return x * __builtin_amdgcn_rcpf(1.0f + __expf(-x)); }
__device__ __forceinline__ float logf_gate(float z, float log_lb, float l1p) {
    const float lsig = fminf(z, 0.f) - __logf(1.0f + __expf(-fabsf(z)));
    const float bb = l1p + lsig;
    const float mx = fmaxf(log_lb, bb), mn = fminf(log_lb, bb);
    return fminf(mx + __logf(1.0f + __expf(mn - mx)), 0.f);
}
struct EpiF32 {
    static constexpr bool PERM = false, AFTER_DRAIN = false;
    float* C; int ldc;
    __device__ __forceinline__ void operator()(const f32x4 (&acc)[2][2][4][2], const Unit& u, int wr, int wc, int fr_, int fq_) const {
        const int ln_ = lane_id_v(); const int fr = ln_ & 15, fq = ln_ >> 4;
        const int row0 = u.pm * BM + wr * 64 + fr, col0 = u.pn * BM + wc * 32 + 4 * fq;
#pragma unroll
        for (int ai = 0; ai < 2; ++ai)
#pragma unroll
            for (int m = 0; m < 4; ++m) { float* rowp = C + (size_t)(row0 + ai * HALF + m * 16) * ldc + col0;
#pragma unroll
                for (int bj = 0; bj < 2; ++bj)
#pragma unroll
                    for (int n = 0; n < 2; ++n) *(f32x4*)(rowp + bj * HALF + n * 16) = acc[ai][bj][m][n]; }
    }
};
struct EpiBf16Split {
    static constexpr bool PERM = true, AFTER_DRAIN = false;
    bf16_t* O; int ldc; int split_cols; size_t split_stride;
    __device__ __forceinline__ void operator()(const f32x4 (&acc)[2][2][4][2], const Unit& u, int wr, int wc, int fr_, int fq_) const {
        const int ln_ = lane_id_v(); const int fr = ln_ & 15, fq = ln_ >> 4;
        const int row0 = u.pm * BM + wr * 64 + fr; int colt = u.pn * BM; bf16_t* base = O;
        if (split_cols) { const int t = colt / split_cols; base += (size_t)t * split_stride; colt -= t * split_cols; }
        const int col0 = colt + wc * 32 + 8 * fq;
#pragma unroll
        for (int ai = 0; ai < 2; ++ai)
#pragma unroll
            for (int m = 0; m < 4; ++m) { bf16_t* rowp = base + (size_t)(row0 + ai * HALF + m * 16) * ldc + col0;
#pragma unroll
                for (int bj = 0; bj < 2; ++bj) { const f32x4 v0 = acc[ai][bj][m][0], v1 = acc[ai][bj][m][1];
                    u32x4 w; w.x = cvt_pk_bf16(v0[0], v0[1]); w.y = cvt_pk_bf16(v0[2], v0[3]); w.z = cvt_pk_bf16(v1[0], v1[1]); w.w = cvt_pk_bf16(v1[2], v1[3]);
                    *(u32x4*)(rowp + bj * HALF) = w; } }
    }
};
struct EpiHgrnIn {
    static constexpr bool PERM = true, AFTER_DRAIN = false;
    unsigned char* ws; int layer;
    __device__ __forceinline__ void operator()(const f32x4 (&acc)[2][2][4][2], const Unit& u, int wr, int wc, int fr_, int fq_) const {
        const int ln_ = lane_id_v(); const int fr = ln_ & 15, fq = ln_ >> 4;
        const int row0 = u.pm * BM + wr * 64 + fr; const int type = u.pn >> 2; const int cl0 = (u.pn & 3) * 256 + wc * 32 + 8 * fq;
        if (type == 1) {
            const float* lbt = (const float*)(ws + WS_LBT) + (size_t)layer * 2048; float* GB = (float*)(ws + WS_GB);
#pragma unroll
            for (int bj = 0; bj < 2; ++bj) {
                const int cl = cl0 + bj * HALF;
                f32x4 t0 = *(const f32x4*)(lbt + 2 * cl), t1 = *(const f32x4*)(lbt + 2 * cl + 4), t2 = *(const f32x4*)(lbt + 2 * cl + 8), t3 = *(const f32x4*)(lbt + 2 * cl + 12);
#pragma unroll
                for (int ai = 0; ai < 2; ++ai)
#pragma unroll
                    for (int m = 0; m < 4; ++m) {
                        const f32x4 v0 = acc[ai][bj][m][0], v1 = acc[ai][bj][m][1]; f32x4 o0, o1;
                        o0[0] = logf_gate(v0[0], t0[0], t0[1]); o0[1] = logf_gate(v0[1], t0[2], t0[3]); o0[2] = logf_gate(v0[2], t1[0], t1[1]); o0[3] = logf_gate(v0[3], t1[2], t1[3]);
                        o1[0] = logf_gate(v1[0], t2[0], t2[1]); o1[1] = logf_gate(v1[1], t2[2], t2[3]); o1[2] = logf_gate(v1[2], t3[0], t3[1]); o1[3] = logf_gate(v1[3], t3[2], t3[3]);
                        float* p = GB + (size_t)(row0 + ai * HALF + m * 16) * 1024 + cl;
                        *(f32x4*)p = o0; *(f32x4*)(p + 4) = o1;
                    }
            }
        } else {
            bf16_t* dst = (bf16_t*)(ws + (type == 0 ? WS_QB : (type == 2 ? WS_VB : WS_GATE)));
#pragma unroll
            for (int ai = 0; ai < 2; ++ai)
#pragma unroll
                for (int m = 0; m < 4; ++m)
#pragma unroll
                    for (int bj = 0; bj < 2; ++bj) {
                        f32x4 v0 = acc[ai][bj][m][0], v1 = acc[ai][bj][m][1];
                        if (type == 0) {
#pragma unroll
                            for (int j = 0; j < 4; ++j) { v0[j] = silu_fast(v0[j]) * 0.08838834764831845f; v1[j] = silu_fast(v1[j]) * 0.08838834764831845f; }
                        } else if (type == 3) {
#pragma unroll
                            for (int j = 0; j < 4; ++j) { v0[j] = silu_fast(v0[j]); v1[j] = silu_fast(v1[j]); }
                        }
                        u32x4 w; w.x = cvt_pk_bf16(v0[0], v0[1]); w.y = cvt_pk_bf16(v0[2], v0[3]); w.z = cvt_pk_bf16(v1[0], v1[1]); w.w = cvt_pk_bf16(v1[2], v1[3]);
                        *(u32x4*)(dst + (size_t)(row0 + ai * HALF + m * 16) * 1024 + cl0 + bj * HALF) = w;
                    }
        }
    }
};
struct EpiSwiglu {
    static constexpr bool PERM = true, AFTER_DRAIN = false;
    bf16_t* ACT; int ldc;
    __device__ __forceinline__ void operator()(const f32x4 (&acc)[2][2][4][2], const Unit& u, int wr, int wc, int fr_, int fq_) const {
        const int ln_ = lane_id_v(); const int fr = ln_ & 15, fq = ln_ >> 4;
        const int row0 = u.pm * BM + wr * 64 + fr, col0 = u.pn * HALF + wc * 32 + 8 * fq;
#pragma unroll
        for (int ai = 0; ai < 2; ++ai)
#pragma unroll
            for (int m = 0; m < 4; ++m) {
                f32x4 r0, r1;
#pragma unroll
                for (int j = 0; j < 4; ++j) { r0[j] = silu_fast(acc[ai][0][m][0][j]) * acc[ai][1][m][0][j]; r1[j] = silu_fast(acc[ai][0][m][1][j]) * acc[ai][1][m][1][j]; }
                u32x4 w; w.x = cvt_pk_bf16(r0[0], r0[1]); w.y = cvt_pk_bf16(r0[2], r0[3]); w.z = cvt_pk_bf16(r1[0], r1[1]); w.w = cvt_pk_bf16(r1[2], r1[3]);
                *(u32x4*)(ACT + (size_t)(row0 + ai * HALF + m * 16) * ldc + col0) = w;
            }
    }
};
struct EpiRope {
    static constexpr bool PERM = true, AFTER_DRAIN = false;
    unsigned char* ws;
    __device__ __forceinline__ void operator()(const f32x4 (&acc)[2][2][4][2], const Unit& u, int wr, int wc, int fr_, int fq_) const {
        const int ln_ = lane_id_v(); const int fr = ln_ & 15, fq = ln_ >> 4;
        const int row0 = u.pm * BM + wr * 64 + fr;
        {
            bf16_t* QR = (bf16_t*)(ws + WS_QR); const float* CS = (const float*)(ws + WS_CS);
            const int rc0 = u.pn * BM + wc * 32 + 8 * fq;
#pragma unroll
            for (int ai = 0; ai < 2; ++ai)
#pragma unroll
                for (int m = 0; m < 4; ++m) { const int row = row0 + ai * HALF + m * 16; const int pos = row & 2047;
#pragma unroll
                    for (int bj = 0; bj < 2; ++bj) { const int rc = rc0 + bj * HALF; const int i0 = (rc & 63) >> 1;
                        const float* cp = CS + (size_t)(pos * 32 + i0) * 2;
                        u32x4 w;
                        { const f32x4 cc = *(const f32x4*)cp; const f32x4 v0 = acc[ai][bj][m][0];
                          w.x = cvt_pk_bf16(v0[0] * cc[0] - v0[1] * cc[1], v0[1] * cc[0] + v0[0] * cc[1]);
                          w.y = cvt_pk_bf16(v0[2] * cc[2] - v0[3] * cc[3], v0[3] * cc[2] + v0[2] * cc[3]); }
                        asm volatile("" ::: "memory");
                        { const f32x4 cc = *(const f32x4*)(cp + 4); const f32x4 v1 = acc[ai][bj][m][1];
                          w.z = cvt_pk_bf16(v1[0] * cc[0] - v1[1] * cc[1], v1[1] * cc[0] + v1[0] * cc[1]);
                          w.w = cvt_pk_bf16(v1[2] * cc[2] - v1[3] * cc[3], v1[3] * cc[2] + v1[2] * cc[3]); }
                        *(u32x4*)(QR + (size_t)row * 512 + rc) = w;
                        asm volatile("" ::: "memory"); } }
        }
    }
};
template <class Epi, class Sched, bool ALIGN_EPI = false, bool SP2 = false>
__device__ __forceinline__ void gemm_phase(PG8_LAS unsigned char* lds, const Gemm g, const Sched& S, const Epi& E, const int tid_in) {
    int tid_o = tid_in; asm volatile("" : "+v"(tid_o));
    const int tid = tid_o, wid = __builtin_amdgcn_readfirstlane(tid >> 6), lane = tid & 63, wr = wid >> 2, wc = wid & 3, fr = lane & 15, fq = lane >> 4;
    const int K = g.K, nt = K / BK;
    unsigned voffA[2], voffB[2];
#pragma unroll
    for (int i = 0; i < 2; ++i) { int R, C; stage_rc(tid * 16 + i * 8192, R, C); const int Rb = Epi::PERM ? ((R & ~31) + perm32(R & 31)) : R;
        voffA[i] = (unsigned)(R * K + C) * 2u; voffB[i] = (unsigned)(Rb * K + C) * 2u; }
    const size_t kstep = (size_t)(BK * 2);
    const size_t hstep = (size_t)HALF * K * 2;
    const size_t tstep = 2 * hstep;
    const unsigned ldsw = (unsigned)wid * 1024u;
    const int aoff = lds_byte(wr * 64 + fr, fq * 8), boff = lds_byte(wc * 32 + fr, fq * 8);
#define PG8_SA(b, h) (((b) * 2 + (h)) * HTB)
#define PG8_SB(b, h) ((4 + (b) * 2 + (h)) * HTB)
#define PG8_STAGE(bufoff, gbase, voff) do { _Pragma("unroll") for (int _i = 0; _i < 2; ++_i) \
        __builtin_amdgcn_global_load_lds((const unsigned*)((const char*)(gbase) + (voff)[_i]), (PG8_LAS unsigned*)(lds + (bufoff) + ldsw + _i * 8192), 16, 0, 0); } while (0)
#define PG8_LDA(dst, b, h) do { _Pragma("unroll") for (int m = 0; m < 4; ++m) _Pragma("unroll") for (int k = 0; k < 2; ++k) dst[m][k] = *(const PG8_LAS bf16x8*)(lds + PG8_SA(b, h) + aoff + m * 2048 + k * 1024); } while (0)
#define PG8_LDB(dst, b, h) do { _Pragma("unroll") for (int n = 0; n < 2; ++n) _Pragma("unroll") for (int k = 0; k < 2; ++k) dst[n][k] = *(const PG8_LAS bf16x8*)(lds + PG8_SB(b, h) + boff + n * 2048 + k * 1024); } while (0)
#define PG8_MMA(ai, bj, At, Bt) do { __builtin_amdgcn_s_setprio(1); _Pragma("unroll") for (int m = 0; m < 4; ++m) _Pragma("unroll") for (int n = 0; n < 2; ++n) _Pragma("unroll") for (int k = 0; k < 2; ++k) \
        acc[ai][bj][m][n] = __builtin_amdgcn_mfma_f32_16x16x32_bf16(Bt[n][k], At[m][k], acc[ai][bj][m][n], 0, 0, 0); __builtin_amdgcn_s_setprio(0); } while (0)
#define PG8_WAIT_V(n) asm volatile("s_waitcnt vmcnt(" #n ")" ::: "memory")
#define PG8_WAIT_L(n) asm volatile("s_waitcnt lgkmcnt(" #n ")" ::: "memory")
#define PG8_BAR __builtin_amdgcn_s_barrier()
#define PG8_SCHED __builtin_amdgcn_sched_barrier(0)
    Unit cur, nxt; int ui = 0;
    if (!S.next(0, cur)) return;
    f32x4 acc[2][2][4][2];
#pragma unroll
    for (int a = 0; a < 2; ++a)
#pragma unroll
        for (int b = 0; b < 2; ++b)
#pragma unroll
            for (int m = 0; m < 4; ++m)
#pragma unroll
                for (int n = 0; n < 2; ++n) acc[a][b][m][n] = (f32x4){0.f, 0.f, 0.f, 0.f};
    bf16x8 At[4][2], B0[2][2], B1[2][2];
    const char* cA = (const char*)g.A + (size_t)cur.pm * tstep; const char* cB = (const char*)g.Bt + (size_t)cur.pn * tstep;
    S.a_ready(cur);
    if constexpr (SP2) {
        PG8_STAGE(PG8_SB(0, 0), cB, voffB); PG8_STAGE(PG8_SB(0, 1), cB + hstep, voffB); PG8_STAGE(PG8_SA(0, 0), cA, voffA); PG8_STAGE(PG8_SA(0, 1), cA + hstep, voffA);
        if (wr == 1) PG8_BAR;
        PG8_WAIT_V(2); PG8_BAR;
        PG8_STAGE(PG8_SB(1, 0), cB + kstep, voffB); PG8_STAGE(PG8_SA(1, 0), cA + kstep, voffA); PG8_STAGE(PG8_SB(1, 1), cB + hstep + kstep, voffB);
        PG8_WAIT_V(6); PG8_BAR;
    } else {
        PG8_STAGE(PG8_SB(0, 0), cB, voffB); PG8_STAGE(PG8_SA(0, 0), cA, voffA); PG8_STAGE(PG8_SB(0, 1), cB + hstep, voffB); PG8_STAGE(PG8_SA(0, 1), cA + hstep, voffA);
        if (wr == 1) PG8_BAR;
        PG8_WAIT_V(4); PG8_BAR;
        PG8_STAGE(PG8_SB(1, 0), cB + kstep, voffB); PG8_STAGE(PG8_SA(1, 0), cA + kstep, voffA); PG8_STAGE(PG8_SB(1, 1), cB + hstep + kstep, voffB);
        PG8_WAIT_V(6); PG8_BAR;
    }
    for (;;) {
        const bool has_next = S.next(ui + 1, nxt);
        const char* nA = has_next ? (const char*)g.A + (size_t)nxt.pm * tstep : cA; const char* nB = has_next ? (const char*)g.Bt + (size_t)nxt.pn * tstep : cB;
        for (int t = 0; t < nt; t += 2) {
            const bool last = (t == nt - 2);
            const char* a1 = cA + (size_t)(t + 1) * kstep;
            const char* a2 = last ? nA : cA + (size_t)(t + 2) * kstep; const char* b2 = last ? nB : cB + (size_t)(t + 2) * kstep;
            const char* a3 = a2 + kstep; const char* b3 = b2 + kstep;
            if (last && has_next) S.a_ready(nxt);
            if constexpr (SP2) {
            PG8_LDB(B0, 0, 0); PG8_LDB(B1, 0, 1); PG8_SCHED; PG8_LDA(At, 0, 0); PG8_STAGE(PG8_SA(1, 1), a1 + hstep, voffA);
            PG8_WAIT_V(8); PG8_WAIT_L(0); PG8_BAR; PG8_MMA(0, 0, At, B0); PG8_MMA(0, 1, At, B1); PG8_BAR; PG8_SCHED;
            PG8_LDA(At, 0, 1); PG8_STAGE(PG8_SB(0, 0), b2, voffB); PG8_STAGE(PG8_SB(0, 1), b2 + hstep, voffB); PG8_STAGE(PG8_SA(0, 0), a2, voffA);
            PG8_WAIT_V(8); PG8_WAIT_L(0); PG8_BAR; PG8_MMA(1, 0, At, B0); PG8_MMA(1, 1, At, B1); PG8_BAR; PG8_SCHED;
            PG8_LDB(B0, 1, 0); PG8_LDB(B1, 1, 1); PG8_SCHED; PG8_LDA(At, 1, 0); PG8_STAGE(PG8_SA(0, 1), a2 + hstep, voffA);
            PG8_WAIT_V(8); PG8_WAIT_L(0); PG8_BAR; PG8_MMA(0, 0, At, B0); PG8_MMA(0, 1, At, B1); PG8_BAR; PG8_SCHED;
            PG8_LDA(At, 1, 1); PG8_STAGE(PG8_SB(1, 0), b3, voffB); PG8_STAGE(PG8_SB(1, 1), b3 + hstep, voffB); PG8_STAGE(PG8_SA(1, 0), a3, voffA);
            PG8_WAIT_V(8); PG8_WAIT_L(0); PG8_BAR; PG8_MMA(1, 0, At, B0); PG8_MMA(1, 1, At, B1); PG8_BAR; PG8_SCHED;
            } else {
            PG8_LDB(B0, 0, 0); PG8_SCHED; PG8_LDA(At, 0, 0); PG8_STAGE(PG8_SA(1, 1), a1 + hstep, voffA);
            PG8_WAIT_L(8); PG8_BAR; PG8_WAIT_L(0); PG8_MMA(0, 0, At, B0); PG8_BAR; PG8_SCHED;
            PG8_LDB(B1, 0, 1); PG8_STAGE(PG8_SB(0, 0), b2, voffB);
            PG8_BAR; PG8_WAIT_L(0); PG8_MMA(0, 1, At, B1); PG8_BAR;
            PG8_LDA(At, 0, 1); PG8_STAGE(PG8_SA(0, 0), a2, voffA);
            PG8_BAR; PG8_WAIT_L(0); PG8_MMA(1, 0, At, B0); PG8_BAR; PG8_SCHED;
            PG8_STAGE(PG8_SB(0, 1), b2 + hstep, voffB);
            PG8_WAIT_V(6); PG8_BAR; PG8_MMA(1, 1, At, B1); PG8_BAR;
            PG8_LDB(B0, 1, 0); PG8_SCHED; PG8_LDA(At, 1, 0); PG8_STAGE(PG8_SA(0, 1), a2 + hstep, voffA);
            PG8_WAIT_L(8); PG8_BAR; PG8_WAIT_L(0); PG8_MMA(0, 0, At, B0); PG8_BAR; PG8_SCHED;
            PG8_LDB(B1, 1, 1); PG8_STAGE(PG8_SB(1, 0), b3, voffB);
            PG8_BAR; PG8_WAIT_L(0); PG8_MMA(0, 1, At, B1); PG8_BAR;
            PG8_LDA(At, 1, 1); PG8_STAGE(PG8_SA(1, 0), a3, voffA);
            PG8_BAR; PG8_WAIT_L(0); PG8_MMA(1, 0, At, B0); PG8_BAR; PG8_SCHED;
            PG8_STAGE(PG8_SB(1, 1), b3 + hstep, voffB);
            PG8_WAIT_V(6); PG8_BAR; PG8_MMA(1, 1, At, B1); PG8_BAR;
            }
        }
        if constexpr (ALIGN_EPI) { if (wr == 0) PG8_BAR; }
        if constexpr (!Epi::AFTER_DRAIN) { E(acc, cur, wr, wc, fr, fq); S.done(cur); }
        if (!has_next) break;
#pragma unroll
        for (int a = 0; a < 2; ++a)
#pragma unroll
            for (int b = 0; b < 2; ++b)
#pragma unroll
                for (int m = 0; m < 4; ++m)
#pragma unroll
                    for (int n = 0; n < 2; ++n) acc[a][b][m][n] = (f32x4){0.f, 0.f, 0.f, 0.f};
        cur = nxt; cA = nA; cB = nB; ++ui;
        if constexpr (ALIGN_EPI) { if (wr == 1) PG8_BAR; }
    }
    PG8_WAIT_V(0);
    if constexpr (!ALIGN_EPI) { if (wr == 0) PG8_BAR; }
    PG8_BAR;
    if constexpr (Epi::AFTER_DRAIN) { E.fused(acc, cur, wr, wc, fr, fq, lds, wid, lane); S.done(cur); }
#undef PG8_SA
#undef PG8_SB
#undef PG8_STAGE
#undef PG8_LDA
#undef PG8_LDB
#undef PG8_MMA
#undef PG8_WAIT_V
#undef PG8_WAIT_L
#undef PG8_BAR
#undef PG8_SCHED
}
}
#define XB_TMO      128
#define XB_XCNT(j)  (256  + 64 * (j))
#define XB_XSUB(j)  (1280 + 64 * (j))
#define XB_XGEN(j)  (2304 + 64 * (j))
#define XB_TOP      3328
#define XB_TOPGEN   3392
#define XCD_BAR_WORDS 3456
#define XB_SPIN_CAP (1u << 18)

__device__ __forceinline__ unsigned xb_ld(unsigned* p)              { return __hip_atomic_load(p, __ATOMIC_RELAXED, __HIP_MEMORY_SCOPE_AGENT); }
__device__ __forceinline__ unsigned xb_add(unsigned* p, unsigned v) { return __hip_atomic_fetch_add(p, v, __ATOMIC_RELAXED, __HIP_MEMORY_SCOPE_AGENT); }
__device__ __forceinline__ unsigned xb_xcc_id() { return (unsigned)__builtin_amdgcn_s_getreg((3 << 11) | 20) & 0xFu; }
#define XB_SPIN(cond, bar) do { unsigned _sp = 0; while (cond) { __builtin_amdgcn_s_sleep(1); \
    if ((++_sp & 255u) == 0u) { if (xb_ld(&(bar)[XB_TMO])) break; if (_sp > XB_SPIN_CAP) { atomicAdd(&(bar)[XB_TMO], 1u); break; } } } } while (0)

struct XcdBarrier {
    int wave; unsigned* bar; unsigned x;
    volatile LAS unsigned* st;
};

__device__ __forceinline__ bool xb_thread0(int wave) { return wave == 0 && lane_id_v() == 0; }
__device__ __forceinline__ XcdBarrier xcd_barrier_post(unsigned* bar, volatile LAS unsigned* st, int wave) {
    XcdBarrier b; b.wave = wave; b.bar = bar; b.x = xb_xcc_id(); b.st = st;
    if (xb_thread0(wave)) (void)xb_add(&bar[XB_XCNT(b.x)], 1u);
    return b;
}
__device__ __forceinline__ void xcd_barrier_complete(unsigned* bar, unsigned x, unsigned& nloc, unsigned& nx) {
    const unsigned G = gridDim.x * gridDim.y * gridDim.z;
    unsigned sum, cnt, mine, sp = 0u;
    for (;;) {
        sum = 0u; cnt = 0u; mine = 0u;
#pragma unroll
        for (unsigned j = 0; j < 16; ++j) { const unsigned c = xb_ld(&bar[XB_XCNT(j)]); sum += c; cnt += (c > 0u) ? 1u : 0u; mine = (j == x) ? c : mine; }
        if (sum == G) break;
        __builtin_amdgcn_s_sleep(1);
        if ((++sp & 255u) == 0u) { if (xb_ld(&bar[XB_TMO])) break; if (sp > XB_SPIN_CAP) { atomicAdd(&bar[XB_TMO], 1u); break; } }
    }
    nloc = mine > 0u ? mine : 1u; nx = cnt > 0u ? cnt : 1u;
}

__device__ __forceinline__ void xcd_barrier(const XcdBarrier& b) {
    asm volatile("s_waitcnt vmcnt(0)" ::: "memory");
    __syncthreads();
    if (xb_thread0(b.wave)) {
        unsigned* bar = b.bar; asm volatile("" : "+s"(bar));
        __builtin_amdgcn_s_waitcnt(0);
        unsigned nloc = b.st[0], nx = b.st[1];
        if (nloc == 0u) { unsigned xo = b.x; asm volatile("" : "+s"(xo)); xcd_barrier_complete(bar, xo, nloc, nx); b.st[0] = nloc; b.st[1] = nx; }
        const unsigned old = xb_add(&bar[XB_XSUB(b.x)], 1u);
        const unsigned gen = old / nloc;
        if (old + 1u == (gen + 1u) * nloc) {
            __builtin_amdgcn_fence(__ATOMIC_RELEASE, "agent");
            asm volatile("s_waitcnt vmcnt(0)" ::: "memory");
            const unsigned og = xb_add(&bar[XB_TOP], 1u);
            const unsigned tg = og / nx;
            if (og + 1u == (tg + 1u) * nx) xb_add(&bar[XB_TOPGEN], 1u);
            else XB_SPIN(xb_ld(&bar[XB_TOPGEN]) == tg, bar);
            __builtin_amdgcn_fence(__ATOMIC_ACQUIRE, "agent");
            xb_add(&bar[XB_XGEN(b.x)], 1u);
            asm volatile("s_waitcnt vmcnt(0)" ::: "memory");
        } else {
            XB_SPIN(xb_ld(&bar[XB_XGEN(b.x)]) == gen, bar);
            __builtin_amdgcn_fence(__ATOMIC_ACQUIRE, "agent");
            asm volatile("s_waitcnt vmcnt(0)" ::: "memory");
        }
    }
    __syncthreads();
}
template <int NT> __device__ __forceinline__ void sg_tile(const bf16* A, int r0, const bf16* Bt, const int (&nrow)[NT], int K, int lane, f32x4 (&acc)[NT]) {
    const bf16* ap = A + (size_t)(r0 + (lane & 15)) * K + 8 * (lane >> 4);
    const bf16* bp[NT];
#pragma unroll
    for (int t = 0; t < NT; ++t) bp[t] = Bt + (size_t)(nrow[t] + (lane & 15)) * K + 8 * (lane >> 4);
#pragma unroll 4
    for (int k = 0; k < K; k += 32) {
        const bf16x8 av = *(const bf16x8*)(ap + k);
#pragma unroll
        for (int t = 0; t < NT; ++t) { const bf16x8 bv = *(const bf16x8*)(bp[t] + k); acc[t] = __builtin_amdgcn_mfma_f32_16x16x32_bf16(av, bv, acc[t], 0, 0, 0); }
    }
}
__device__ __forceinline__ void sg_hgrn_in(const bf16* HN, const bf16* Wt, bf16* QB, float* GB, bf16* VB, bf16* GATE, const float* lbt, int gw, int NGW, int lane) {
    const bf16* A = HN + (size_t)MP * 1024;
    for (int tile = gw; tile < 8 * 256; tile += NGW) {
        const int mt = tile & 7, nt = tile >> 3; const int nrow[1] = {nt * 16}; f32x4 acc[1] = {{0.f, 0.f, 0.f, 0.f}};
        sg_tile<1>(A, mt * 16, Wt, nrow, 1024, lane, acc);
        const int col = nt * 16 + (lane & 15), type = col >> 10, c = col & 1023;
        const float llb = lbt[2 * c], l1p = lbt[2 * c + 1];
#pragma unroll
        for (int reg = 0; reg < 4; ++reg) {
            const size_t o = (size_t)(MP + mt * 16 + 4 * (lane >> 4) + reg) * 1024 + c; const float x = acc[0][reg];
            if (type == 0) QB[o] = (bf16)f2bf(pg8::silu_fast(x) * 0.08838834764831845f);
            else if (type == 1) GB[o] = pg8::logf_gate(x, llb, l1p);
            else if (type == 2) VB[o] = (bf16)f2bf(x);
            else GATE[o] = (bf16)f2bf(pg8::silu_fast(x));
        }
    }
}
__device__ __forceinline__ void sg_f32(const bf16* Abuf, int K, const bf16* Wt, int N, float* C, int ldc, int gw, int NGW, int lane) {
    const bf16* A = Abuf + (size_t)MP * K;
    for (int tile = gw; tile < 8 * (N / 16); tile += NGW) {
        const int mt = tile & 7, nt = tile >> 3; const int nrow[1] = {nt * 16}; f32x4 acc[1] = {{0.f, 0.f, 0.f, 0.f}};
        sg_tile<1>(A, mt * 16, Wt, nrow, K, lane, acc);
#pragma unroll
        for (int reg = 0; reg < 4; ++reg) C[(size_t)(MP + mt * 16 + 4 * (lane >> 4) + reg) * ldc + nt * 16 + (lane & 15)] = acc[0][reg];
    }
}
__device__ __forceinline__ void sg_swiglu(const bf16* HN, const bf16* Wt, bf16* ACT, int gw, int NGW, int lane) {
    const bf16* A = HN + (size_t)MP * 1024;
    for (int tile = gw; tile < 8 * (DFF / 16); tile += NGW) {
        const int mt = tile & 7, nt = tile >> 3, j0 = nt * 16; const int ng = 256 * (j0 >> 7) + (j0 & 127); const int nrow[2] = {ng, ng + 128};
        f32x4 acc[2] = {{0.f, 0.f, 0.f, 0.f}, {0.f, 0.f, 0.f, 0.f}};
        sg_tile<2>(A, mt * 16, Wt, nrow, 1024, lane, acc);
#pragma unroll
        for (int reg = 0; reg < 4; ++reg) ACT[(size_t)(MP + mt * 16 + 4 * (lane >> 4) + reg) * DFF + j0 + (lane & 15)] = (bf16)f2bf(pg8::silu_fast(acc[0][reg]) * acc[1][reg]);
    }
}
__device__ __forceinline__ void sg_uq(const bf16* QAN, const bf16* Wt, bf16* QN, bf16* QR, const float* CS, int gw, int NGW, int lane) {
    const bf16* A = QAN + (size_t)MP * QL;
    for (int tile = gw; tile < 8 * (1536 / 16); tile += NGW) {
        const int mt = tile & 7, nt = tile >> 3; const int nrow[1] = {nt * 16}; f32x4 acc[1] = {{0.f, 0.f, 0.f, 0.f}};
        sg_tile<1>(A, mt * 16, Wt, nrow, QL, lane, acc);
        const int col = nt * 16 + (lane & 15);
#pragma unroll
        for (int reg = 0; reg < 4; ++reg) {
            const int row = MP + mt * 16 + 4 * (lane >> 4) + reg; const float x = acc[0][reg]; const float partner = shx(x, 1, lane);
            if (col < 1024) QN[(size_t)row * 1024 + col] = (bf16)f2bf(x);
            else { const int rc = col - 1024, h = rc >> 6, ii = rc & 63, i = ii >> 1; const float cs = CS[(size_t)(2048 * 32 + i) * 2], sn = CS[(size_t)(2048 * 32 + i) * 2 + 1];
                float o; int ref;
                if ((ii & 1) == 0) { o = x * cs - partner * sn; ref = i; } else { o = x * cs + partner * sn; ref = 32 + i; }
                QR[(size_t)row * 512 + h * 64 + ref] = (bf16)f2bf(o); }
        }
    }
}

__device__ __forceinline__ int maprow(int kind, int j) {
    if (kind == 1) { if (j < DFF) return 256 * (j >> 7) + (j & 127); const int jj = j - DFF; return 256 * (jj >> 7) + 128 + (jj & 127); }
    if (kind == 2) return 384 + j;
    if (kind == 3) { const int h = j / 192, n = j - h * 192; if (n < 128) return h * 128 + n; const int i = n - 128; return 1024 + h * 64 + (i < 32 ? 2 * i : 2 * (i - 32) + 1); }
    if (kind == 4) { const int h = j >> 8, n = j & 255; return n < 128 ? h * 128 + n : 1024 + h * 128 + (n - 128); }
    return j;
}
__device__ __forceinline__ void cvt_item(const float* W, int K, int N, bf16* WT, int kind, const float* gain, float scale, LAS float* scr, int item, int lane) {
    const int nblk = N / 32, kb = item / nblk, nb = item - kb * nblk, k0 = 64 * kb, n0 = 32 * nb;
#pragma unroll 8
    for (int i = 0; i < 32; ++i) { const int kk = 2 * i + (lane >> 5); const float g = gain ? gain[k0 + kk] * scale : scale;
        scr[kk * 33 + (lane & 31)] = W[(size_t)(k0 + kk) * N + n0 + (lane & 31)] * g; }
    LDS_WAIT(); asm volatile("" ::: "memory");
    const int c = lane & 7;
#pragma unroll
    for (int j = 0; j < 4; ++j) { const int n = (lane >> 3) + 8 * j; const LAS float* s = scr + (8 * c) * 33 + n;
        v4u o; o.x = pk2(s[0 * 33], s[1 * 33]); o.y = pk2(s[2 * 33], s[3 * 33]); o.z = pk2(s[4 * 33], s[5 * 33]); o.w = pk2(s[6 * 33], s[7 * 33]);
        *(v4u*)(WT + (size_t)maprow(kind, n0 + n) * K + k0 + 8 * c) = o; }
    LDS_WAIT(); asm volatile("" ::: "memory");
}
__device__ __forceinline__ void row_resid_norm(const float* mix, float* X, const float* gain, bf16* HN, int lane) {
    const f32x4* mr = (const f32x4*)mix + lane; f32x4* xr = (f32x4*)X + lane; const f32x4* gr = (const f32x4*)gain + lane;
    f32x4 v[4]; float s = 0.f;
#pragma unroll
    for (int j = 0; j < 4; ++j) { v[j] = mr[64 * j]; s += (v[j][0] * v[j][0] + v[j][1] * v[j][1]) + (v[j][2] * v[j][2] + v[j][3] * v[j][3]); }
    const float r = rsqrtf(wave_sum(s) * (1.f / 1024.f) + EPS); float s2 = 0.f;
#pragma unroll
    for (int j = 0; j < 4; ++j) { const f32x4 x = xr[64 * j] + v[j] * r * gr[64 * j]; xr[64 * j] = x; v[j] = x; s2 += (x[0] * x[0] + x[1] * x[1]) + (x[2] * x[2] + x[3] * x[3]); }
    const float r2 = rsqrtf(wave_sum(s2) * (1.f / 1024.f) + EPS);
    v2u* o8 = (v2u*)HN + lane;
#pragma unroll
    for (int j = 0; j < 4; ++j) { v2u w; w.x = pk2(v[j][0] * r2, v[j][1] * r2); w.y = pk2(v[j][2] * r2, v[j][3] * r2); o8[64 * j] = w; }
}
__device__ __forceinline__ void hgrn_naive_phase(const bf16* QB, const float* GB, const bf16* VB, const bf16* GATE, const float* gnorm, const float* s0, float* st_p, float* st_s, bf16* OG,
                                                 LAS unsigned char* lds, int wg, int G, int tid) {
    LAS float* sq = (LAS float*)lds; LAS float* sf = sq + 128; LAS float* sk = sf + 128; LAS float* red = sk + 128;
    const int dv = tid & 127; const bool active = tid < 128;
    for (int unit = wg; unit < 64 + DB * HA; unit += G) {
        const bool prompt = unit < 64; const int uu = prompt ? unit : unit - 64; const int seq = uu >> 3, h = uu & 7;
        const int T = prompt ? SEQ : 1; const int row0 = prompt ? seq * SEQ : MP + seq;
        const size_t sb = ((size_t)seq * HA + h) * DK * DV;
        float S[128];
#pragma unroll
        for (int k = 0; k < 128; ++k) S[k] = (!prompt && active) ? s0[sb + (size_t)k * DV + dv] : 0.f;
        for (int t = 0; t < T; ++t) {
            const size_t o = (size_t)(row0 + t) * 1024 + h * 128 + dv;
            __syncthreads();
            float v = 0.f;
            if (active) { sq[dv] = bf2f(QB[o]); const float lf = GB[o]; sf[dv] = expf(lf); sk[dv] = -expm1f(lf); v = bf2f(VB[o]); }
            __syncthreads();
            float ov = 0.f;
            if (active) {
#pragma unroll
                for (int k = 0; k < 128; ++k) { S[k] = sf[k] * S[k] + sk[k] * v; ov += sq[k] * S[k]; }
            }
            const float ss = wave_sum(ov * ov);
            if (active && (tid & 63) == 0) red[tid >> 6] = ss;
            __syncthreads();
            if (active) { const float r = rsqrtf((red[0] + red[1]) * (1.f / 128.f) + EPS); OG[o] = (bf16)f2bf(ov * r * gnorm[h * 128 + dv] * bf2f(GATE[o])); }
        }
        if (active) { float* so = (prompt ? st_p : st_s) + sb;
#pragma unroll
            for (int k = 0; k < 128; ++k) so[(size_t)k * DV + dv] = S[k]; }
    }
}
__device__ __forceinline__ void attn_naive_phase(const bf16* QN, const bf16* QR, const bf16* KN, const bf16* KRB, const bf16* VV, bf16* O, LAS unsigned char* lds, int wg, int G, int tid) {
    LAS float* sc = (LAS float*)lds;
    LAS float* red = sc + SEQ;
    LAS float* part = red + 16;
    const int g16 = tid >> 4, l16 = tid & 15, wave = tid >> 6;
    for (int unit = wg; unit < BATCH * 8 * SEQ; unit += G) {
        const int t = unit & (SEQ - 1), h = (unit >> 11) & 7, b = unit >> 14; const size_t row = (size_t)b * SEQ + t;
        const v4u qa = *(const v4u*)(QN + row * 1024 + h * 128 + 8 * l16); const v2u qb = *(const v2u*)(QR + row * 512 + h * 64 + 4 * l16);
        float qf[12];
        qf[0] = bf2f(qa.x & 0xffff); qf[1] = bf2f(qa.x >> 16); qf[2] = bf2f(qa.y & 0xffff); qf[3] = bf2f(qa.y >> 16); qf[4] = bf2f(qa.z & 0xffff); qf[5] = bf2f(qa.z >> 16); qf[6] = bf2f(qa.w & 0xffff); qf[7] = bf2f(qa.w >> 16);
        qf[8] = bf2f(qb.x & 0xffff); qf[9] = bf2f(qb.x >> 16); qf[10] = bf2f(qb.y & 0xffff); qf[11] = bf2f(qb.y >> 16);
        __syncthreads();
        float mx = -1e30f;
        for (int s = g16; s <= t; s += 32) {
            const size_t kr = (size_t)b * SEQ + s;
            const v4u ka = *(const v4u*)(KN + kr * 1024 + h * 128 + 8 * l16); const v2u kb = *(const v2u*)(KRB + kr * 64 + 4 * l16);
            float d = qf[0] * bf2f(ka.x & 0xffff) + qf[1] * bf2f(ka.x >> 16) + qf[2] * bf2f(ka.y & 0xffff) + qf[3] * bf2f(ka.y >> 16) + qf[4] * bf2f(ka.z & 0xffff) + qf[5] * bf2f(ka.z >> 16) + qf[6] * bf2f(ka.w & 0xffff) + qf[7] * bf2f(ka.w >> 16)
                    + qf[8] * bf2f(kb.x & 0xffff) + qf[9] * bf2f(kb.x >> 16) + qf[10] * bf2f(kb.y & 0xffff) + qf[11] * bf2f(kb.y >> 16);
            { const int ln = tid & 63; d += shx(d, 1, ln); d += shx(d, 2, ln); d += shx(d, 4, ln); d += shx(d, 8, ln); }
            if (l16 == 0) sc[s] = d;
            mx = fmaxf(mx, d);
        }
        mx = wave_max(mx);
        if ((tid & 63) == 0) red[wave] = mx;
        __syncthreads();
        mx = fmaxf(fmaxf(fmaxf(red[0], red[1]), fmaxf(red[2], red[3])), fmaxf(fmaxf(red[4], red[5]), fmaxf(red[6], red[7])));
        float sum = 0.f;
        for (int s = tid; s <= t; s += NTHR) { const float p = exp2f(sc[s] - mx); sc[s] = p; sum += p; }
        sum = wave_sum(sum);
        if ((tid & 63) == 0) red[8 + wave] = sum;
        __syncthreads();
        sum = ((red[8] + red[9]) + (red[10] + red[11])) + ((red[12] + red[13]) + (red[14] + red[15]));
        const int d = tid & 127, pt = tid >> 7;
        float o = 0.f;
        for (int s = pt; s <= t; s += 4) o += sc[s] * bf2f(VV[((size_t)b * SEQ + s) * 1024 + h * 128 + d]);
        part[pt * 128 + d] = o;
        __syncthreads();
        if (pt == 0) O[row * 1024 + h * 128 + d] = (bf16)f2bf(((part[d] + part[128 + d]) + (part[256 + d] + part[384 + d])) / sum);
    }
}
__device__ __forceinline__ void decode_naive_phase(const bf16* QN, const bf16* QR, const bf16* WUKVN, const bf16* WUKV, const float* cache_c, const float* cache_kr, const int* page_table,
                                                   const float* c_s, const float* kr_s, float* SC, bf16* O, LAS unsigned char* lds, int wg, int G, int tid) {
    LAS float* ql = (LAS float*)lds;
    LAS float* qr = ql + 8 * 256;
    LAS float* red = qr + 8 * 64;
    LAS float* smx = red + 64;
    LAS float* ssum = smx + 8;
    LAS float* part = ssum + 8;
    const int lane = tid & 63, wave = tid >> 6;
    for (int b = wg; b < DB; b += G) {
        const size_t row = (size_t)MP + b;
        __syncthreads();
        { const int c = tid & 255, hh = tid >> 8;
            for (int h = hh * 4; h < hh * 4 + 4; ++h) { float a = 0.f;
                for (int n = 0; n < 128; ++n) a += bf2f(QN[row * 1024 + h * 128 + n]) * bf2f(WUKVN[(size_t)c * 2048 + h * 256 + n]);
                ql[h * 256 + c] = a; } }
        qr[tid] = bf2f(QR[row * 512 + tid]);
        __syncthreads();
        float* sc = SC + (size_t)b * 8 * SCP;
        float mx[8];
#pragma unroll
        for (int h = 0; h < 8; ++h) mx[h] = -1e30f;
        for (int s = wave; s <= PAST; s += NWAVES) {
            const float* cp; const float* kp;
            if (s < PAST) { const int pg = page_table[b * NPAGES + (s >> 7)]; cp = cache_c + ((size_t)pg * PAGE + (s & 127)) * 256; kp = cache_kr + ((size_t)pg * PAGE + (s & 127)) * 64; }
            else { cp = c_s + (size_t)b * 256; kp = kr_s + (size_t)b * 64; }
            const f32x4 cv = *(const f32x4*)(cp + 4 * lane); const float kv = kp[lane];
#pragma unroll
            for (int h = 0; h < 8; ++h) {
                const f32x4 q4 = *(const LAS f32x4*)(ql + h * 256 + 4 * lane);
                float d = (q4[0] * cv[0] + q4[1] * cv[1]) + (q4[2] * cv[2] + q4[3] * cv[3]) + qr[h * 64 + lane] * kv;
                d = wave_sum(d);
                if (lane == 0) sc[(size_t)h * SCP + s] = d;
                mx[h] = fmaxf(mx[h], d);
            }
        }
#pragma unroll
        for (int h = 0; h < 8; ++h) if (lane == 0) red[h * 8 + wave] = mx[h];
        asm volatile("s_waitcnt vmcnt(0)" ::: "memory");
        __syncthreads();
        if (tid < 8) { float m = red[tid * 8]; for (int w = 1; w < 8; ++w) m = fmaxf(m, red[tid * 8 + w]); smx[tid] = m; }
        __syncthreads();
#pragma unroll
        for (int h = 0; h < 8; ++h) {
            float sum = 0.f; const float m = smx[h];
            for (int s = tid; s <= PAST; s += NTHR) { const float p = exp2f(sc[(size_t)h * SCP + s] - m); sc[(size_t)h * SCP + s] = p; sum += p; }
            sum = wave_sum(sum);
            if (lane == 0) red[h * 8 + wave] = sum;
        }
        asm volatile("s_waitcnt vmcnt(0)" ::: "memory");
        __syncthreads();
        if (tid < 8) { float m = 0.f; for (int w = 0; w < 8; ++w) m += red[tid * 8 + w]; ssum[tid] = m; }
        __syncthreads();
        { const int c = tid & 255, pt = tid >> 8;
            float a[8];
#pragma unroll
            for (int h = 0; h < 8; ++h) a[h] = 0.f;
            for (int s = pt; s <= PAST; s += 2) {
                float cv;
                if (s < PAST) { const int pg = page_table[b * NPAGES + (s >> 7)]; cv = cache_c[((size_t)pg * PAGE + (s & 127)) * 256 + c]; }
                else cv = c_s[(size_t)b * 256 + c];
#pragma unroll
                for (int h = 0; h < 8; ++h) a[h] += sc[(size_t)h * SCP + s] * cv;
            }
#pragma unroll
            for (int h = 0; h < 8; ++h) part[(pt * 8 + h) * 256 + c] = a[h];
        }
        __syncthreads();
        for (int i = tid; i < 8 * 256; i += NTHR) { const int h = i >> 8; ql[i] = (part[i] + part[8 * 256 + i]) / ssum[h]; }
        __syncthreads();
        for (int idx = tid; idx < 1024; idx += NTHR) {
            const int h = idx >> 7; const bf16* w = WUKV + (size_t)(1024 + idx) * 256; float a = 0.f;
            for (int c = 0; c < 256; ++c) a += ql[h * 256 + c] * bf2f(w[c]);
            O[row * 1024 + idx] = (bf16)f2bf(a);
        }
    }
}
typedef float f32x16 __attribute__((ext_vector_type(16)));
__device__ __forceinline__ void attn_prompt_phase(const bf16* QN, const bf16* QR, const bf16* KN, const bf16* KRB, const bf16* VT, bf16* O, LAS unsigned char* lds, int wg, int G, int tid) {
    constexpr int KP = 400, VP = 136, KTB = 64 * KP, VTB = 128 * VP, BUFB = KTB + VTB;
    const int lane = tid & 63, wave = __builtin_amdgcn_readfirstlane(tid >> 6), r32 = lane & 31, hh = lane >> 5;
    const int c0 = tid, c1 = tid + 512;
    for (int unit = wg; unit < 256; unit += G) {
        const int bh = unit >> 2, pr = unit & 3, b = bh >> 3, h = bh & 7;
        for (int half = 0; half < 2; ++half) {
            const int qb = half ? 7 - pr : pr; const int ntiles = 4 * (qb + 1); const int q0 = 256 * qb + 32 * wave;
            const size_t qrow = (size_t)b * SEQ + q0 + r32;
            bf16x8 Qf[12];
#pragma unroll
            for (int ks = 0; ks < 8; ++ks) Qf[ks] = *(const bf16x8*)(QN + qrow * 1024 + h * 128 + 16 * ks + 8 * hh);
#pragma unroll
            for (int ks = 0; ks < 4; ++ks) Qf[8 + ks] = *(const bf16x8*)(QR + qrow * 512 + h * 64 + 16 * ks + 8 * hh);
            f32x16 Oa[4];
#pragma unroll
            for (int nb = 0; nb < 4; ++nb)
#pragma unroll
                for (int i = 0; i < 16; ++i) Oa[nb][i] = 0.f;
            float m = -1e30f, l = 0.f;
            v4u sk0, sk1, skr, sv0, sv1;
#define ATT_LOAD(kt) do { const size_t key0 = (size_t)b * SEQ + 64 * (kt); \
                sk0 = *(const v4u*)(KN + (key0 + (c0 >> 4)) * 1024 + h * 128 + (c0 & 15) * 8); sk1 = *(const v4u*)(KN + (key0 + (c1 >> 4)) * 1024 + h * 128 + (c1 & 15) * 8); \
                skr = *(const v4u*)(KRB + (key0 + (tid >> 3)) * 64 + (tid & 7) * 8); \
                sv0 = *(const v4u*)(VT + (size_t)(h * 128 + (c0 >> 3)) * MP + key0 + (c0 & 7) * 8); sv1 = *(const v4u*)(VT + (size_t)(h * 128 + (c1 >> 3)) * MP + key0 + (c1 & 7) * 8); } while (0)
#define ATT_WRITE(bi) do { LAS unsigned char* base = lds + (bi) * BUFB; \
                *(LAS v4u*)(base + (c0 >> 4) * KP + (c0 & 15) * 16) = sk0; *(LAS v4u*)(base + (c1 >> 4) * KP + (c1 & 15) * 16) = sk1; *(LAS v4u*)(base + (tid >> 3) * KP + 256 + (tid & 7) * 16) = skr; \
                { LAS v2u* p = (LAS v2u*)(base + KTB + (c0 >> 3) * VP + (c0 & 7) * 16); p[0] = (v2u){sv0.x, sv0.y}; p[1] = (v2u){sv0.z, sv0.w}; } \
                { LAS v2u* p = (LAS v2u*)(base + KTB + (c1 >> 3) * VP + (c1 & 7) * 16); p[0] = (v2u){sv1.x, sv1.y}; p[1] = (v2u){sv1.z, sv1.w}; } } while (0)
            ATT_LOAD(0); ATT_WRITE(0);
            __syncthreads();
            for (int kt = 0; kt < ntiles; ++kt) {
                if (kt + 1 < ntiles) ATT_LOAD(kt + 1);
                if (64 * kt <= q0 + 31) {
                    const LAS unsigned char* kb_ = lds + (kt & 1) * BUFB; const LAS unsigned char* vb_ = kb_ + KTB;
                    for (int kb = 0; kb < 2; ++kb) {
                        if (64 * kt + 32 * kb > q0 + 31) break;
                        f32x16 X;
#pragma unroll
                        for (int i = 0; i < 16; ++i) X[i] = 0.f;
                        const LAS unsigned char* kp = kb_ + (32 * kb + r32) * KP + hh * 16;
#pragma unroll
                        for (int ks = 0; ks < 12; ++ks) {
                            const bf16x8 kf = *(const LAS bf16x8*)(kp + ks * 32);
                            X = __builtin_amdgcn_mfma_f32_32x32x16_bf16(kf, Qf[ks], X, 0, 0, 0);
                            if ((ks & 3) == 3) asm volatile("" ::: "memory");
                        }
                        if (64 * kt + 32 * kb + 31 > q0) {
                            const int qi = q0 + r32, kbase = 64 * kt + 32 * kb + 4 * hh;
#pragma unroll
                            for (int i = 0; i < 16; ++i) { const int kr = kbase + (i & 3) + 8 * (i >> 2); if (kr > qi) X[i] = -1e30f; }
                        }
                        float mx = X[0];
#pragma unroll
                        for (int i = 1; i < 16; ++i) mx = fmaxf(mx, X[i]);
                        mx = fmaxf(mx, shx(mx, 32, lane));
                        const float mn = fmaxf(m, mx), alpha = __builtin_amdgcn_exp2f(m - mn); m = mn;
                        float ls = 0.f;
#pragma unroll
                        for (int i = 0; i < 16; ++i) { X[i] = __builtin_amdgcn_exp2f(X[i] - mn); ls += X[i]; }
                        l = l * alpha + ls;
                        if (__any(alpha != 1.0f)) {
#pragma unroll
                            for (int nb = 0; nb < 4; ++nb)
#pragma unroll
                                for (int i = 0; i < 16; ++i) Oa[nb][i] *= alpha;
                        }
                        bf16x8 Pf[2];
#pragma unroll
                        for (int s = 0; s < 2; ++s) {
                            v4u w0;
                            w0.x = pg8::cvt_pk_bf16(X[8 * s + 0], X[8 * s + 1]); w0.y = pg8::cvt_pk_bf16(X[8 * s + 2], X[8 * s + 3]); w0.z = pg8::cvt_pk_bf16(X[8 * s + 4], X[8 * s + 5]); w0.w = pg8::cvt_pk_bf16(X[8 * s + 6], X[8 * s + 7]);
                            Pf[s] = __builtin_bit_cast(bf16x8, w0);
                        }
                        const LAS unsigned char* vp0 = vb_ + r32 * VP + (32 * kb + 4 * hh) * 2;
#pragma unroll
                        for (int nb = 0; nb < 4; ++nb) {
#pragma unroll
                            for (int s = 0; s < 2; ++s) {
                                const LAS unsigned char* vp = vp0 + 32 * nb * VP + 32 * s;
                                const v2u a0 = *(const LAS v2u*)vp, a1 = *(const LAS v2u*)(vp + 16);
                                const v4u av = (v4u){a0.x, a0.y, a1.x, a1.y};
                                Oa[nb] = __builtin_amdgcn_mfma_f32_32x32x16_bf16(__builtin_bit_cast(bf16x8, av), Pf[s], Oa[nb], 0, 0, 0);
                            }
                            if (nb & 1) asm volatile("" ::: "memory");
                        }
                    }
                }
                if (kt + 1 < ntiles) ATT_WRITE((kt + 1) & 1);
                __syncthreads();
            }
#undef ATT_LOAD
#undef ATT_WRITE
            l += shx(l, 32, lane);
            const float inv = 1.0f / l;
            bf16* orow = O + qrow * 1024 + h * 128;
#pragma unroll
            for (int nb = 0; nb < 4; ++nb)
#pragma unroll
                for (int g = 0; g < 4; ++g) {
                    v2u w; w.x = pk2(Oa[nb][4 * g + 0] * inv, Oa[nb][4 * g + 1] * inv); w.y = pk2(Oa[nb][4 * g + 2] * inv, Oa[nb][4 * g + 3] * inv);
                    *(v2u*)(orow + 32 * nb + 8 * g + 4 * hh) = w;
                }
        }
    }
}
typedef float f32x4v __attribute__((ext_vector_type(4)));
__device__ __forceinline__ void hgrn_phase(const bf16* QB, const float* GB, const bf16* VB, const bf16* GATE, const float* gnorm, const float* s0, float* st_p, float* st_s, bf16* OG,
                                           LAS unsigned char* lds, int wg, int G, int tid) {
    constexpr int QDP = 272, TP = 80;
    const int lane = tid & 63, wave = __builtin_amdgcn_readfirstlane(tid >> 6), l15 = lane & 15, q4 = lane >> 4;
    if (wg < 64) {
        LAS unsigned char* QD = lds; LAS unsigned char* KD = QD + 32 * QDP; LAS unsigned char* KLT = KD + 32 * QDP; LAS unsigned char* VTt = KLT + 128 * TP; LAS unsigned char* AM = VTt + 128 * TP;
        LAS float* Dv = (LAS float*)(AM + 32 * TP); LAS float* tot = Dv + 128; LAS float* ssq = tot + 512;
        const int kc = tid & 127, tg = tid >> 7;
        for (int unit = wg; unit < 64; unit += G) {
            const int b = unit >> 3, h = unit & 7; const size_t row0 = (size_t)b * SEQ;
            f32x4v S[8];
#pragma unroll
            for (int kt = 0; kt < 8; ++kt) S[kt] = (f32x4v){0.f, 0.f, 0.f, 0.f};
            const float gn = gnorm[h * 128 + 16 * wave + l15];
            float gr[8]; unsigned qr[8], vr[8];
#define HG_LOAD(c) do { _Pragma("unroll") for (int i = 0; i < 8; ++i) { const size_t o_ = (row0 + 32 * (c) + 8 * tg + i) * 1024 + h * 128 + kc; gr[i] = GB[o_]; qr[i] = QB[o_]; vr[i] = VB[o_]; } } while (0)
            HG_LOAD(0);
            for (int c = 0; c < SEQ / 32; ++c) {
                float p[8]; p[0] = gr[0];
#pragma unroll
                for (int i = 1; i < 8; ++i) p[i] = p[i - 1] + gr[i];
                tot[tg * 128 + kc] = p[7];
                __syncthreads();
                float off = 0.f, blast = 0.f;
#pragma unroll
                for (int j = 0; j < 4; ++j) { const float tv = tot[j * 128 + kc]; blast += tv; if (j < tg) off += tv; }
                float kl[8];
#pragma unroll
                for (int i = 0; i < 8; ++i) {
                    const float bc = off + p[i], e = __expf(bc), kk = -expm1f(gr[i]);
                    const float qd = bf2f(qr[i]) * e, kd = kk * __expf(-fmaxf(bc, -80.f)); kl[i] = kk * __expf(blast - bc);
                    *(LAS bf16*)(QD + (8 * tg + i) * QDP + kc * 2) = (bf16)f2bf(qd);
                    *(LAS bf16*)(KD + (8 * tg + i) * QDP + kc * 2) = (bf16)f2bf(kd);
                }
                *(LAS v4u*)(KLT + kc * TP + tg * 16) = (v4u){pk2(kl[0], kl[1]), pk2(kl[2], kl[3]), pk2(kl[4], kl[5]), pk2(kl[6], kl[7])};
                *(LAS v4u*)(VTt + kc * TP + tg * 16) = (v4u){vr[0] | (vr[1] << 16), vr[2] | (vr[3] << 16), vr[4] | (vr[5] << 16), vr[6] | (vr[7] << 16)};
                if (tg == 0) Dv[kc] = __expf(blast);
                __syncthreads();
                if (c + 1 < SEQ / 32) HG_LOAD(c + 1);
                unsigned gt[8];
#pragma unroll
                for (int i = 0; i < 8; ++i) gt[i] = GATE[(row0 + 32 * c + 16 * (i >> 2) + 4 * q4 + (i & 3)) * 1024 + h * 128 + 16 * wave + l15];
                if (wave < 4) {
                    const int ti = wave >> 1, si = wave & 1; f32x4v a = (f32x4v){0.f, 0.f, 0.f, 0.f};
                    if (si <= ti) {
#pragma unroll
                        for (int ks = 0; ks < 4; ++ks) {
                            const bf16x8 af = *(const LAS bf16x8*)(QD + (16 * ti + l15) * QDP + 64 * ks + 16 * q4), bfr = *(const LAS bf16x8*)(KD + (16 * si + l15) * QDP + 64 * ks + 16 * q4);
                            a = __builtin_amdgcn_mfma_f32_16x16x32_bf16(af, bfr, a, 0, 0, 0);
                        }
                    }
#pragma unroll
                    for (int r = 0; r < 4; ++r) { const int t = 16 * ti + 4 * q4 + r, s = 16 * si + l15; *(LAS bf16*)(AM + t * TP + s * 2) = (bf16)f2bf(s <= t ? a[r] : 0.f); }
                }
                __syncthreads();
                const bf16x8 vtf = *(const LAS bf16x8*)(VTt + (16 * wave + l15) * TP + 16 * q4);
                bf16x8 Sb[4];
#pragma unroll
                for (int ks = 0; ks < 4; ++ks) { const v4u w = (v4u){pk2(S[2 * ks][0], S[2 * ks][1]), pk2(S[2 * ks][2], S[2 * ks][3]), pk2(S[2 * ks + 1][0], S[2 * ks + 1][1]), pk2(S[2 * ks + 1][2], S[2 * ks + 1][3])}; Sb[ks] = __builtin_bit_cast(bf16x8, w); }
                f32x4v o[2];
#pragma unroll
                for (int tt = 0; tt < 2; ++tt) {
                    const bf16x8 amf = *(const LAS bf16x8*)(AM + (16 * tt + l15) * TP + 16 * q4);
                    o[tt] = __builtin_amdgcn_mfma_f32_16x16x32_bf16(amf, vtf, (f32x4v){0.f, 0.f, 0.f, 0.f}, 0, 0, 0);
#pragma unroll
                    for (int ks = 0; ks < 4; ++ks) {
                        const LAS unsigned char* qp = QD + (16 * tt + l15) * QDP + (32 * ks + 4 * q4) * 2;
                        const v2u a0 = *(const LAS v2u*)qp, a1 = *(const LAS v2u*)(qp + 32);
                        const v4u av = (v4u){a0.x, a0.y, a1.x, a1.y};
                        o[tt] = __builtin_amdgcn_mfma_f32_16x16x32_bf16(__builtin_bit_cast(bf16x8, av), Sb[ks], o[tt], 0, 0, 0);
                    }
                }
#pragma unroll
                for (int kt = 0; kt < 8; ++kt) {
                    const f32x4v d4 = *(const LAS f32x4v*)(Dv + 16 * kt + 4 * q4);
                    const bf16x8 klf = *(const LAS bf16x8*)(KLT + (16 * kt + l15) * TP + 16 * q4);
                    S[kt] = __builtin_amdgcn_mfma_f32_16x16x32_bf16(klf, vtf, S[kt] * d4, 0, 0, 0);
                }
#pragma unroll
                for (int tt = 0; tt < 2; ++tt)
#pragma unroll
                    for (int r = 0; r < 4; ++r) { float ss = o[tt][r] * o[tt][r]; ss += shx(ss, 1, lane); ss += shx(ss, 2, lane); ss += shx(ss, 4, lane); ss += shx(ss, 8, lane);
                        if (l15 == 0) ssq[(16 * tt + 4 * q4 + r) * 8 + wave] = ss; }
                __syncthreads();
#pragma unroll
                for (int tt = 0; tt < 2; ++tt)
#pragma unroll
                    for (int r = 0; r < 4; ++r) { const int t = 16 * tt + 4 * q4 + r;
                        const f32x4v s0v = *(const LAS f32x4v*)(ssq + t * 8), s1v = *(const LAS f32x4v*)(ssq + t * 8 + 4);
                        const float rs = rsqrtf(((s0v[0] + s0v[1]) + (s0v[2] + s0v[3]) + (s1v[0] + s1v[1]) + (s1v[2] + s1v[3])) * (1.f / 128.f) + EPS);
                        OG[(row0 + 32 * c + t) * 1024 + h * 128 + 16 * wave + l15] = (bf16)f2bf(o[tt][r] * rs * gn * bf2f(gt[4 * tt + r])); }
            }
#undef HG_LOAD
            float* so = st_p + ((size_t)b * HA + h) * DK * DV + 16 * wave + l15;
#pragma unroll
            for (int kt = 0; kt < 8; ++kt)
#pragma unroll
                for (int r = 0; r < 4; ++r) so[(size_t)(16 * kt + 4 * q4 + r) * DV] = S[kt][r];
            __syncthreads();
        }
    }
    if (G <= 64 || wg >= 64) {
        LAS float* sq = (LAS float*)lds; LAS float* sf = sq + 128; LAS float* skk = sf + 128; LAS float* sv = skk + 128; LAS float* red = sv + 128; LAS float* po = red + 16;
        const int first = G > 64 ? wg - 64 : wg, step = G > 64 ? G - 64 : G;
        for (int unit = first; unit < DB * HA; unit += step) {
            const int b = unit >> 3, h = unit & 7; const size_t idx = ((size_t)MP + b) * 1024 + h * 128 + (tid & 127); const size_t sb = ((size_t)b * HA + h) * DK * DV;
            __syncthreads();
            if (tid < 128) { sq[tid] = bf2f(QB[idx]); const float g = GB[idx]; sf[tid] = expf(g); skk[tid] = -expm1f(g); sv[tid] = bf2f(VB[idx]); }
            __syncthreads();
            const int dv4 = (tid & 31) * 4, kg = tid >> 5;
            const f32x4v vv = *(const LAS f32x4v*)(sv + dv4); f32x4v oacc = (f32x4v){0.f, 0.f, 0.f, 0.f};
#pragma unroll
            for (int i = 0; i < 8; ++i) { const int k = kg + 16 * i; const f32x4v s = *(const f32x4v*)(s0 + sb + (size_t)k * DV + dv4);
                const f32x4v sn = s * sf[k] + vv * skk[k]; *(f32x4v*)(st_s + sb + (size_t)k * DV + dv4) = sn; oacc += sn * sq[k]; }
            *(LAS f32x4v*)(po + kg * 128 + dv4) = oacc;
            __syncthreads();
            float ov = 0.f;
            if (tid < 128) {
#pragma unroll
                for (int j = 0; j < 16; ++j) ov += po[j * 128 + tid];
            }
            const float ss = wave_sum(ov * ov);
            if (tid < 128 && lane == 0) red[wave] = ss;
            __syncthreads();
            if (tid < 128) { const float rs = rsqrtf((red[0] + red[1]) * (1.f / 128.f) + EPS); OG[idx] = (bf16)f2bf(ov * rs * gnorm[h * 128 + tid] * bf2f(GATE[idx])); }
        }
    }
}
constexpr int NPH = 1 + 4 * 10;
__host__ __device__ constexpr bool phase_exists(int k) {
    if (k == 0) return true;
    const int l = (k - 1) / 10, s = (k - 1) % 10;
    if (l < 2) return !(s == 2 || s == 3 || s == 4);
    return s != 3 || l == 2;
}
struct Args { const float* in[21]; float* out; unsigned char* ws; int ph_lo, ph_hi, li, pad; };


__device__ __forceinline__ unsigned long long karg64(int byte_off) {
    unsigned long long v;
    asm volatile("s_load_dwordx2 %0, %1, %2\n\ts_waitcnt lgkmcnt(0)" : "=s"(v) : "s"(__builtin_amdgcn_kernarg_segment_ptr()), "i"(byte_off) : "memory");
    return v;
}
__device__ __forceinline__ int karg32(int byte_off) {
    int v;
    asm volatile("s_load_dword %0, %1, %2\n\ts_waitcnt lgkmcnt(0)" : "=s"(v) : "s"(__builtin_amdgcn_kernarg_segment_ptr()), "i"(byte_off) : "memory");
    return v;
}
#define ARG_IN(i) ((const float*)karg64(8 * (i)))
#define ARG_OUT() ((float*)karg64(8 * 21))
#define ARG_WS() ((unsigned char*)karg64(8 * 22))
struct Ctx { LAS unsigned char* lds; int tid, lane, wave, wg, G, gw, NGW; };
__device__ __forceinline__ Ctx fresh(const Ctx& c0) {
    Ctx c; c.lds = c0.lds; int wv = c0.wave; asm volatile("" : "+s"(wv)); int t = wv * 64 + lane_id_v(); int w = blockIdx.x; asm volatile("" : "+s"(w)); int g = gridDim.x; asm volatile("" : "+s"(g));
    c.tid = t; c.lane = t & 63; c.wave = __builtin_amdgcn_readfirstlane(t >> 6); c.wg = w; c.G = g; c.gw = w * NWAVES + c.wave; c.NGW = g * NWAVES; return c;
}

__device__ __forceinline__ void ph_prologue(const Ctx& c0) {
    const Ctx c = fresh(c0);
    unsigned char* ws = ARG_WS();
    const float* norm_gains = ARG_IN(6);
    LAS float* scr = (LAS float*)(c.lds + c.wave * 16384);
    constexpr int NITEMS = 4096 + 1024 + 11264 + 5632 + 192 + 160 + 192 + 576 + 256 + 1024;
    for (int it = c.gw; it < NITEMS; it += c.NGW) {
        int r = it, l; const float* W; int K, N, kind = 0; bf16* WT; const float* gain = nullptr; float scale = 1.f;
        if (r < 4096) { l = r / 2048; r -= l * 2048; W = ARG_IN(9) + (size_t)l * 1024 * 4096; K = 1024; N = 4096; WT = (bf16*)(ws + WS_WIN) + (size_t)l * 4096 * 1024; gain = norm_gains + (l * 4 + 0) * 1024; }
        else if ((r -= 4096) < 1024) { l = r / 512; r -= l * 512; W = ARG_IN(12) + (size_t)l * 1024 * 1024; K = 1024; N = 1024; WT = (bf16*)(ws + WS_WOUTA) + (size_t)l * 1024 * 1024; }
        else if ((r -= 1024) < 11264) { l = r / 2816; r -= l * 2816; W = ARG_IN(7) + (size_t)l * 1024 * 5632; K = 1024; N = 5632; WT = (bf16*)(ws + WS_WFIN) + (size_t)l * 5632 * 1024; kind = 1; gain = norm_gains + (l * 4 + 2) * 1024; }
        else if ((r -= 11264) < 5632) { l = r / 1408; r -= l * 1408; W = ARG_IN(8) + (size_t)l * 2816 * 1024; K = 2816; N = 1024; WT = (bf16*)(ws + WS_WFOUT) + (size_t)l * 1024 * 2816; }
        else if ((r -= 5632) < 192) { W = ARG_IN(17); K = 1024; N = 384; WT = (bf16*)(ws + WS_WDQ0); gain = norm_gains + (2 * 4 + 0) * 1024; }
        else if ((r -= 192) < 160) { W = ARG_IN(14); K = 1024; N = 320; WT = (bf16*)(ws + WS_WDQ0); kind = 2; gain = ARG_IN(13); }
        else if ((r -= 160) < 192) { W = ARG_IN(17) + (size_t)1024 * 384; K = 1024; N = 384; WT = (bf16*)(ws + WS_WDQ1); gain = norm_gains + (3 * 4 + 0) * 1024; }
        else if ((r -= 192) < 576) { l = r / 288; r -= l * 288; W = ARG_IN(19) + (size_t)l * 384 * 1536; K = 384; N = 1536; WT = (bf16*)(ws + WS_WUQ) + (size_t)l * 1536 * 384; kind = 3; gain = ARG_IN(18) + l * 384; scale = QSCALE; }
        else if ((r -= 576) < 256) { W = ARG_IN(16); K = 256; N = 2048; WT = (bf16*)(ws + WS_WUKV); kind = 4; }
        else { r -= 256; l = r / 512; r -= l * 512; W = ARG_IN(20) + (size_t)l * 1024 * 1024; K = 1024; N = 1024; WT = (bf16*)(ws + WS_WOUTB) + (size_t)l * 1024 * 1024; }
        cvt_item(W, K, N, WT, kind, gain, scale, scr, r, c.lane);
    }
    const size_t gt = (size_t)c.wg * NTHR + c.tid, NT = (size_t)c.G * NTHR;
    { bf16* WDQ0 = (bf16*)(ws + WS_WDQ0); bf16* WDQ1 = (bf16*)(ws + WS_WDQ1);
      for (size_t i = gt; i < (size_t)64 * 1024 / 8; i += NT) ((v4u*)(WDQ0 + (size_t)704 * 1024))[i] = (v4u){0u, 0u, 0u, 0u};
      for (size_t i = gt; i < (size_t)128 * 1024 / 8; i += NT) ((v4u*)(WDQ1 + (size_t)384 * 1024))[i] = (v4u){0u, 0u, 0u, 0u}; }
    { const float* w_ukv = ARG_IN(16); bf16* WUKVN = (bf16*)(ws + WS_WUKVN);
      for (size_t i = gt; i < (size_t)256 * 2048 / 4; i += NT) { const f32x4 v = ((const f32x4*)w_ukv)[i]; v2u w; w.x = pk2(v[0], v[1]); w.y = pk2(v[2], v[3]); ((v2u*)WUKVN)[i] = w; } }
    { float* CS = (float*)(ws + WS_CS);
      for (size_t i = gt; i < (size_t)2049 * 32; i += NT) { const int p = (int)(i >> 5), fi = (int)(i & 31); const double pos = p < 2048 ? (double)p : (double)PAST;
        const double ang = pos * pow(10000.0, -(double)fi / 32.0); CS[2 * i] = (float)cos(ang); CS[2 * i + 1] = (float)sin(ang); } }
    { float* LBT = (float*)(ws + WS_LBT); const float* lb_logits = ARG_IN(10);
      for (size_t i = gt; i < 2048; i += NT) { const int l = (int)(i >> 10), d = (int)(i & 1023); float lb = 0.f;
        if (l == 1) lb = 1.f / (1.f + expf(lb_logits[d] - lb_logits[1024 + d]));
        LBT[2 * i] = logf(fmaxf(lb, 1e-30f)); LBT[2 * i + 1] = log1pf(-lb); } }
    { const float* x_prompt = ARG_IN(0); const float* x_sample = ARG_IN(1); float* X = ARG_OUT(); bf16* HN = (bf16*)(ws + WS_HN);
      for (int m = c.gw; m < M; m += c.NGW) {
        const f32x4* xr = (const f32x4*)(m < MP ? x_prompt + (size_t)m * D : x_sample + (size_t)(m - MP) * D) + c.lane; f32x4* xo = (f32x4*)(X + (size_t)m * D) + c.lane;
        f32x4 v[4]; float s = 0.f;
#pragma unroll
        for (int j = 0; j < 4; ++j) { v[j] = xr[64 * j]; xo[64 * j] = v[j]; s += (v[j][0] * v[j][0] + v[j][1] * v[j][1]) + (v[j][2] * v[j][2] + v[j][3] * v[j][3]); }
        const float r = rsqrtf(wave_sum(s) * (1.f / 1024.f) + EPS);
        v2u* o8 = (v2u*)(HN + (size_t)m * D) + c.lane;
#pragma unroll
        for (int j = 0; j < 4; ++j) { v2u w; w.x = pk2(v[j][0] * r, v[j][1] * r); w.y = pk2(v[j][2] * r, v[j][3] * r); o8[64 * j] = w; }
      } }
}
__device__ __forceinline__ void ph_hgrn_in(const Ctx& c0, int l) {
    const Ctx c = fresh(c0);
    unsigned char* ws = ARG_WS();
    const bf16* HN = (const bf16*)(ws + WS_HN); const bf16* Wt = (const bf16*)(ws + WS_WIN) + (size_t)l * 4096 * 1024; const float* lbt = (const float*)(ws + WS_LBT) + (size_t)l * 2048;
    bf16* QB = (bf16*)(ws + WS_QB); float* GB = (float*)(ws + WS_GB); bf16* VB = (bf16*)(ws + WS_VB); bf16* GATE = (bf16*)(ws + WS_GATE);
    pg8::Gemm g{HN, Wt, MP, 4096, 1024}; pg8::StaticOrder S; S.init(MP, 4096, c.G, c.wg);
    pg8::EpiHgrnIn E{ws, l};
    pg8::gemm_phase<pg8::EpiHgrnIn, pg8::StaticOrder, true, true>(c.lds, g, S, E, c.tid);
    const Ctx c2 = fresh(c0);
    sg_hgrn_in(HN, Wt, QB, GB, VB, GATE, lbt, c2.gw, c2.NGW, c2.lane);
}
__device__ __forceinline__ void ph_hgrn_rec(const Ctx& c0, int l) {
    const Ctx c = fresh(c0);
    unsigned char* ws = ARG_WS(); float* X = ARG_OUT();
    float* st_p = X + (size_t)M * D; float* st_s = st_p + (size_t)2 * BATCH * HA * DK * DV + (size_t)MP * KVL + (size_t)MP * 64;
    hgrn_phase((const bf16*)(ws + WS_QB), (const float*)(ws + WS_GB), (const bf16*)(ws + WS_VB), (const bf16*)(ws + WS_GATE), ARG_IN(11) + (size_t)l * D, ARG_IN(2) + (size_t)l * DB * HA * DK * DV,
                     st_p + (size_t)l * BATCH * HA * DK * DV, st_s + (size_t)l * DB * HA * DK * DV, (bf16*)(ws + WS_OG), c.lds, c.wg, c.G, c.tid);
}
__device__ __forceinline__ void ph_dq(const Ctx& c0, int j) {
    const Ctx c = fresh(c0);
    unsigned char* ws = ARG_WS();
    const int N = (j == 0) ? 768 : 512; const bf16* Wt = (const bf16*)(ws + ((j == 0) ? WS_WDQ0 : WS_WDQ1)); const bf16* HN = (const bf16*)(ws + WS_HN); float* QC = (float*)(ws + WS_QC);
    pg8::Gemm g{HN, Wt, MP, N, 1024}; pg8::StaticOrder S; S.init(MP, N, c.G, c.wg);
    pg8::EpiF32 E{QC, QCP};
    pg8::gemm_phase<pg8::EpiF32, pg8::StaticOrder, true, true>(c.lds, g, S, E, c.tid);
    const Ctx c2 = fresh(c0);
    sg_f32(HN, 1024, Wt, N, QC, QCP, c2.gw, c2.NGW, c2.lane);
}
__device__ __forceinline__ void ph_qnorm(const Ctx& c0, int j) {
    const Ctx c = fresh(c0);
    unsigned char* ws = ARG_WS(); float* X = ARG_OUT();
    float* c_p = X + (size_t)M * D + (size_t)2 * BATCH * HA * DK * DV; float* kr_p = c_p + (size_t)MP * KVL; float* c_s = kr_p + (size_t)MP * 64 + (size_t)2 * DB * HA * DK * DV; float* kr_s = c_s + (size_t)DB * KVL;
    const float* QC = (const float*)(ws + WS_QC); bf16* QAN = (bf16*)(ws + WS_QAN); bf16* CB = (bf16*)(ws + WS_CB); bf16* KRB = (bf16*)(ws + WS_KRB); const float* CS = (const float*)(ws + WS_CS);
    const float* kv_a_norm = ARG_IN(15); const int lane = c.lane;
    for (int m = c.gw; m < M; m += c.NGW) {
        const float* qc = QC + (size_t)m * QCP;
        float v[6]; float s = 0.f;
#pragma unroll
        for (int i = 0; i < 6; ++i) { v[i] = qc[lane + 64 * i]; s += v[i] * v[i]; }
        const float r = rsqrtf(wave_sum(s) * (1.f / 384.f) + EPS);
#pragma unroll
        for (int i = 0; i < 6; ++i) QAN[(size_t)m * QL + lane + 64 * i] = (bf16)f2bf(v[i] * r);
        if (j == 0) {
            float cc[4]; float s2 = 0.f;
#pragma unroll
            for (int i = 0; i < 4; ++i) { cc[i] = qc[384 + lane + 64 * i]; s2 += cc[i] * cc[i]; }
            const float r2 = rsqrtf(wave_sum(s2) * (1.f / 256.f) + EPS);
            float* co = m < MP ? c_p + (size_t)m * KVL : c_s + (size_t)(m - MP) * KVL;
#pragma unroll
            for (int i = 0; i < 4; ++i) { const float o = cc[i] * r2 * kv_a_norm[lane + 64 * i]; co[lane + 64 * i] = o; CB[(size_t)m * KVL + lane + 64 * i] = (bf16)f2bf(o); }
            if (lane < 32) {
                const float x1 = qc[640 + lane], x2 = qc[672 + lane]; const int p = m < MP ? (m & (SEQ - 1)) : 2048;
                const float cs = CS[(size_t)(p * 32 + lane) * 2], sn = CS[(size_t)(p * 32 + lane) * 2 + 1];
                const float o1 = x1 * cs - x2 * sn, o2 = x2 * cs + x1 * sn;
                float* ko = m < MP ? kr_p + (size_t)m * 64 : kr_s + (size_t)(m - MP) * 64;
                ko[lane] = o1; ko[32 + lane] = o2;
                if (m < MP) ((unsigned*)(KRB + (size_t)m * 64))[lane] = pk2(o1, o2);
            }
        }
    }
}
__device__ __forceinline__ void ph_uq(const Ctx& c0, int j) {
    const Ctx c = fresh(c0);
    unsigned char* ws = ARG_WS();
    const bf16* QAN = (const bf16*)(ws + WS_QAN); const bf16* Wt = (const bf16*)(ws + WS_WUQ) + (size_t)j * 1536 * 384; bf16* QN = (bf16*)(ws + WS_QN); bf16* QR = (bf16*)(ws + WS_QR); const float* CS = (const float*)(ws + WS_CS);
    { pg8::Gemm g{QAN, Wt, MP, 1024, QL}; pg8::StaticOrder S; S.init(MP, 1024, c.G, c.wg);
      pg8::EpiBf16Split E{QN, 1024, 0, 0};
      pg8::gemm_phase<pg8::EpiBf16Split, pg8::StaticOrder, true, true>(c.lds, g, S, E, c.tid); }
    { const Ctx c1 = fresh(c0);
      pg8::Gemm g{QAN, Wt + (size_t)1024 * QL, MP, 512, QL}; pg8::StaticOrder S; S.init(MP, 512, c1.G, c1.wg);
      pg8::EpiRope E{ws};
      pg8::gemm_phase<pg8::EpiRope, pg8::StaticOrder, true, true>(c1.lds, g, S, E, c1.tid); }
    const Ctx c2 = fresh(c0);
    sg_uq(QAN, Wt, QN, QR, CS, c2.gw, c2.NGW, c2.lane);
}
__device__ __forceinline__ void ph_kvup(const Ctx& c0) {
    const Ctx c = fresh(c0);
    unsigned char* ws = ARG_WS();
    {
        pg8::Gemm g{(const bf16*)(ws + WS_CB), (const bf16*)(ws + WS_WUKV), MP, 1024, KVL}; pg8::StaticOrder S; S.init(MP, 1024, c.G, c.wg);
        pg8::EpiBf16Split E{(bf16*)(ws + WS_KN), 1024, 0, 0};
        pg8::gemm_phase<pg8::EpiBf16Split, pg8::StaticOrder, true, true>(c.lds, g, S, E, c.tid); }
    {
        const Ctx c1 = fresh(c0);
        pg8::Gemm g{(const bf16*)(ws + WS_WUKV) + (size_t)1024 * KVL, (const bf16*)(ws + WS_CB), 1024, MP, KVL}; pg8::StaticOrder S; S.init(1024, MP, c1.G, c1.wg);
        pg8::EpiBf16Split E{(bf16*)(ws + WS_VV), MP, 0, 0};
        pg8::gemm_phase<pg8::EpiBf16Split, pg8::StaticOrder, true, true>(c1.lds, g, S, E, c1.tid); }
}
__device__ __forceinline__ void ph_attn(const Ctx& c0) {
    const Ctx c = fresh(c0);
    unsigned char* ws = ARG_WS(); float* X = ARG_OUT();
    float* c_s = X + (size_t)M * D + (size_t)2 * BATCH * HA * DK * DV + (size_t)MP * KVL + (size_t)MP * 64 + (size_t)2 * DB * HA * DK * DV; float* kr_s = c_s + (size_t)DB * KVL;
    attn_prompt_phase((const bf16*)(ws + WS_QN), (const bf16*)(ws + WS_QR), (const bf16*)(ws + WS_KN), (const bf16*)(ws + WS_KRB), (const bf16*)(ws + WS_VV), (bf16*)(ws + WS_OG), c.lds, c.wg, c.G, c.tid);
    decode_naive_phase((const bf16*)(ws + WS_QN), (const bf16*)(ws + WS_QR), (const bf16*)(ws + WS_WUKVN), (const bf16*)(ws + WS_WUKV), ARG_IN(3), ARG_IN(4), (const int*)ARG_IN(5), c_s, kr_s,
                       (float*)(ws + WS_SC), (bf16*)(ws + WS_OG), c.lds, c.wg, c.G, c.tid);
}
__device__ __forceinline__ void ph_mixout(const Ctx& c0, int l) {
    const Ctx c = fresh(c0);
    unsigned char* ws = ARG_WS();
    const bf16* Wt = (l < 2) ? (const bf16*)(ws + WS_WOUTA) + (size_t)l * 1024 * 1024 : (const bf16*)(ws + WS_WOUTB) + (size_t)(l - 2) * 1024 * 1024;
    const bf16* OG = (const bf16*)(ws + WS_OG); float* MIX = (float*)(ws + WS_MIX);
    pg8::Gemm g{OG, Wt, MP, 1024, 1024}; pg8::StaticOrder S; S.init(MP, 1024, c.G, c.wg);
    pg8::EpiF32 E{MIX, 1024};
    pg8::gemm_phase<pg8::EpiF32, pg8::StaticOrder, true, true>(c.lds, g, S, E, c.tid);
    const Ctx c2 = fresh(c0);
    sg_f32(OG, 1024, Wt, 1024, MIX, 1024, c2.gw, c2.NGW, c2.lane);
}
__device__ __forceinline__ void ph_resid(const Ctx& c0, int l, int which) {
    const Ctx c = fresh(c0);
    unsigned char* ws = ARG_WS(); float* X = ARG_OUT(); const float* gain = ARG_IN(6) + (size_t)(l * 4 + which) * D;
    const float* MIX = (const float*)(ws + WS_MIX); bf16* HN = (bf16*)(ws + WS_HN);
    for (int m = c.gw; m < M; m += c.NGW) row_resid_norm(MIX + (size_t)m * D, X + (size_t)m * D, gain, HN + (size_t)m * D, c.lane);
}
__device__ __forceinline__ void ph_ffn_in(const Ctx& c0, int l) {
    const Ctx c = fresh(c0);
    unsigned char* ws = ARG_WS();
    const bf16* HN = (const bf16*)(ws + WS_HN); const bf16* Wt = (const bf16*)(ws + WS_WFIN) + (size_t)l * 5632 * 1024; bf16* ACT = (bf16*)(ws + WS_ACT);
    pg8::Gemm g{HN, Wt, MP, 5632, 1024}; pg8::StaticOrder S; S.init(MP, 5632, c.G, c.wg);
    pg8::EpiSwiglu E{ACT, DFF};
    pg8::gemm_phase<pg8::EpiSwiglu, pg8::StaticOrder, true, true>(c.lds, g, S, E, c.tid);
    const Ctx c2 = fresh(c0);
    sg_swiglu(HN, Wt, ACT, c2.gw, c2.NGW, c2.lane);
}
__device__ __forceinline__ void ph_ffn_out(const Ctx& c0, int l) {
    const Ctx c = fresh(c0);
    unsigned char* ws = ARG_WS();
    const bf16* ACT = (const bf16*)(ws + WS_ACT); const bf16* Wt = (const bf16*)(ws + WS_WFOUT) + (size_t)l * 1024 * 2816; float* MIX = (float*)(ws + WS_MIX);
    pg8::Gemm g{ACT, Wt, MP, 1024, DFF}; pg8::StaticOrder S; S.init(MP, 1024, c.G, c.wg);
    pg8::EpiF32 E{MIX, 1024};
    pg8::gemm_phase<pg8::EpiF32, pg8::StaticOrder, true, true>(c.lds, g, S, E, c.tid);
    const Ctx c2 = fresh(c0);
    sg_f32(ACT, DFF, Wt, 1024, MIX, 1024, c2.gw, c2.NGW, c2.lane);
}

__global__ void __launch_bounds__(NTHR, 2) mk_fwd(Args args) {
    extern __shared__ __attribute__((aligned(16))) unsigned char lds_raw[];
    Ctx c;
    c.lds = (LAS unsigned char*)lds_raw;
    c.tid = 0; c.lane = 0; c.wave = __builtin_amdgcn_readfirstlane((int)threadIdx.x >> 6);
    c.wg = blockIdx.x; c.G = gridDim.x; c.gw = c.wg * NWAVES + c.wave; c.NGW = c.G * NWAVES;
    for (int u = threadIdx.x; u < (LDS_BYTES - RING_BYTES) / 4; u += NTHR) ((LAS unsigned*)(c.lds + RING_BYTES))[u] = 0u;
    __syncthreads();
#define MAKE_BAR(b) XcdBarrier b; b.wave = c.wave; b.bar = (unsigned*)(ARG_WS() + WS_CTL) + CW_BAR + karg32(192) * XCD_BAR_WORDS; b.x = xb_xcc_id(); b.st = (volatile LAS unsigned*)(c.lds + MISC_OFF) + 8
    { MAKE_BAR(b0); if (xb_thread0(c.wave)) (void)xb_add(&b0.bar[XB_XCNT(b0.x)], 1u); }
#define PH_BEGIN(k) { const int lo_ = karg32(184), hi_ = karg32(188); if (lo_ <= (k) && (k) < hi_) { if ((k) > lo_) { MAKE_BAR(bb); xcd_barrier(bb); }
#define PH_END } }
    PH_BEGIN(0) ph_prologue(c); PH_END
    for (int l = 0; l < 4; ++l) {
        const int pb = 1 + l * 10;
        if (l < 2) {
            PH_BEGIN(pb + 0) ph_hgrn_in(c, l); PH_END
            PH_BEGIN(pb + 1) ph_hgrn_rec(c, l); PH_END
        } else {
            PH_BEGIN(pb + 0) ph_dq(c, l - 2); PH_END
            PH_BEGIN(pb + 1) ph_qnorm(c, l - 2); PH_END
            PH_BEGIN(pb + 2) ph_uq(c, l - 2); PH_END
            if (l == 2) { PH_BEGIN(pb + 3) ph_kvup(c); PH_END }
            PH_BEGIN(pb + 4) ph_attn(c); PH_END
        }
        PH_BEGIN(pb + 5) ph_mixout(c, l); PH_END
        PH_BEGIN(pb + 6) ph_resid(c, l, 1); PH_END
        PH_BEGIN(pb + 7) ph_ffn_in(c, l); PH_END
        PH_BEGIN(pb + 8) ph_ffn_out(c, l); PH_END
        PH_BEGIN(pb + 9) ph_resid(c, l, 3); PH_END
    }
#undef PH_BEGIN
#undef PH_END
}

#ifndef MK_PER_PHASE
#define MK_PER_PHASE 0
#endif
extern "C" void kernel_launch(void* const* d_in, const int* in_sizes, int n_in, void* d_out, int out_size, void* d_ws, size_t ws_size, hipStream_t stream) {
    static int grid = 0;
    if (grid == 0) {
        int dev = 0, cus = 0, per_cu = 0;
        if (n_in != 21 || ws_size < WS_END) { fprintf(stderr, "kernel_launch: unexpected arguments (n_in %d, ws %zu < %zu)\n", n_in, ws_size, (size_t)WS_END); grid = -1; return; }
        if (hipGetDevice(&dev) != hipSuccess || hipDeviceGetAttribute(&cus, hipDeviceAttributeMultiprocessorCount, dev) != hipSuccess) { grid = -1; return; }
        if (hipFuncSetAttribute((const void*)mk_fwd, hipFuncAttributeMaxDynamicSharedMemorySize, LDS_BYTES) != hipSuccess) { fprintf(stderr, "kernel_launch: hipFuncSetAttribute failed\n"); grid = -1; return; }
        if (hipOccupancyMaxActiveBlocksPerMultiprocessor(&per_cu, (const void*)mk_fwd, NTHR, LDS_BYTES) != hipSuccess || per_cu < 1) fprintf(stderr, "kernel_launch: occupancy query reports %d\n", per_cu);
        (void)hipGetLastError();
        grid = cus;
    }
    if (grid < 0) return;
    (void)hipMemsetAsync((char*)d_ws + WS_CTL, 0, CTL_BYTES, stream);
    Args a{};
    for (int i = 0; i < 21; ++i) a.in[i] = (const float*)d_in[i];
    a.out = (float*)d_out; a.ws = (unsigned char*)d_ws;
#if MK_PER_PHASE
    int li = 0;
    for (int k = 0; k < NPH; ++k) { if (!phase_exists(k)) continue; a.ph_lo = k; a.ph_hi = k + 1; a.li = li++; hipLaunchKernelGGL(mk_fwd, dim3(grid), dim3(NTHR), LDS_BYTES, stream, a); }
#else
    a.ph_lo = 0; a.ph_hi = NPH; a.li = 0;
    hipLaunchKernelGGL(mk_fwd, dim3(grid), dim3(NTHR), LDS_BYTES, stream, a);
#endif
    const hipError_t le = hipPeekAtLastError();
    if (le != hipSuccess) fprintf(stderr, "kernel_launch: launch failed: %s\n", hipGetErrorName(le));
}
```

```cpp
#include <hip/hip_runtime.h>
#include <cstdio>
#include <cstdint>
#include <math.h>
#define GAS __attribute__((address_space(1)))
#define LAS __attribute__((address_space(3)))
typedef unsigned short bf16;
typedef unsigned v4u __attribute__((ext_vector_type(4)));
typedef unsigned v2u __attribute__((ext_vector_type(2)));
typedef float f32x4 __attribute__((ext_vector_type(4)));
typedef short bf16x8 __attribute__((ext_vector_type(8)));
constexpr int NWAVES = 8, NTHR = 512;
constexpr int D = 1024, BATCH = 8, SEQ = 2048, MP = BATCH * SEQ, DB = 128, M = MP + DB;
constexpr int HA = 8, DK = 128, DV = 128;
constexpr int QL = 384, KVL = 256;
constexpr int PAST = 8192, PAGE = 128, NPAGES = PAST / PAGE;
constexpr int DFF = 2816;
constexpr float EPS = 1e-6f;
constexpr float QSCALE = 0.07216878364870322f * 1.4426950408889634f;
constexpr int QCP = 768;
constexpr int SCP = PAST + 64;

constexpr size_t MiB = 1u << 20;
constexpr size_t WS_CTL = 0, CTL_BYTES = 1 * MiB;
constexpr size_t WS_WIN   = 1 * MiB;
constexpr size_t WS_WOUTA = WS_WIN + 2 * (size_t)4096 * 1024 * 2;
constexpr size_t WS_WFIN  = WS_WOUTA + 2 * (size_t)1024 * 1024 * 2;
constexpr size_t WS_WFOUT = WS_WFIN + 4 * (size_t)5632 * 1024 * 2;
constexpr size_t WS_WDQ0  = WS_WFOUT + 4 * (size_t)1024 * 2816 * 2;
constexpr size_t WS_WDQ1  = WS_WDQ0 + (size_t)768 * 1024 * 2;
constexpr size_t WS_WUQ   = WS_WDQ1 + (size_t)512 * 1024 * 2;
constexpr size_t WS_WUKV  = WS_WUQ + 2 * (size_t)1536 * 384 * 2;
constexpr size_t WS_WUKVN = WS_WUKV + (size_t)2048 * 256 * 2;
constexpr size_t WS_WOUTB = WS_WUKVN + (size_t)256 * 2048 * 2;
constexpr size_t WS_CS    = WS_WOUTB + 2 * (size_t)1024 * 1024 * 2;
constexpr size_t WS_LBT   = WS_CS + (size_t)2049 * 64 * 4 + 256;
constexpr size_t WS_HN    = ((WS_LBT + 2 * 1024 * 2 * 4 + 4095) / 4096) * 4096;
constexpr size_t WS_QB    = WS_HN + (size_t)M * 1024 * 2;
constexpr size_t WS_VB    = WS_QB + (size_t)M * 1024 * 2;
constexpr size_t WS_GATE  = WS_VB + (size_t)M * 1024 * 2;
constexpr size_t WS_GB    = WS_GATE + (size_t)M * 1024 * 2;
constexpr size_t WS_OG    = WS_GB + (size_t)M * 1024 * 4;
constexpr size_t WS_MIX   = WS_OG + (size_t)M * 1024 * 2;
constexpr size_t WS_ACT   = WS_MIX + (size_t)M * 1024 * 4;
constexpr size_t WS_QC    = WS_ACT + (size_t)M * 2816 * 2;
constexpr size_t WS_QAN   = WS_QC + (size_t)M * QCP * 4;
constexpr size_t WS_CB    = WS_QAN + (size_t)M * 384 * 2;
constexpr size_t WS_KRB   = WS_CB + (size_t)M * 256 * 2;
constexpr size_t WS_QN    = WS_KRB + (size_t)MP * 64 * 2;
constexpr size_t WS_QR    = WS_QN + (size_t)M * 1024 * 2;
constexpr size_t WS_KN    = WS_QR + (size_t)M * 512 * 2;
constexpr size_t WS_VV    = WS_KN + (size_t)MP * 1024 * 2;
constexpr size_t WS_SC    = WS_VV + (size_t)MP * 1024 * 2;
constexpr size_t WS_PART  = WS_SC + (size_t)DB * 8 * SCP * 4;
constexpr size_t WS_PML   = WS_PART + (size_t)DB * 2 * 8 * 256 * 4;
constexpr size_t WS_QLAT  = WS_PML + (size_t)DB * 2 * 8 * 2 * 4;
constexpr size_t WS_END   = WS_QLAT + (size_t)DB * 8 * 320 * 4;
constexpr int CW_BAR = 4096;
constexpr int RING_BYTES = 131072, MISC_OFF = RING_BYTES + 320, LDS_BYTES = 147456;

__device__ __forceinline__ float bf2f(unsigned b) { return __uint_as_float(b << 16); }
__device__ __forceinline__ unsigned f2bf(float f) { unsigned u = __float_as_uint(f); return (u + 0x7fffu + ((u >> 16) & 1u)) >> 16; }
__device__ __forceinline__ unsigned pk2(float lo, float hi) { return f2bf(lo) | (f2bf(hi) << 16); }
typedef __bf16 bf16x2_t __attribute__((ext_vector_type(2)));
typedef float f32x2_t __attribute__((ext_vector_type(2)));
__device__ __forceinline__ unsigned cvtpk(float lo, float hi) { const f32x2_t v = {lo, hi}; const bf16x2_t b = __builtin_convertvector(v, bf16x2_t); return __builtin_bit_cast(unsigned, b); }
#define LDS_WAIT() asm volatile("s_waitcnt lgkmcnt(0)" ::: "memory")
__device__ __forceinline__ int lane_id_v() { int l; asm volatile("v_mbcnt_lo_u32_b32 %0, -1, 0\n\tv_mbcnt_hi_u32_b32 %0, -1, %0" : "=v"(l)); return l; }
__device__ __forceinline__ float shx(float v, int mask, int lane) { return __int_as_float(__builtin_amdgcn_ds_bpermute((lane ^ mask) << 2, __float_as_int(v))); }
__device__ __forceinline__ float wave_sum(float v) {
    const int lane = lane_id_v();
#pragma unroll
    for (int o = 1; o < 64; o <<= 1) v += shx(v, o, lane);
    return v;
}
__device__ __forceinline__ float wave_max(float v) {
    const int lane = lane_id_v();
#pragma unroll
    for (int o = 1; o < 64; o <<= 1) v = fmaxf(v, shx(v, o, lane));
    return v;
}
namespace pg8 {
#define PG8_LAS __attribute__((address_space(3)))
typedef unsigned short bf16_t;
typedef short bf16x8 __attribute__((ext_vector_type(8)));
typedef float f32x4 __attribute__((ext_vector_type(4)));
typedef unsigned u32x4 __attribute__((ext_vector_type(4)));
constexpr int BM = 256, BK = 64, HALF = 128, HTB = HALF * BK * 2  , STAGE_BYTES = 8 * HTB, NXCD = 8, WGM = 8;

__host__ __device__ __forceinline__ int lds_byte(int r, int c) { const int st = (r >> 4) * 2 + (c >> 5), rr = r & 15, cc = c & 31, ob = rr * 64 + cc * 2; return st * 1024 + (ob ^ (((ob >> 9) & 1) << 5)); }
__host__ __device__ __forceinline__ void stage_rc(int b, int& R, int& C) { const int st = b / 1024, sb = b % 1024, swz = sb ^ (((sb >> 9) & 1) << 5); R = (st >> 1) * 16 + swz / 64; C = (st & 1) * 32 + (swz % 64) / 2; }
__host__ __device__ __forceinline__ int perm32(int rho) { const int n = rho >> 4, i = rho & 15; return 8 * (i >> 2) + 4 * n + (i & 3); }

struct Unit { int pm, pn; };
struct Gemm { const bf16_t* A; const bf16_t* Bt; int M, N, K; };

struct StaticOrder {
    int nM, nN, nwg, G, c;
    __host__ __device__ void init(int M, int N, int G_, int c_) { nM = M / BM; nN = N / BM; nwg = nM * nN; G = G_; c = c_; }
    __host__ __device__ bool next(int i, Unit& u) const {
        const long L = (long)i * G + c; if (L >= nwg) return false;
        int wgid = (int)L; { const int q = nwg / NXCD, r = nwg % NXCD, xcd = wgid % NXCD, off = wgid / NXCD; wgid = (xcd < r ? xcd * (q + 1) : r * (q + 1) + (xcd - r) * q) + off; }
        const int nig = WGM * nN, gid = wgid / nig, fm = gid * WGM, gsz = (nM - fm) < WGM ? (nM - fm) : WGM;
        u.pm = fm + ((wgid % nig) % gsz); u.pn = (wgid % nig) / gsz; return true;
    }
    __device__ __forceinline__ void a_ready(const Unit&) const {}
    __device__ __forceinline__ void done(const Unit&) const {}
};

__device__ __forceinline__ unsigned cvt_pk_bf16(float lo, float hi) { unsigned r; asm volatile("v_cvt_pk_bf16_f32 %0, %1, %2" : "=v"(r) : "v"(lo), "v"(hi)); return r; }
typedef float f32x2 __attribute__((ext_vector_type(2)));
__device__ __forceinline__ float silu_fast(float x) { return x * __builtin_amdgcn_rcpf(1.0f + __expf(-x)); }
__device__ __forceinline__ float logf_gate(float z, float log_lb, float l1p) {
    const float lsig = fminf(z, 0.f) - __logf(1.0f + __expf(-fabsf(z)));
    const float bb = l1p + lsig;
    const float mx = fmaxf(log_lb, bb), mn = fminf(log_lb, bb);
    return fminf(mx + __logf(1.0f + __expf(mn - mx)), 0.f);
}
struct EpiF32 {
    static constexpr bool PERM = false, AFTER_DRAIN = false;
    float* C; int ldc;
    __device__ __forceinline__ void operator()(const f32x4 (&acc)[2][2][4][2], const Unit& u, int wr, int wc, int fr_, int fq_) const {
        const int ln_ = lane_id_v(); const int fr = ln_ & 15, fq = ln_ >> 4;
        const int row0 = u.pm * BM + wr * 64 + fr, col0 = u.pn * BM + wc * 32 + 4 * fq;
#pragma unroll
        for (int ai = 0; ai < 2; ++ai)
#pragma unroll
            for (int m = 0; m < 4; ++m) { float* rowp = C + (size_t)(row0 + ai * HALF + m * 16) * ldc + col0;
#pragma unroll
                for (int bj = 0; bj < 2; ++bj)
#pragma unroll
                    for (int n = 0; n < 2; ++n) *(f32x4*)(rowp + bj * HALF + n * 16) = acc[ai][bj][m][n]; }
    }
};
struct EpiBf16Split {
    static constexpr bool PERM = true, AFTER_DRAIN = false;
    bf16_t* O; int ldc; int split_cols; size_t split_stride;
    __device__ __forceinline__ void operator()(const f32x4 (&acc)[2][2][4][2], const Unit& u, int wr, int wc, int fr_, int fq_) const {
        const int ln_ = lane_id_v(); const int fr = ln_ & 15, fq = ln_ >> 4;
        const int row0 = u.pm * BM + wr * 64 + fr; int colt = u.pn * BM; bf16_t* base = O;
        if (split_cols) { const int t = colt / split_cols; base += (size_t)t * split_stride; colt -= t * split_cols; }
        const int col0 = colt + wc * 32 + 8 * fq;
#pragma unroll
        for (int ai = 0; ai < 2; ++ai)
#pragma unroll
            for (int m = 0; m < 4; ++m) { bf16_t* rowp = base + (size_t)(row0 + ai * HALF + m * 16) * ldc + col0;
#pragma unroll
                for (int bj = 0; bj < 2; ++bj) { const f32x4 v0 = acc[ai][bj][m][0], v1 = acc[ai][bj][m][1];
                    u32x4 w; w.x = cvt_pk_bf16(v0[0], v0[1]); w.y = cvt_pk_bf16(v0[2], v0[3]); w.z = cvt_pk_bf16(v1[0], v1[1]); w.w = cvt_pk_bf16(v1[2], v1[3]);
                    *(u32x4*)(rowp + bj * HALF) = w; } }
    }
};
struct EpiHgrnIn {
    static constexpr bool PERM = true, AFTER_DRAIN = false;
    unsigned char* ws; int layer;
    __device__ __forceinline__ void operator()(const f32x4 (&acc)[2][2][4][2], const Unit& u, int wr, int wc, int fr_, int fq_) const {
        const int ln_ = lane_id_v(); const int fr = ln_ & 15, fq = ln_ >> 4;
        const int row0 = u.pm * BM + wr * 64 + fr; const int type = u.pn >> 2; const int cl0 = (u.pn & 3) * 256 + wc * 32 + 8 * fq;
        if (type == 1) {
            const float* lbt = (const float*)(ws + WS_LBT) + (size_t)layer * 2048; float* GB = (float*)(ws + WS_GB);
#pragma unroll
            for (int bj = 0; bj < 2; ++bj) {
                const int cl = cl0 + bj * HALF;
                f32x4 t0 = *(const f32x4*)(lbt + 2 * cl), t1 = *(const f32x4*)(lbt + 2 * cl + 4), t2 = *(const f32x4*)(lbt + 2 * cl + 8), t3 = *(const f32x4*)(lbt + 2 * cl + 12);
#pragma unroll
                for (int ai = 0; ai < 2; ++ai)
#pragma unroll
                    for (int m = 0; m < 4; ++m) {
                        const f32x4 v0 = acc[ai][bj][m][0], v1 = acc[ai][bj][m][1]; f32x4 o0, o1;
                        o0[0] = logf_gate(v0[0], t0[0], t0[1]); o0[1] = logf_gate(v0[1], t0[2], t0[3]); o0[2] = logf_gate(v0[2], t1[0], t1[1]); o0[3] = logf_gate(v0[3], t1[2], t1[3]);
                        o1[0] = logf_gate(v1[0], t2[0], t2[1]); o1[1] = logf_gate(v1[1], t2[2], t2[3]); o1[2] = logf_gate(v1[2], t3[0], t3[1]); o1[3] = logf_gate(v1[3], t3[2], t3[3]);
                        float* p = GB + (size_t)(row0 + ai * HALF + m * 16) * 1024 + cl;
                        *(f32x4*)p = o0; *(f32x4*)(p + 4) = o1;
                    }
            }
        } else {
            bf16_t* dst = (bf16_t*)(ws + (type == 0 ? WS_QB : (type == 2 ? WS_VB : WS_GATE)));
#pragma unroll
            for (int ai = 0; ai < 2; ++ai)
#pragma unroll
                for (int m = 0; m < 4; ++m)
#pragma unroll
                    for (int bj = 0; bj < 2; ++bj) {
                        f32x4 v0 = acc[ai][bj][m][0], v1 = acc[ai][bj][m][1];
                        if (type == 0) {
#pragma unroll
                            for (int j = 0; j < 4; ++j) { v0[j] = silu_fast(v0[j]) * 0.08838834764831845f; v1[j] = silu_fast(v1[j]) * 0.08838834764831845f; }
                        } else if (type == 3) {
#pragma unroll
                            for (int j = 0; j < 4; ++j) { v0[j] = silu_fast(v0[j]); v1[j] = silu_fast(v1[j]); }
                        }
                        u32x4 w; w.x = cvt_pk_bf16(v0[0], v0[1]); w.y = cvt_pk_bf16(v0[2], v0[3]); w.z = cvt_pk_bf16(v1[0], v1[1]); w.w = cvt_pk_bf16(v1[2], v1[3]);
                        *(u32x4*)(dst + (size_t)(row0 + ai * HALF + m * 16) * 1024 + cl0 + bj * HALF) = w;
                    }
        }
    }
};
struct EpiSwiglu {
    static constexpr bool PERM = true, AFTER_DRAIN = false;
    bf16_t* ACT; int ldc;
    __device__ __forceinline__ void operator()(const f32x4 (&acc)[2][2][4][2], const Unit& u, int wr, int wc, int fr_, int fq_) const {
        const int ln_ = lane_id_v(); const int fr = ln_ & 15, fq = ln_ >> 4;
        const int row0 = u.pm * BM + wr * 64 + fr, col0 = u.pn * HALF + wc * 32 + 8 * fq;
#pragma unroll
        for (int ai = 0; ai < 2; ++ai)
#pragma unroll
            for (int m = 0; m < 4; ++m) {
                f32x4 r0, r1;
#pragma unroll
                for (int j = 0; j < 4; ++j) { r0[j] = silu_fast(acc[ai][0][m][0][j]) * acc[ai][1][m][0][j]; r1[j] = silu_fast(acc[ai][0][m][1][j]) * acc[ai][1][m][1][j]; }
                u32x4 w; w.x = cvt_pk_bf16(r0[0], r0[1]); w.y = cvt_pk_bf16(r0[2], r0[3]); w.z = cvt_pk_bf16(r1[0], r1[1]); w.w = cvt_pk_bf16(r1[2], r1[3]);
                *(u32x4*)(ACT + (size_t)(row0 + ai * HALF + m * 16) * ldc + col0) = w;
            }
    }
};
struct EpiRope {
    static constexpr bool PERM = true, AFTER_DRAIN = false;
    unsigned char* ws;
    __device__ __forceinline__ void operator()(const f32x4 (&acc)[2][2][4][2], const Unit& u, int wr, int wc, int fr_, int fq_) const {
        const int ln_ = lane_id_v(); const int fr = ln_ & 15, fq = ln_ >> 4;
        const int row0 = u.pm * BM + wr * 64 + fr;
        {
            bf16_t* QR = (bf16_t*)(ws + WS_QR); const float* CS = (const float*)(ws + WS_CS);
            const int rc0 = u.pn * BM + wc * 32 + 8 * fq;
#pragma unroll
            for (int ai = 0; ai < 2; ++ai)
#pragma unroll
                for (int m = 0; m < 4; ++m) { const int row = row0 + ai * HALF + m * 16; const int pos = row & 2047;
#pragma unroll
                    for (int bj = 0; bj < 2; ++bj) { const int rc = rc0 + bj * HALF; const int i0 = (rc & 63) >> 1;
                        const float* cp = CS + (size_t)(pos * 32 + i0) * 2;
                        u32x4 w;
                        { const f32x4 cc = *(const f32x4*)cp; const f32x4 v0 = acc[ai][bj][m][0];
                          w.x = cvt_pk_bf16(v0[0] * cc[0] - v0[1] * cc[1], v0[1] * cc[0] + v0[0] * cc[1]);
                          w.y = cvt_pk_bf16(v0[2] * cc[2] - v0[3] * cc[3], v0[3] * cc[2] + v0[2] * cc[3]); }
                        asm volatile("" ::: "memory");
                        { const f32x4 cc = *(const f32x4*)(cp + 4); const f32x4 v1 = acc[ai][bj][m][1];
                          w.z = cvt_pk_bf16(v1[0] * cc[0] - v1[1] * cc[1], v1[1] * cc[0] + v1[0] * cc[1]);
                          w.w = cvt_pk_bf16(v1[2] * cc[2] - v1[3] * cc[3], v1[3] * cc[2] + v1[2] * cc[3]); }
                        *(u32x4*)(QR + (size_t)row * 512 + rc) = w;
                        asm volatile("" ::: "memory"); } }
        }
    }
};
template <class Epi, class Sched, bool ALIGN_EPI = false, bool SP2 = false>
__device__ __forceinline__ void gemm_phase(PG8_LAS unsigned char* lds, const Gemm g, const Sched& S, const Epi& E, const int tid_in) {
    int tid_o = tid_in; asm volatile("" : "+v"(tid_o));
    const int tid = tid_o, wid = __builtin_amdgcn_readfirstlane(tid >> 6), lane = tid & 63, wr = wid >> 2, wc = wid & 3, fr = lane & 15, fq = lane >> 4;
    const int K = g.K, nt = K / BK;
    unsigned voffA[2], voffB[2];
#pragma unroll
    for (int i = 0; i < 2; ++i) { int R, C; stage_rc(tid * 16 + i * 8192, R, C); const int Rb = Epi::PERM ? ((R & ~31) + perm32(R & 31)) : R;
        voffA[i] = (unsigned)(R * K + C) * 2u; voffB[i] = (unsigned)(Rb * K + C) * 2u; }
    const size_t kstep = (size_t)(BK * 2);
    const size_t hstep = (size_t)HALF * K * 2;
    const size_t tstep = 2 * hstep;
    const unsigned ldsw = (unsigned)wid * 1024u;
    const int aoff = lds_byte(wr * 64 + fr, fq * 8), boff = lds_byte(wc * 32 + fr, fq * 8);
#define PG8_SA(b, h) (((b) * 2 + (h)) * HTB)
#define PG8_SB(b, h) ((4 + (b) * 2 + (h)) * HTB)
#define PG8_STAGE(bufoff, gbase, voff) do { _Pragma("unroll") for (int _i = 0; _i < 2; ++_i) \
        __builtin_amdgcn_global_load_lds((const unsigned*)((const char*)(gbase) + (voff)[_i]), (PG8_LAS unsigned*)(lds + (bufoff) + ldsw + _i * 8192), 16, 0, 0); } while (0)
#define PG8_LDA(dst, b, h) do { _Pragma("unroll") for (int m = 0; m < 4; ++m) _Pragma("unroll") for (int k = 0; k < 2; ++k) dst[m][k] = *(const PG8_LAS bf16x8*)(lds + PG8_SA(b, h) + aoff + m * 2048 + k * 1024); } while (0)
#define PG8_LDB(dst, b, h) do { _Pragma("unroll") for (int n = 0; n < 2; ++n) _Pragma("unroll") for (int k = 0; k < 2; ++k) dst[n][k] = *(const PG8_LAS bf16x8*)(lds + PG8_SB(b, h) + boff + n * 2048 + k * 1024); } while (0)
#define PG8_MMA(ai, bj, At, Bt) do { __builtin_amdgcn_s_setprio(1); _Pragma("unroll") for (int m = 0; m < 4; ++m) _Pragma("unroll") for (int n = 0; n < 2; ++n) _Pragma("unroll") for (int k = 0; k < 2; ++k) \
        acc[ai][bj][m][n] = __builtin_amdgcn_mfma_f32_16x16x32_bf16(Bt[n][k], At[m][k], acc[ai][bj][m][n], 0, 0, 0); __builtin_amdgcn_s_setprio(0); } while (0)
#define PG8_WAIT_V(n) asm volatile("s_waitcnt vmcnt(" #n ")" ::: "memory")
#define PG8_WAIT_L(n) asm volatile("s_waitcnt lgkmcnt(" #n ")" ::: "memory")
#define PG8_BAR __builtin_amdgcn_s_barrier()
#define PG8_SCHED __builtin_amdgcn_sched_barrier(0)
    Unit cur, nxt; int ui = 0;
    if (!S.next(0, cur)) return;
    f32x4 acc[2][2][4][2];
#pragma unroll
    for (int a = 0; a < 2; ++a)
#pragma unroll
        for (int b = 0; b < 2; ++b)
#pragma unroll
            for (int m = 0; m < 4; ++m)
#pragma unroll
                for (int n = 0; n < 2; ++n) acc[a][b][m][n] = (f32x4){0.f, 0.f, 0.f, 0.f};
    bf16x8 At[4][2], B0[2][2], B1[2][2];
    const char* cA = (const char*)g.A + (size_t)cur.pm * tstep; const char* cB = (const char*)g.Bt + (size_t)cur.pn * tstep;
    S.a_ready(cur);
    if constexpr (SP2) {
        PG8_STAGE(PG8_SB(0, 0), cB, voffB); PG8_STAGE(PG8_SB(0, 1), cB + hstep, voffB); PG8_STAGE(PG8_SA(0, 0), cA, voffA); PG8_STAGE(PG8_SA(0, 1), cA + hstep, voffA);
        if (wr == 1) PG8_BAR;
        PG8_WAIT_V(2); PG8_BAR;
        PG8_STAGE(PG8_SB(1, 0), cB + kstep, voffB); PG8_STAGE(PG8_SA(1, 0), cA + kstep, voffA); PG8_STAGE(PG8_SB(1, 1), cB + hstep + kstep, voffB);
        PG8_WAIT_V(6); PG8_BAR;
    } else {
        PG8_STAGE(PG8_SB(0, 0), cB, voffB); PG8_STAGE(PG8_SA(0, 0), cA, voffA); PG8_STAGE(PG8_SB(0, 1), cB + hstep, voffB); PG8_STAGE(PG8_SA(0, 1), cA + hstep, voffA);
        if (wr == 1) PG8_BAR;
        PG8_WAIT_V(4); PG8_BAR;
        PG8_STAGE(PG8_SB(1, 0), cB + kstep, voffB); PG8_STAGE(PG8_SA(1, 0), cA + kstep, voffA); PG8_STAGE(PG8_SB(1, 1), cB + hstep + kstep, voffB);
        PG8_WAIT_V(6); PG8_BAR;
    }
    for (;;) {
        const bool has_next = S.next(ui + 1, nxt);
        const char* nA = has_next ? (const char*)g.A + (size_t)nxt.pm * tstep : cA; const char* nB = has_next ? (const char*)g.Bt + (size_t)nxt.pn * tstep : cB;
        for (int t = 0; t < nt; t += 2) {
            const bool last = (t == nt - 2);
            const char* a1 = cA + (size_t)(t + 1) * kstep;
            const char* a2 = last ? nA : cA + (size_t)(t + 2) * kstep; const char* b2 = last ? nB : cB + (size_t)(t + 2) * kstep;
            const char* a3 = a2 + kstep; const char* b3 = b2 + kstep;
            if (last && has_next) S.a_ready(nxt);
            if constexpr (SP2) {
            PG8_LDB(B0, 0, 0); PG8_LDB(B1, 0, 1); PG8_SCHED; PG8_LDA(At, 0, 0); PG8_STAGE(PG8_SA(1, 1), a1 + hstep, voffA);
            PG8_WAIT_V(8); PG8_WAIT_L(0); PG8_BAR; PG8_MMA(0, 0, At, B0); PG8_MMA(0, 1, At, B1); PG8_BAR; PG8_SCHED;
            PG8_LDA(At, 0, 1); PG8_STAGE(PG8_SB(0, 0), b2, voffB); PG8_STAGE(PG8_SB(0, 1), b2 + hstep, voffB); PG8_STAGE(PG8_SA(0, 0), a2, voffA);
            PG8_WAIT_V(8); PG8_WAIT_L(0); PG8_BAR; PG8_MMA(1, 0, At, B0); PG8_MMA(1, 1, At, B1); PG8_BAR; PG8_SCHED;
            PG8_LDB(B0, 1, 0); PG8_LDB(B1, 1, 1); PG8_SCHED; PG8_LDA(At, 1, 0); PG8_STAGE(PG8_SA(0, 1), a2 + hstep, voffA);
            PG8_WAIT_V(8); PG8_WAIT_L(0); PG8_BAR; PG8_MMA(0, 0, At, B0); PG8_MMA(0, 1, At, B1); PG8_BAR; PG8_SCHED;
            PG8_LDA(At, 1, 1); PG8_STAGE(PG8_SB(1, 0), b3, voffB); PG8_STAGE(PG8_SB(1, 1), b3 + hstep, voffB); PG8_STAGE(PG8_SA(1, 0), a3, voffA);
            PG8_WAIT_V(8); PG8_WAIT_L(0); PG8_BAR; PG8_MMA(1, 0, At, B0); PG8_MMA(1, 1, At, B1); PG8_BAR; PG8_SCHED;
            } else {
            PG8_LDB(B0, 0, 0); PG8_SCHED; PG8_LDA(At, 0, 0); PG8_STAGE(PG8_SA(1, 1), a1 + hstep, voffA);
            PG8_WAIT_L(8); PG8_BAR; PG8_WAIT_L(0); PG8_MMA(0, 0, At, B0); PG8_BAR; PG8_SCHED;
            PG8_LDB(B1, 0, 1); PG8_STAGE(PG8_SB(0, 0), b2, voffB);
            PG8_BAR; PG8_WAIT_L(0); PG8_MMA(0, 1, At, B1); PG8_BAR;
            PG8_LDA(At, 0, 1); PG8_STAGE(PG8_SA(0, 0), a2, voffA);
            PG8_BAR; PG8_WAIT_L(0); PG8_MMA(1, 0, At, B0); PG8_BAR; PG8_SCHED;
            PG8_STAGE(PG8_SB(0, 1), b2 + hstep, voffB);
            PG8_WAIT_V(6); PG8_BAR; PG8_MMA(1, 1, At, B1); PG8_BAR;
            PG8_LDB(B0, 1, 0); PG8_SCHED; PG8_LDA(At, 1, 0); PG8_STAGE(PG8_SA(0, 1), a2 + hstep, voffA);
            PG8_WAIT_L(8); PG8_BAR; PG8_WAIT_L(0); PG8_MMA(0, 0, At, B0); PG8_BAR; PG8_SCHED;
            PG8_LDB(B1, 1, 1); PG8_STAGE(PG8_SB(1, 0), b3, voffB);
            PG8_BAR; PG8_WAIT_L(0); PG8_MMA(0, 1, At, B1); PG8_BAR;
            PG8_LDA(At, 1, 1); PG8_STAGE(PG8_SA(1, 0), a3, voffA);
            PG8_BAR; PG8_WAIT_L(0); PG8_MMA(1, 0, At, B0); PG8_BAR; PG8_SCHED;
            PG8_STAGE(PG8_SB(1, 1), b3 + hstep, voffB);
            PG8_WAIT_V(6); PG8_BAR; PG8_MMA(1, 1, At, B1); PG8_BAR;
            }
        }
        if constexpr (ALIGN_EPI) { if (wr == 0) PG8_BAR; }
        if constexpr (!Epi::AFTER_DRAIN) { E(acc, cur, wr, wc, fr, fq); S.done(cur); }
        if (!has_next) break;
#pragma unroll
        for (int a = 0; a < 2; ++a)
#pragma unroll
            for (int b = 0; b < 2; ++b)
#pragma unroll
                for (int m = 0; m < 4; ++m)
#pragma unroll
                    for (int n = 0; n < 2; ++n) acc[a][b][m][n] = (f32x4){0.f, 0.f, 0.f, 0.f};
        cur = nxt; cA = nA; cB = nB; ++ui;
        if constexpr (ALIGN_EPI) { if (wr == 1) PG8_BAR; }
    }
    PG8_WAIT_V(0);
    if constexpr (!ALIGN_EPI) { if (wr == 0) PG8_BAR; }
    PG8_BAR;
    if constexpr (Epi::AFTER_DRAIN) { E.fused(acc, cur, wr, wc, fr, fq, lds, wid, lane); S.done(cur); }
#undef PG8_SA
#undef PG8_SB
#undef PG8_STAGE
#undef PG8_LDA
#undef PG8_LDB
#undef PG8_MMA
#undef PG8_WAIT_V
#undef PG8_WAIT_L
#undef PG8_BAR
#undef PG8_SCHED
}
}
#define XB_TMO      128
#define XB_XCNT(j)  (256  + 64 * (j))
#define XB_XSUB(j)  (1280 + 64 * (j))
#define XB_XGEN(j)  (2304 + 64 * (j))
#define XB_TOP      3328
#define XB_TOPGEN   3392
#define XCD_BAR_WORDS 3456
#define XB_SPIN_CAP (1u << 18)

__device__ __forceinline__ unsigned xb_ld(unsigned* p)              { return __hip_atomic_load(p, __ATOMIC_RELAXED, __HIP_MEMORY_SCOPE_AGENT); }
__device__ __forceinline__ unsigned xb_add(unsigned* p, unsigned v) { return __hip_atomic_fetch_add(p, v, __ATOMIC_RELAXED, __HIP_MEMORY_SCOPE_AGENT); }
__device__ __forceinline__ unsigned xb_xcc_id() { return (unsigned)__builtin_amdgcn_s_getreg((3 << 11) | 20) & 0xFu; }
#define XB_SPIN(cond, bar) do { unsigned _sp = 0; while (cond) { __builtin_amdgcn_s_sleep(1); \
    if ((++_sp & 255u) == 0u) { if (xb_ld(&(bar)[XB_TMO])) break; if (_sp > XB_SPIN_CAP) { atomicAdd(&(bar)[XB_TMO], 1u); break; } } } } while (0)

struct XcdBarrier {
    int wave; unsigned* bar; unsigned x;
    volatile LAS unsigned* st;
};

__device__ __forceinline__ bool xb_thread0(int wave) { return wave == 0 && lane_id_v() == 0; }
__device__ __forceinline__ XcdBarrier xcd_barrier_post(unsigned* bar, volatile LAS unsigned* st, int wave) {
    XcdBarrier b; b.wave = wave; b.bar = bar; b.x = xb_xcc_id(); b.st = st;
    if (xb_thread0(wave)) (void)xb_add(&bar[XB_XCNT(b.x)], 1u);
    return b;
}
__device__ __forceinline__ void xcd_barrier_complete(unsigned* bar, unsigned x, unsigned& nloc, unsigned& nx) {
    const unsigned G = gridDim.x * gridDim.y * gridDim.z;
    unsigned sum, cnt, mine, sp = 0u;
    for (;;) {
        sum = 0u; cnt = 0u; mine = 0u;
#pragma unroll
        for (unsigned j = 0; j < 16; ++j) { const unsigned c = xb_ld(&bar[XB_XCNT(j)]); sum += c; cnt += (c > 0u) ? 1u : 0u; mine = (j == x) ? c : mine; }
        if (sum == G) break;
        __builtin_amdgcn_s_sleep(1);
        if ((++sp & 255u) == 0u) { if (xb_ld(&bar[XB_TMO])) break; if (sp > XB_SPIN_CAP) { atomicAdd(&bar[XB_TMO], 1u); break; } }
    }
    nloc = mine > 0u ? mine : 1u; nx = cnt > 0u ? cnt : 1u;
}

__device__ __forceinline__ void xcd_barrier(const XcdBarrier& b) {
    asm volatile("s_waitcnt vmcnt(0)" ::: "memory");
    __syncthreads();
    if (xb_thread0(b.wave)) {
        unsigned* bar = b.bar; asm volatile("" : "+s"(bar));
        __builtin_amdgcn_s_waitcnt(0);
        unsigned nloc = b.st[0], nx = b.st[1];
        if (nloc == 0u) { unsigned xo = b.x; asm volatile("" : "+s"(xo)); xcd_barrier_complete(bar, xo, nloc, nx); b.st[0] = nloc; b.st[1] = nx; }
        const unsigned old = xb_add(&bar[XB_XSUB(b.x)], 1u);
        const unsigned gen = old / nloc;
        if (old + 1u == (gen + 1u) * nloc) {
            __builtin_amdgcn_fence(__ATOMIC_RELEASE, "agent");
            asm volatile("s_waitcnt vmcnt(0)" ::: "memory");
            const unsigned og = xb_add(&bar[XB_TOP], 1u);
            const unsigned tg = og / nx;
            if (og + 1u == (tg + 1u) * nx) xb_add(&bar[XB_TOPGEN], 1u);
            else XB_SPIN(xb_ld(&bar[XB_TOPGEN]) == tg, bar);
            __builtin_amdgcn_fence(__ATOMIC_ACQUIRE, "agent");
            xb_add(&bar[XB_XGEN(b.x)], 1u);
            asm volatile("s_waitcnt vmcnt(0)" ::: "memory");
        } else {
            XB_SPIN(xb_ld(&bar[XB_XGEN(b.x)]) == gen, bar);
            __builtin_amdgcn_fence(__ATOMIC_ACQUIRE, "agent");
            asm volatile("s_waitcnt vmcnt(0)" ::: "memory");
        }
    }
    __syncthreads();
}
template <int NT> __device__ __forceinline__ void sg_tile(const bf16* A, int r0, const bf16* Bt, const int (&nrow)[NT], int K, int lane, f32x4 (&acc)[NT]) {
    const bf16* ap = A + (size_t)(r0 + (lane & 15)) * K + 8 * (lane >> 4);
    const bf16* bp[NT];
#pragma unroll
    for (int t = 0; t < NT; ++t) bp[t] = Bt + (size_t)(nrow[t] + (lane & 15)) * K + 8 * (lane >> 4);
#pragma unroll 4
    for (int k = 0; k < K; k += 32) {
        const bf16x8 av = *(const bf16x8*)(ap + k);
#pragma unroll
        for (int t = 0; t < NT; ++t) { const bf16x8 bv = *(const bf16x8*)(bp[t] + k); acc[t] = __builtin_amdgcn_mfma_f32_16x16x32_bf16(av, bv, acc[t], 0, 0, 0); }
    }
}
__device__ __forceinline__ void sg_hgrn_in(const bf16* HN, const bf16* Wt, bf16* QB, float* GB, bf16* VB, bf16* GATE, const float* lbt, int gw, int NGW, int lane) {
    const bf16* A = HN + (size_t)MP * 1024;
    for (int tile = gw; tile < 8 * 256; tile += NGW) {
        const int mt = tile & 7, nt = tile >> 3; const int nrow[1] = {nt * 16}; f32x4 acc[1] = {{0.f, 0.f, 0.f, 0.f}};
        sg_tile<1>(A, mt * 16, Wt, nrow, 1024, lane, acc);
        const int col = nt * 16 + (lane & 15), type = col >> 10, c = col & 1023;
        const float llb = lbt[2 * c], l1p = lbt[2 * c + 1];
#pragma unroll
        for (int reg = 0; reg < 4; ++reg) {
            const size_t o = (size_t)(MP + mt * 16 + 4 * (lane >> 4) + reg) * 1024 + c; const float x = acc[0][reg];
            if (type == 0) QB[o] = (bf16)f2bf(pg8::silu_fast(x) * 0.08838834764831845f);
            else if (type == 1) GB[o] = pg8::logf_gate(x, llb, l1p);
            else if (type == 2) VB[o] = (bf16)f2bf(x);
            else GATE[o] = (bf16)f2bf(pg8::silu_fast(x));
        }
    }
}
__device__ __forceinline__ void sg_f32(const bf16* Abuf, int K, const bf16* Wt, int N, float* C, int ldc, int gw, int NGW, int lane) {
    const bf16* A = Abuf + (size_t)MP * K;
    for (int tile = gw; tile < 8 * (N / 16); tile += NGW) {
        const int mt = tile & 7, nt = tile >> 3; const int nrow[1] = {nt * 16}; f32x4 acc[1] = {{0.f, 0.f, 0.f, 0.f}};
        sg_tile<1>(A, mt * 16, Wt, nrow, K, lane, acc);
#pragma unroll
        for (int reg = 0; reg < 4; ++reg) C[(size_t)(MP + mt * 16 + 4 * (lane >> 4) + reg) * ldc + nt * 16 + (lane & 15)] = acc[0][reg];
    }
}
__device__ __forceinline__ void sg_swiglu(const bf16* HN, const bf16* Wt, bf16* ACT, int gw, int NGW, int lane) {
    const bf16* A = HN + (size_t)MP * 1024;
    for (int tile = gw; tile < 8 * (DFF / 16); tile += NGW) {
        const int mt = tile & 7, nt = tile >> 3, j0 = nt * 16; const int ng = 256 * (j0 >> 7) + (j0 & 127); const int nrow[2] = {ng, ng + 128};
        f32x4 acc[2] = {{0.f, 0.f, 0.f, 0.f}, {0.f, 0.f, 0.f, 0.f}};
        sg_tile<2>(A, mt * 16, Wt, nrow, 1024, lane, acc);
#pragma unroll
        for (int reg = 0; reg < 4; ++reg) ACT[(size_t)(MP + mt * 16 + 4 * (lane >> 4) + reg) * DFF + j0 + (lane & 15)] = (bf16)f2bf(pg8::silu_fast(acc[0][reg]) * acc[1][reg]);
    }
}
__device__ __forceinline__ void sg_uq(const bf16* QAN, const bf16* Wt, bf16* QN, bf16* QR, const float* CS, int gw, int NGW, int lane) {
    const bf16* A = QAN + (size_t)MP * QL;
    for (int tile = gw; tile < 8 * (1536 / 16); tile += NGW) {
        const int mt = tile & 7, nt = tile >> 3; const int nrow[1] = {nt * 16}; f32x4 acc[1] = {{0.f, 0.f, 0.f, 0.f}};
        sg_tile<1>(A, mt * 16, Wt, nrow, QL, lane, acc);
        const int col = nt * 16 + (lane & 15);
#pragma unroll
        for (int reg = 0; reg < 4; ++reg) {
            const int row = MP + mt * 16 + 4 * (lane >> 4) + reg; const float x = acc[0][reg]; const float partner = shx(x, 1, lane);
            if (col < 1024) QN[(size_t)row * 1024 + col] = (bf16)f2bf(x);
            else { const int rc = col - 1024, h = rc >> 6, ii = rc & 63, i = ii >> 1; const float cs = CS[(size_t)(2048 * 32 + i) * 2], sn = CS[(size_t)(2048 * 32 + i) * 2 + 1];
                float o; int ref;
                if ((ii & 1) == 0) { o = x * cs - partner * sn; ref = i; } else { o = x * cs + partner * sn; ref = 32 + i; }
                QR[(size_t)row * 512 + h * 64 + ref] = (bf16)f2bf(o); }
        }
    }
}

__device__ __forceinline__ int maprow(int kind, int j) {
    if (kind == 1) { if (j < DFF) return 256 * (j >> 7) + (j & 127); const int jj = j - DFF; return 256 * (jj >> 7) + 128 + (jj & 127); }
    if (kind == 2) return 384 + j;
    if (kind == 3) { const int h = j / 192, n = j - h * 192; if (n < 128) return h * 128 + n; const int i = n - 128; return 1024 + h * 64 + (i < 32 ? 2 * i : 2 * (i - 32) + 1); }
    if (kind == 4) { const int h = j >> 8, n = j & 255; return n < 128 ? h * 128 + n : 1024 + h * 128 + (n - 128); }
    return j;
}
__device__ __forceinline__ void cvt_item(const float* W, int K, int N, bf16* WT, int kind, const float* gain, float scale, LAS float* scr, int item, int lane) {
    const int nblk = N / 32, kb = item / nblk, nb = item - kb * nblk, k0 = 64 * kb, n0 = 32 * nb;
#pragma unroll 8
    for (int i = 0; i < 32; ++i) { const int kk = 2 * i + (lane >> 5); const float g = gain ? gain[k0 + kk] * scale : scale;
        scr[kk * 33 + (lane & 31)] = W[(size_t)(k0 + kk) * N + n0 + (lane & 31)] * g; }
    LDS_WAIT(); asm volatile("" ::: "memory");
    const int c = lane & 7;
#pragma unroll
    for (int j = 0; j < 4; ++j) { const int n = (lane >> 3) + 8 * j; const LAS float* s = scr + (8 * c) * 33 + n;
        v4u o; o.x = pk2(s[0 * 33], s[1 * 33]); o.y = pk2(s[2 * 33], s[3 * 33]); o.z = pk2(s[4 * 33], s[5 * 33]); o.w = pk2(s[6 * 33], s[7 * 33]);
        *(v4u*)(WT + (size_t)maprow(kind, n0 + n) * K + k0 + 8 * c) = o; }
    LDS_WAIT(); asm volatile("" ::: "memory");
}
__device__ __forceinline__ void row_resid_norm(const float* mix, float* X, const float* gain, bf16* HN, int lane) {
    const f32x4* mr = (const f32x4*)mix + lane; f32x4* xr = (f32x4*)X + lane; const f32x4* gr = (const f32x4*)gain + lane;
    f32x4 v[4]; float s = 0.f;
#pragma unroll
    for (int j = 0; j < 4; ++j) { v[j] = mr[64 * j]; s += (v[j][0] * v[j][0] + v[j][1] * v[j][1]) + (v[j][2] * v[j][2] + v[j][3] * v[j][3]); }
    const float r = rsqrtf(wave_sum(s) * (1.f / 1024.f) + EPS); float s2 = 0.f;
#pragma unroll
    for (int j = 0; j < 4; ++j) { const f32x4 x = xr[64 * j] + v[j] * r * gr[64 * j]; xr[64 * j] = x; v[j] = x; s2 += (x[0] * x[0] + x[1] * x[1]) + (x[2] * x[2] + x[3] * x[3]); }
    const float r2 = rsqrtf(wave_sum(s2) * (1.f / 1024.f) + EPS);
    v2u* o8 = (v2u*)HN + lane;
#pragma unroll
    for (int j = 0; j < 4; ++j) { v2u w; w.x = pk2(v[j][0] * r2, v[j][1] * r2); w.y = pk2(v[j][2] * r2, v[j][3] * r2); o8[64 * j] = w; }
}
__device__ __forceinline__ void hgrn_naive_phase(const bf16* QB, const float* GB, const bf16* VB, const bf16* GATE, const float* gnorm, const float* s0, float* st_p, float* st_s, bf16* OG,
                                                 LAS unsigned char* lds, int wg, int G, int tid) {
    LAS float* sq = (LAS float*)lds; LAS float* sf = sq + 128; LAS float* sk = sf + 128; LAS float* red = sk + 128;
    const int dv = tid & 127; const bool active = tid < 128;
    for (int unit = wg; unit < 64 + DB * HA; unit += G) {
        const bool prompt = unit < 64; const int uu = prompt ? unit : unit - 64; const int seq = uu >> 3, h = uu & 7;
        const int T = prompt ? SEQ : 1; const int row0 = prompt ? seq * SEQ : MP + seq;
        const size_t sb = ((size_t)seq * HA + h) * DK * DV;
        float S[128];
#pragma unroll
        for (int k = 0; k < 128; ++k) S[k] = (!prompt && active) ? s0[sb + (size_t)k * DV + dv] : 0.f;
        for (int t = 0; t < T; ++t) {
            const size_t o = (size_t)(row0 + t) * 1024 + h * 128 + dv;
            __syncthreads();
            float v = 0.f;
            if (active) { sq[dv] = bf2f(QB[o]); const float lf = GB[o]; sf[dv] = expf(lf); sk[dv] = -expm1f(lf); v = bf2f(VB[o]); }
            __syncthreads();
            float ov = 0.f;
            if (active) {
#pragma unroll
                for (int k = 0; k < 128; ++k) { S[k] = sf[k] * S[k] + sk[k] * v; ov += sq[k] * S[k]; }
            }
            const float ss = wave_sum(ov * ov);
            if (active && (tid & 63) == 0) red[tid >> 6] = ss;
            __syncthreads();
            if (active) { const float r = rsqrtf((red[0] + red[1]) * (1.f / 128.f) + EPS); OG[o] = (bf16)f2bf(ov * r * gnorm[h * 128 + dv] * bf2f(GATE[o])); }
        }
        if (active) { float* so = (prompt ? st_p : st_s) + sb;
#pragma unroll
            for (int k = 0; k < 128; ++k) so[(size_t)k * DV + dv] = S[k]; }
    }
}
__device__ __forceinline__ void attn_naive_phase(const bf16* QN, const bf16* QR, const bf16* KN, const bf16* KRB, const bf16* VV, bf16* O, LAS unsigned char* lds, int wg, int G, int tid) {
    LAS float* sc = (LAS float*)lds;
    LAS float* red = sc + SEQ;
    LAS float* part = red + 16;
    const int g16 = tid >> 4, l16 = tid & 15, wave = tid >> 6;
    for (int unit = wg; unit < BATCH * 8 * SEQ; unit += G) {
        const int t = unit & (SEQ - 1), h = (unit >> 11) & 7, b = unit >> 14; const size_t row = (size_t)b * SEQ + t;
        const v4u qa = *(const v4u*)(QN + row * 1024 + h * 128 + 8 * l16); const v2u qb = *(const v2u*)(QR + row * 512 + h * 64 + 4 * l16);
        float qf[12];
        qf[0] = bf2f(qa.x & 0xffff); qf[1] = bf2f(qa.x >> 16); qf[2] = bf2f(qa.y & 0xffff); qf[3] = bf2f(qa.y >> 16); qf[4] = bf2f(qa.z & 0xffff); qf[5] = bf2f(qa.z >> 16); qf[6] = bf2f(qa.w & 0xffff); qf[7] = bf2f(qa.w >> 16);
        qf[8] = bf2f(qb.x & 0xffff); qf[9] = bf2f(qb.x >> 16); qf[10] = bf2f(qb.y & 0xffff); qf[11] = bf2f(qb.y >> 16);
        __syncthreads();
        float mx = -1e30f;
        for (int s = g16; s <= t; s += 32) {
            const size_t kr = (size_t)b * SEQ + s;
            const v4u ka = *(const v4u*)(KN + kr * 1024 + h * 128 + 8 * l16); const v2u kb = *(const v2u*)(KRB + kr * 64 + 4 * l16);
            float d = qf[0] * bf2f(ka.x & 0xffff) + qf[1] * bf2f(ka.x >> 16) + qf[2] * bf2f(ka.y & 0xffff) + qf[3] * bf2f(ka.y >> 16) + qf[4] * bf2f(ka.z & 0xffff) + qf[5] * bf2f(ka.z >> 16) + qf[6] * bf2f(ka.w & 0xffff) + qf[7] * bf2f(ka.w >> 16)
                    + qf[8] * bf2f(kb.x & 0xffff) + qf[9] * bf2f(kb.x >> 16) + qf[10] * bf2f(kb.y & 0xffff) + qf[11] * bf2f(kb.y >> 16);
            { const int ln = tid & 63; d += shx(d, 1, ln); d += shx(d, 2, ln); d += shx(d, 4, ln); d += shx(d, 8, ln); }
            if (l16 == 0) sc[s] = d;
            mx = fmaxf(mx, d);
        }
        mx = wave_max(mx);
        if ((tid & 63) == 0) red[wave] = mx;
        __syncthreads();
        mx = fmaxf(fmaxf(fmaxf(red[0], red[1]), fmaxf(red[2], red[3])), fmaxf(fmaxf(red[4], red[5]), fmaxf(red[6], red[7])));
        float sum = 0.f;
        for (int s = tid; s <= t; s += NTHR) { const float p = exp2f(sc[s] - mx); sc[s] = p; sum += p; }
        sum = wave_sum(sum);
        if ((tid & 63) == 0) red[8 + wave] = sum;
        __syncthreads();
        sum = ((red[8] + red[9]) + (red[10] + red[11])) + ((red[12] + red[13]) + (red[14] + red[15]));
        const int d = tid & 127, pt = tid >> 7;
        float o = 0.f;
        for (int s = pt; s <= t; s += 4) o += sc[s] * bf2f(VV[((size_t)b * SEQ + s) * 1024 + h * 128 + d]);
        part[pt * 128 + d] = o;
        __syncthreads();
        if (pt == 0) O[row * 1024 + h * 128 + d] = (bf16)f2bf(((part[d] + part[128 + d]) + (part[256 + d] + part[384 + d])) / sum);
    }
}
__device__ __forceinline__ void decode_naive_phase(const bf16* QN, const bf16* QR, const bf16* WUKVN, const bf16* WUKV, const float* cache_c, const float* cache_kr, const int* page_table,
                                                   const float* c_s, const float* kr_s, float* SC, bf16* O, LAS unsigned char* lds, int wg, int G, int tid) {
    LAS float* ql = (LAS float*)lds;
    LAS float* qr = ql + 8 * 256;
    LAS float* red = qr + 8 * 64;
    LAS float* smx = red + 64;
    LAS float* ssum = smx + 8;
    LAS float* part = ssum + 8;
    const int lane = tid & 63, wave = tid >> 6;
    for (int b = wg; b < DB; b += G) {
        const size_t row = (size_t)MP + b;
        __syncthreads();
        { const int c = tid & 255, hh = tid >> 8;
            for (int h = hh * 4; h < hh * 4 + 4; ++h) { float a = 0.f;
                for (int n = 0; n < 128; ++n) a += bf2f(QN[row * 1024 + h * 128 + n]) * bf2f(WUKVN[(size_t)c * 2048 + h * 256 + n]);
                ql[h * 256 + c] = a; } }
        qr[tid] = bf2f(QR[row * 512 + tid]);
        __syncthreads();
        float* sc = SC + (size_t)b * 8 * SCP;
        float mx[8];
#pragma unroll
        for (int h = 0; h < 8; ++h) mx[h] = -1e30f;
        for (int s = wave; s <= PAST; s += NWAVES) {
            const float* cp; const float* kp;
            if (s < PAST) { const int pg = page_table[b * NPAGES + (s >> 7)]; cp = cache_c + ((size_t)pg * PAGE + (s & 127)) * 256; kp = cache_kr + ((size_t)pg * PAGE + (s & 127)) * 64; }
            else { cp = c_s + (size_t)b * 256; kp = kr_s + (size_t)b * 64; }
            const f32x4 cv = *(const f32x4*)(cp + 4 * lane); const float kv = kp[lane];
#pragma unroll
            for (int h = 0; h < 8; ++h) {
                const f32x4 q4 = *(const LAS f32x4*)(ql + h * 256 + 4 * lane);
                float d = (q4[0] * cv[0] + q4[1] * cv[1]) + (q4[2] * cv[2] + q4[3] * cv[3]) + qr[h * 64 + lane] * kv;
                d = wave_sum(d);
                if (lane == 0) sc[(size_t)h * SCP + s] = d;
                mx[h] = fmaxf(mx[h], d);
            }
        }
#pragma unroll
        for (int h = 0; h < 8; ++h) if (lane == 0) red[h * 8 + wave] = mx[h];
        asm volatile("s_waitcnt vmcnt(0)" ::: "memory");
        __syncthreads();
        if (tid < 8) { float m = red[tid * 8]; for (int w = 1; w < 8; ++w) m = fmaxf(m, red[tid * 8 + w]); smx[tid] = m; }
        __syncthreads();
#pragma unroll
        for (int h = 0; h < 8; ++h) {
            float sum = 0.f; const float m = smx[h];
            for (int s = tid; s <= PAST; s += NTHR) { const float p = exp2f(sc[(size_t)h * SCP + s] - m); sc[(size_t)h * SCP + s] = p; sum += p; }
            sum = wave_sum(sum);
            if (lane == 0) red[h * 8 + wave] = sum;
        }
        asm volatile("s_waitcnt vmcnt(0)" ::: "memory");
        __syncthreads();
        if (tid < 8) { float m = 0.f; for (int w = 0; w < 8; ++w) m += red[tid * 8 + w]; ssum[tid] = m; }
        __syncthreads();
        { const int c = tid & 255, pt = tid >> 8;
            float a[8];
#pragma unroll
            for (int h = 0; h < 8; ++h) a[h] = 0.f;
            for (int s = pt; s <= PAST; s += 2) {
                float cv;
                if (s < PAST) { const int pg = page_table[b * NPAGES + (s >> 7)]; cv = cache_c[((size_t)pg * PAGE + (s & 127)) * 256 + c]; }
                else cv = c_s[(size_t)b * 256 + c];
#pragma unroll
                for (int h = 0; h < 8; ++h) a[h] += sc[(size_t)h * SCP + s] * cv;
            }
#pragma unroll
            for (int h = 0; h < 8; ++h) part[(pt * 8 + h) * 256 + c] = a[h];
        }
        __syncthreads();
        for (int i = tid; i < 8 * 256; i += NTHR) { const int h = i >> 8; ql[i] = (part[i] + part[8 * 256 + i]) / ssum[h]; }
        __syncthreads();
        for (int idx = tid; idx < 1024; idx += NTHR) {
            const int h = idx >> 7; const bf16* w = WUKV + (size_t)(1024 + idx) * 256; float a = 0.f;
            for (int c = 0; c < 256; ++c) a += ql[h * 256 + c] * bf2f(w[c]);
            O[row * 1024 + idx] = (bf16)f2bf(a);
        }
    }
}
typedef float f32x16 __attribute__((ext_vector_type(16)));
__device__ __forceinline__ void attn_prompt_phase(const bf16* QN, const bf16* QR, const bf16* KN, const bf16* KRB, const bf16* VT, bf16* O, LAS unsigned char* lds, int wg, int G, int tid) {
    constexpr int KP = 400, VP = 136, KTB = 64 * KP, VTB = 128 * VP, BUFB = KTB + VTB;
    const int lane = tid & 63, wave = __builtin_amdgcn_readfirstlane(tid >> 6), r32 = lane & 31, hh = lane >> 5;
    const int c0 = tid, c1 = tid + 512;
    for (int unit = wg; unit < 256; unit += G) {
        const int bh = unit >> 2, pr = unit & 3, b = bh >> 3, h = bh & 7;
        for (int half = 0; half < 2; ++half) {
            const int qb = half ? 7 - pr : pr; const int ntiles = 4 * (qb + 1); const int q0 = 256 * qb + 32 * wave;
            const size_t qrow = (size_t)b * SEQ + q0 + r32;
            bf16x8 Qf[12];
#pragma unroll
            for (int ks = 0; ks < 8; ++ks) Qf[ks] = *(const bf16x8*)(QN + qrow * 1024 + h * 128 + 16 * ks + 8 * hh);
#pragma unroll
            for (int ks = 0; ks < 4; ++ks) Qf[8 + ks] = *(const bf16x8*)(QR + qrow * 512 + h * 64 + 16 * ks + 8 * hh);
            f32x16 Oa[4];
#pragma unroll
            for (int nb = 0; nb < 4; ++nb)
#pragma unroll
                for (int i = 0; i < 16; ++i) Oa[nb][i] = 0.f;
            float m = -1e30f, l = 0.f;
            v4u sk0, sk1, skr, sv0, sv1;
#define ATT_LOAD(kt) do { const size_t key0 = (size_t)b * SEQ + 64 * (kt); \
                sk0 = *(const v4u*)(KN + (key0 + (c0 >> 4)) * 1024 + h * 128 + (c0 & 15) * 8); sk1 = *(const v4u*)(KN + (key0 + (c1 >> 4)) * 1024 + h * 128 + (c1 & 15) * 8); \
                skr = *(const v4u*)(KRB + (key0 + (tid >> 3)) * 64 + (tid & 7) * 8); \
                sv0 = *(const v4u*)(VT + (size_t)(h * 128 + (c0 >> 3)) * MP + key0 + (c0 & 7) * 8); sv1 = *(const v4u*)(VT + (size_t)(h * 128 + (c1 >> 3)) * MP + key0 + (c1 & 7) * 8); } while (0)
#define ATT_WRITE(bi) do { LAS unsigned char* base = lds + (bi) * BUFB; \
                *(LAS v4u*)(base + (c0 >> 4) * KP + (c0 & 15) * 16) = sk0; *(LAS v4u*)(base + (c1 >> 4) * KP + (c1 & 15) * 16) = sk1; *(LAS v4u*)(base + (tid >> 3) * KP + 256 + (tid & 7) * 16) = skr; \
                { LAS v2u* p = (LAS v2u*)(base + KTB + (c0 >> 3) * VP + (c0 & 7) * 16); p[0] = (v2u){sv0.x, sv0.y}; p[1] = (v2u){sv0.z, sv0.w}; } \
                { LAS v2u* p = (LAS v2u*)(base + KTB + (c1 >> 3) * VP + (c1 & 7) * 16); p[0] = (v2u){sv1.x, sv1.y}; p[1] = (v2u){sv1.z, sv1.w}; } } while (0)
            ATT_LOAD(0); ATT_WRITE(0);
            __syncthreads();
            for (int kt = 0; kt < ntiles; ++kt) {
                if (kt + 1 < ntiles) ATT_LOAD(kt + 1);
                if (64 * kt <= q0 + 31) {
                    const LAS unsigned char* kb_ = lds + (kt & 1) * BUFB; const LAS unsigned char* vb_ = kb_ + KTB;
                    for (int kb = 0; kb < 2; ++kb) {
                        if (64 * kt + 32 * kb > q0 + 31) break;
                        f32x16 X;
#pragma unroll
                        for (int i = 0; i < 16; ++i) X[i] = 0.f;
                        const LAS unsigned char* kp = kb_ + (32 * kb + r32) * KP + hh * 16;
#pragma unroll
                        for (int ks = 0; ks < 12; ++ks) {
                            const bf16x8 kf = *(const LAS bf16x8*)(kp + ks * 32);
                            X = __builtin_amdgcn_mfma_f32_32x32x16_bf16(kf, Qf[ks], X, 0, 0, 0);
                            if ((ks & 3) == 3) asm volatile("" ::: "memory");
                        }
                        if (64 * kt + 32 * kb + 31 > q0) {
                            const int qi = q0 + r32, kbase = 64 * kt + 32 * kb + 4 * hh;
#pragma unroll
                            for (int i = 0; i < 16; ++i) { const int kr = kbase + (i & 3) + 8 * (i >> 2); if (kr > qi) X[i] = -1e30f; }
                        }
                        float mx = X[0];
#pragma unroll
                        for (int i = 1; i < 16; ++i) mx = fmaxf(mx, X[i]);
                        mx = fmaxf(mx, shx(mx, 32, lane));
                        const float mn = fmaxf(m, mx), alpha = __builtin_amdgcn_exp2f(m - mn); m = mn;
                        float ls = 0.f;
#pragma unroll
                        for (int i = 0; i < 16; ++i) { X[i] = __builtin_amdgcn_exp2f(X[i] - mn); ls += X[i]; }
                        l = l * alpha + ls;
                        if (__any(alpha != 1.0f)) {
#pragma unroll
                            for (int nb = 0; nb < 4; ++nb)
#pragma unroll
                                for (int i = 0; i < 16; ++i) Oa[nb][i] *= alpha;
                        }
                        bf16x8 Pf[2];
#pragma unroll
                        for (int s = 0; s < 2; ++s) {
                            v4u w0;
                            w0.x = cvtpk(X[8 * s + 0], X[8 * s + 1]); w0.y = cvtpk(X[8 * s + 2], X[8 * s + 3]); w0.z = cvtpk(X[8 * s + 4], X[8 * s + 5]); w0.w = cvtpk(X[8 * s + 6], X[8 * s + 7]);
                            Pf[s] = __builtin_bit_cast(bf16x8, w0);
                        }
                        const LAS unsigned char* vp0 = vb_ + r32 * VP + (32 * kb + 4 * hh) * 2;
#pragma unroll
                        for (int nb = 0; nb < 4; ++nb) {
#pragma unroll
                            for (int s = 0; s < 2; ++s) {
                                const LAS unsigned char* vp = vp0 + 32 * nb * VP + 32 * s;
                                const v2u a0 = *(const LAS v2u*)vp, a1 = *(const LAS v2u*)(vp + 16);
                                const v4u av = (v4u){a0.x, a0.y, a1.x, a1.y};
                                Oa[nb] = __builtin_amdgcn_mfma_f32_32x32x16_bf16(__builtin_bit_cast(bf16x8, av), Pf[s], Oa[nb], 0, 0, 0);
                            }
                            if (nb & 1) asm volatile("" ::: "memory");
                        }
                    }
                }
                if (kt + 1 < ntiles) ATT_WRITE((kt + 1) & 1);
                __syncthreads();
            }
#undef ATT_LOAD
#undef ATT_WRITE
            l += shx(l, 32, lane);
            const float inv = 1.0f / l;
            bf16* orow = O + qrow * 1024 + h * 128;
#pragma unroll
            for (int nb = 0; nb < 4; ++nb)
#pragma unroll
                for (int g = 0; g < 4; ++g) {
                    v2u w; w.x = pk2(Oa[nb][4 * g + 0] * inv, Oa[nb][4 * g + 1] * inv); w.y = pk2(Oa[nb][4 * g + 2] * inv, Oa[nb][4 * g + 3] * inv);
                    *(v2u*)(orow + 32 * nb + 8 * g + 4 * hh) = w;
                }
        }
    }
}
typedef float f32x4v __attribute__((ext_vector_type(4)));
__device__ __forceinline__ void hgrn_phase(const bf16* QB, const float* GB, const bf16* VB, const bf16* GATE, const float* gnorm, const float* s0, float* st_p, float* st_s, bf16* OG,
                                           LAS unsigned char* lds, int wg, int G, int tid) {
    constexpr int QDP = 272, TP = 80;
    const int lane = tid & 63, wave = __builtin_amdgcn_readfirstlane(tid >> 6), l15 = lane & 15, q4 = lane >> 4;
    if (wg < 64) {
        LAS unsigned char* QD = lds; LAS unsigned char* KD = QD + 32 * QDP; LAS unsigned char* KLT = KD + 32 * QDP; LAS unsigned char* VTt = KLT + 128 * TP; LAS unsigned char* AM = VTt + 128 * TP;
        LAS float* Dv = (LAS float*)(AM + 32 * TP); LAS float* tot = Dv + 128; LAS float* ssq = tot + 512;
        const int kc = tid & 127, tg = tid >> 7;
        for (int unit = wg; unit < 64; unit += G) {
            const int b = unit >> 3, h = unit & 7; const size_t row0 = (size_t)b * SEQ;
            f32x4v S[8];
#pragma unroll
            for (int kt = 0; kt < 8; ++kt) S[kt] = (f32x4v){0.f, 0.f, 0.f, 0.f};
            const float gn = gnorm[h * 128 + 16 * wave + l15];
            float gr[8]; unsigned qr[8], vr[8];
#define HG_LOAD(c) do { _Pragma("unroll") for (int i = 0; i < 8; ++i) { const size_t o_ = (row0 + 32 * (c) + 8 * tg + i) * 1024 + h * 128 + kc; gr[i] = GB[o_]; qr[i] = QB[o_]; vr[i] = VB[o_]; } } while (0)
            HG_LOAD(0);
            for (int c = 0; c < SEQ / 32; ++c) {
                float p[8]; p[0] = gr[0];
#pragma unroll
                for (int i = 1; i < 8; ++i) p[i] = p[i - 1] + gr[i];
                tot[tg * 128 + kc] = p[7];
                __syncthreads();
                float off = 0.f, blast = 0.f;
#pragma unroll
                for (int j = 0; j < 4; ++j) { const float tv = tot[j * 128 + kc]; blast += tv; if (j < tg) off += tv; }
                float kl[8];
#pragma unroll
                for (int i = 0; i < 8; ++i) {
                    const float bc = off + p[i], e = __expf(bc), kk = -expm1f(gr[i]);
                    const float qd = bf2f(qr[i]) * e, kd = kk * __expf(-fmaxf(bc, -80.f)); kl[i] = kk * __expf(blast - bc);
                    *(LAS bf16*)(QD + (8 * tg + i) * QDP + kc * 2) = (bf16)f2bf(qd);
                    *(LAS bf16*)(KD + (8 * tg + i) * QDP + kc * 2) = (bf16)f2bf(kd);
                }
                *(LAS v4u*)(KLT + kc * TP + tg * 16) = (v4u){pk2(kl[0], kl[1]), pk2(kl[2], kl[3]), pk2(kl[4], kl[5]), pk2(kl[6], kl[7])};
                *(LAS v4u*)(VTt + kc * TP + tg * 16) = (v4u){vr[0] | (vr[1] << 16), vr[2] | (vr[3] << 16), vr[4] | (vr[5] << 16), vr[6] | (vr[7] << 16)};
                if (tg == 0) Dv[kc] = __expf(blast);
                __syncthreads();
                if (c + 1 < SEQ / 32) HG_LOAD(c + 1);
                unsigned gt[8];
#pragma unroll
                for (int i = 0; i < 8; ++i) gt[i] = GATE[(row0 + 32 * c + 16 * (i >> 2) + 4 * q4 + (i & 3)) * 1024 + h * 128 + 16 * wave + l15];
                if (wave < 4) {
                    const int ti = wave >> 1, si = wave & 1; f32x4v a = (f32x4v){0.f, 0.f, 0.f, 0.f};
                    if (si <= ti) {
#pragma unroll
                        for (int ks = 0; ks < 4; ++ks) {
                            const bf16x8 af = *(const LAS bf16x8*)(QD + (16 * ti + l15) * QDP + 64 * ks + 16 * q4), bfr = *(const LAS bf16x8*)(KD + (16 * si + l15) * QDP + 64 * ks + 16 * q4);
                            a = __builtin_amdgcn_mfma_f32_16x16x32_bf16(af, bfr, a, 0, 0, 0);
                        }
                    }
#pragma unroll
                    for (int r = 0; r < 4; ++r) { const int t = 16 * ti + 4 * q4 + r, s = 16 * si + l15; *(LAS bf16*)(AM + t * TP + s * 2) = (bf16)f2bf(s <= t ? a[r] : 0.f); }
                }
                __syncthreads();
                const bf16x8 vtf = *(const LAS bf16x8*)(VTt + (16 * wave + l15) * TP + 16 * q4);
                bf16x8 Sb[4];
#pragma unroll
                for (int ks = 0; ks < 4; ++ks) { const v4u w = (v4u){pk2(S[2 * ks][0], S[2 * ks][1]), pk2(S[2 * ks][2], S[2 * ks][3]), pk2(S[2 * ks + 1][0], S[2 * ks + 1][1]), pk2(S[2 * ks + 1][2], S[2 * ks + 1][3])}; Sb[ks] = __builtin_bit_cast(bf16x8, w); }
                f32x4v o[2];
#pragma unroll
                for (int tt = 0; tt < 2; ++tt) {
                    const bf16x8 amf = *(const LAS bf16x8*)(AM + (16 * tt + l15) * TP + 16 * q4);
                    o[tt] = __builtin_amdgcn_mfma_f32_16x16x32_bf16(amf, vtf, (f32x4v){0.f, 0.f, 0.f, 0.f}, 0, 0, 0);
#pragma unroll
                    for (int ks = 0; ks < 4; ++ks) {
                        const LAS unsigned char* qp = QD + (16 * tt + l15) * QDP + (32 * ks + 4 * q4) * 2;
                        const v2u a0 = *(const LAS v2u*)qp, a1 = *(const LAS v2u*)(qp + 32);
                        const v4u av = (v4u){a0.x, a0.y, a1.x, a1.y};
                        o[tt] = __builtin_amdgcn_mfma_f32_16x16x32_bf16(__builtin_bit_cast(bf16x8, av), Sb[ks], o[tt], 0, 0, 0);
                    }
                }
#pragma unroll
                for (int kt = 0; kt < 8; ++kt) {
                    const f32x4v d4 = *(const LAS f32x4v*)(Dv + 16 * kt + 4 * q4);
                    const bf16x8 klf = *(const LAS bf16x8*)(KLT + (16 * kt + l15) * TP + 16 * q4);
                    S[kt] = __builtin_amdgcn_mfma_f32_16x16x32_bf16(klf, vtf, S[kt] * d4, 0, 0, 0);
                }
#pragma unroll
                for (int tt = 0; tt < 2; ++tt)
#pragma unroll
                    for (int r = 0; r < 4; ++r) { float ss = o[tt][r] * o[tt][r]; ss += shx(ss, 1, lane); ss += shx(ss, 2, lane); ss += shx(ss, 4, lane); ss += shx(ss, 8, lane);
                        if (l15 == 0) ssq[(16 * tt + 4 * q4 + r) * 8 + wave] = ss; }
                __syncthreads();
#pragma unroll
                for (int tt = 0; tt < 2; ++tt)
#pragma unroll
                    for (int r = 0; r < 4; ++r) { const int t = 16 * tt + 4 * q4 + r;
                        const f32x4v s0v = *(const LAS f32x4v*)(ssq + t * 8), s1v = *(const LAS f32x4v*)(ssq + t * 8 + 4);
                        const float rs = rsqrtf(((s0v[0] + s0v[1]) + (s0v[2] + s0v[3]) + (s1v[0] + s1v[1]) + (s1v[2] + s1v[3])) * (1.f / 128.f) + EPS);
                        OG[(row0 + 32 * c + t) * 1024 + h * 128 + 16 * wave + l15] = (bf16)f2bf(o[tt][r] * rs * gn * bf2f(gt[4 * tt + r])); }
            }
#undef HG_LOAD
            float* so = st_p + ((size_t)b * HA + h) * DK * DV + 16 * wave + l15;
#pragma unroll
            for (int kt = 0; kt < 8; ++kt)
#pragma unroll
                for (int r = 0; r < 4; ++r) so[(size_t)(16 * kt + 4 * q4 + r) * DV] = S[kt][r];
            __syncthreads();
        }
    }
    if (G <= 64 || wg >= 64) {
        LAS float* sq = (LAS float*)lds; LAS float* sf = sq + 128; LAS float* skk = sf + 128; LAS float* sv = skk + 128; LAS float* red = sv + 128; LAS float* po = red + 16;
        const int first = G > 64 ? wg - 64 : wg, step = G > 64 ? G - 64 : G;
        for (int unit = first; unit < DB * HA; unit += step) {
            const int b = unit >> 3, h = unit & 7; const size_t idx = ((size_t)MP + b) * 1024 + h * 128 + (tid & 127); const size_t sb = ((size_t)b * HA + h) * DK * DV;
            __syncthreads();
            if (tid < 128) { sq[tid] = bf2f(QB[idx]); const float g = GB[idx]; sf[tid] = expf(g); skk[tid] = -expm1f(g); sv[tid] = bf2f(VB[idx]); }
            __syncthreads();
            const int dv4 = (tid & 31) * 4, kg = tid >> 5;
            const f32x4v vv = *(const LAS f32x4v*)(sv + dv4); f32x4v oacc = (f32x4v){0.f, 0.f, 0.f, 0.f};
#pragma unroll
            for (int i = 0; i < 8; ++i) { const int k = kg + 16 * i; const f32x4v s = *(const f32x4v*)(s0 + sb + (size_t)k * DV + dv4);
                const f32x4v sn = s * sf[k] + vv * skk[k]; *(f32x4v*)(st_s + sb + (size_t)k * DV + dv4) = sn; oacc += sn * sq[k]; }
            *(LAS f32x4v*)(po + kg * 128 + dv4) = oacc;
            __syncthreads();
            float ov = 0.f;
            if (tid < 128) {
#pragma unroll
                for (int j = 0; j < 16; ++j) ov += po[j * 128 + tid];
            }
            const float ss = wave_sum(ov * ov);
            if (tid < 128 && lane == 0) red[wave] = ss;
            __syncthreads();
            if (tid < 128) { const float rs = rsqrtf((red[0] + red[1]) * (1.f / 128.f) + EPS); OG[idx] = (bf16)f2bf(ov * rs * gnorm[h * 128 + tid] * bf2f(GATE[idx])); }
        }
    }
}
__device__ __forceinline__ void decode_phase(const bf16* QN, const bf16* QR, const bf16* WUKVN, const float* cache_c, const float* cache_kr, const int* page_table,
                                             float* PART, float* PML, float* QLAT, LAS unsigned char* lds, int wg, int G, int tid) {
    constexpr int QLP = 656;
    LAS unsigned char* QL = lds;
    LAS float* WO = (LAS float*)(lds + 16384);
    LAS float* WM = WO + 8 * 8 * 256;
    const int lane = tid & 63, wave = __builtin_amdgcn_readfirstlane(tid >> 6), l15 = lane & 15, q4 = lane >> 4;
    for (int unit = wg; unit < 2 * DB; unit += G) {
        const int b = unit >> 1, sp = unit & 1; const size_t row = (size_t)MP + b;
        __syncthreads();
        {
            const int c = tid & 255, hh = tid >> 8;
#pragma unroll 1
            for (int h = hh * 4; h < hh * 4 + 4; ++h) {
                const v4u* qp = (const v4u*)(QN + row * 1024 + h * 128); const v4u* wp = (const v4u*)(WUKVN + (size_t)c * 2048 + h * 256);
                float a = 0.f;
#pragma unroll 4
                for (int i = 0; i < 16; ++i) { const v4u qv = qp[i], wv = wp[i];
                    a += bf2f(qv.x & 0xffff) * bf2f(wv.x & 0xffff) + bf2f(qv.x >> 16) * bf2f(wv.x >> 16) + bf2f(qv.y & 0xffff) * bf2f(wv.y & 0xffff) + bf2f(qv.y >> 16) * bf2f(wv.y >> 16)
                       + bf2f(qv.z & 0xffff) * bf2f(wv.z & 0xffff) + bf2f(qv.z >> 16) * bf2f(wv.z >> 16) + bf2f(qv.w & 0xffff) * bf2f(wv.w & 0xffff) + bf2f(qv.w >> 16) * bf2f(wv.w >> 16); }
                *(LAS bf16*)(QL + h * QLP + c * 2) = (bf16)f2bf(a);
                if (sp == 0) QLAT[((size_t)b * 8 + h) * 320 + c] = a;
            }
            { const int h = tid >> 6, i = tid & 63; const unsigned qv = QR[row * 512 + tid]; *(LAS bf16*)(QL + h * QLP + 512 + i * 2) = (bf16)qv; if (sp == 0) QLAT[((size_t)b * 8 + h) * 320 + 256 + i] = bf2f(qv); }
            for (int i = tid; i < 8 * QLP / 4; i += NTHR) ((LAS unsigned*)(QL + 8 * QLP))[i] = 0u;
        }
        __syncthreads();
        bf16x8 ID[2];
        { v4u w0, w1; const int kl = 8 * q4;
#define IDW(x, j) ((kl + (j) == 16 * (x) + l15) ? 0x3F80u : 0u)
            w0.x = IDW(0, 0) | (IDW(0, 1) << 16); w0.y = IDW(0, 2) | (IDW(0, 3) << 16); w0.z = IDW(0, 4) | (IDW(0, 5) << 16); w0.w = IDW(0, 6) | (IDW(0, 7) << 16);
            w1.x = IDW(1, 0) | (IDW(1, 1) << 16); w1.y = IDW(1, 2) | (IDW(1, 3) << 16); w1.z = IDW(1, 4) | (IDW(1, 5) << 16); w1.w = IDW(1, 6) | (IDW(1, 7) << 16);
#undef IDW
            ID[0] = __builtin_bit_cast(bf16x8, w0); ID[1] = __builtin_bit_cast(bf16x8, w1); }
        f32x4v Oa[16];
#pragma unroll
        for (int cb = 0; cb < 16; ++cb) Oa[cb] = (f32x4v){0.f, 0.f, 0.f, 0.f};
        float m = -1e30f, l = 0.f;
        const LAS unsigned char* qfp = QL + l15 * QLP + 16 * q4;
        for (int pi = 0; pi < 4; ++pi) {
            const int page = page_table[b * NPAGES + 32 * sp + 4 * wave + pi];
            for (int st = 0; st < 8; ++st) {
                const size_t slot = (size_t)page * PAGE + 16 * st + l15;
                const GAS float* crow = (const GAS float*)cache_c + slot * 256 + 8 * q4; const GAS float* krow = (const GAS float*)cache_kr + slot * 64 + 8 * q4;
                f32x4v raw[20];
#pragma unroll
                for (int ks = 0; ks < 10; ++ks) {
                    const GAS float* p = ks < 8 ? crow + 32 * ks : krow + 32 * (ks - 8);
                    raw[2 * ks] = __builtin_nontemporal_load((const GAS f32x4v*)p); raw[2 * ks + 1] = __builtin_nontemporal_load((const GAS f32x4v*)(p + 4));
                }
                bf16x8 Cf[10];
#pragma unroll
                for (int ks = 0; ks < 10; ++ks) {
                    const f32x4v r0 = raw[2 * ks], r1 = raw[2 * ks + 1];
                    const v4u w = (v4u){cvtpk(r0[0], r0[1]), cvtpk(r0[2], r0[3]), cvtpk(r1[0], r1[1]), cvtpk(r1[2], r1[3])};
                    Cf[ks] = __builtin_bit_cast(bf16x8, w);
                }
                f32x4v S = (f32x4v){0.f, 0.f, 0.f, 0.f};
#pragma unroll
                for (int ks = 0; ks < 10; ++ks) { const bf16x8 qf = *(const LAS bf16x8*)(qfp + 64 * ks); S = __builtin_amdgcn_mfma_f32_16x16x32_bf16(Cf[ks], qf, S, 0, 0, 0); }
                float mx = fmaxf(fmaxf(S[0], S[1]), fmaxf(S[2], S[3]));
                mx = fmaxf(mx, shx(mx, 16, lane)); mx = fmaxf(mx, shx(mx, 32, lane));
                const float mn = fmaxf(m, mx), alpha = __builtin_amdgcn_exp2f(m - mn); m = mn;
                const float p0 = __builtin_amdgcn_exp2f(S[0] - mn), p1 = __builtin_amdgcn_exp2f(S[1] - mn), p2 = __builtin_amdgcn_exp2f(S[2] - mn), p3 = __builtin_amdgcn_exp2f(S[3] - mn);
                l = l * alpha + ((p0 + p1) + (p2 + p3));
                if (__any(alpha != 1.0f)) {
#pragma unroll
                    for (int cb = 0; cb < 16; ++cb) Oa[cb] *= alpha;
                }
                const v4u pw = (v4u){cvtpk(p0, p1), cvtpk(p2, p3), 0u, 0u};
                const bf16x8 Pf = __builtin_bit_cast(bf16x8, pw);
#pragma unroll
                for (int cb = 0; cb < 16; ++cb) {
                    const f32x4v Dt = __builtin_amdgcn_mfma_f32_16x16x32_bf16(Cf[cb >> 1], ID[cb & 1], (f32x4v){0.f, 0.f, 0.f, 0.f}, 0, 0, 0);
                    const v4u aw = (v4u){cvtpk(Dt[0], Dt[1]), cvtpk(Dt[2], Dt[3]), 0u, 0u};
                    Oa[cb] = __builtin_amdgcn_mfma_f32_16x16x32_bf16(__builtin_bit_cast(bf16x8, aw), Pf, Oa[cb], 0, 0, 0);
                }
            }
        }
        l += shx(l, 16, lane); l += shx(l, 32, lane);
        if (l15 < 8) {
#pragma unroll
            for (int cb = 0; cb < 16; ++cb) *(LAS f32x4v*)(WO + (wave * 8 + l15) * 256 + 16 * cb + 4 * q4) = Oa[cb];
            if (q4 == 0) { WM[(wave * 8 + l15) * 2] = m; WM[(wave * 8 + l15) * 2 + 1] = l; }
        }
        __syncthreads();
        {
            const int t2 = wave * 64 + lane_id_v(); const int h = t2 >> 6, ch4 = (t2 & 63) * 4;
            float M = -1e30f;
#pragma unroll
            for (int w = 0; w < 8; ++w) M = fmaxf(M, WM[(w * 8 + h) * 2]);
            float L = 0.f; f32x4v acc = (f32x4v){0.f, 0.f, 0.f, 0.f};
#pragma unroll
            for (int w = 0; w < 8; ++w) { const float e = __builtin_amdgcn_exp2f(WM[(w * 8 + h) * 2] - M); L += WM[(w * 8 + h) * 2 + 1] * e; acc += *(const LAS f32x4v*)(WO + (w * 8 + h) * 256 + ch4) * e; }
            *(f32x4v*)(PART + (((size_t)b * 2 + sp) * 8 + h) * 256 + ch4) = acc;
            if ((t2 & 63) == 0) { PML[(((size_t)b * 2 + sp) * 8 + h) * 2] = M; PML[(((size_t)b * 2 + sp) * 8 + h) * 2 + 1] = L; }
        }
    }
}
__device__ __forceinline__ void decode_combine_phase(const float* PART, const float* PML, const float* QLAT, const float* c_s, const float* kr_s, const bf16* WUKV, bf16* O, LAS unsigned char* lds, int wg, int G, int tid) {
    LAS float* ol = (LAS float*)lds;
    LAS float* sn = ol + 8 * 256;
    const int lane = tid & 63, wave = __builtin_amdgcn_readfirstlane(tid >> 6);
    for (int b = wg; b < DB; b += G) {
        __syncthreads();
        { const float* q = QLAT + ((size_t)b * 8 + wave) * 320; float d = 0.f;
#pragma unroll
            for (int i = 0; i < 4; ++i) d += q[lane + 64 * i] * c_s[(size_t)b * 256 + lane + 64 * i];
            d += q[256 + lane] * kr_s[(size_t)b * 64 + lane];
            d = wave_sum(d);
            if (lane == 0) sn[wave] = d; }
        __syncthreads();
        { const int h = tid >> 6, ch4 = (tid & 63) * 4;
            const float m0 = PML[(((size_t)b * 2 + 0) * 8 + h) * 2], l0 = PML[(((size_t)b * 2 + 0) * 8 + h) * 2 + 1], m1 = PML[(((size_t)b * 2 + 1) * 8 + h) * 2], l1 = PML[(((size_t)b * 2 + 1) * 8 + h) * 2 + 1], s2 = sn[h];
            const float Mx = fmaxf(fmaxf(m0, m1), s2), w0 = __builtin_amdgcn_exp2f(m0 - Mx), w1 = __builtin_amdgcn_exp2f(m1 - Mx), w2 = __builtin_amdgcn_exp2f(s2 - Mx);
            const float invL = 1.0f / (l0 * w0 + l1 * w1 + w2);
            const f32x4v a0 = *(const f32x4v*)(PART + (((size_t)b * 2 + 0) * 8 + h) * 256 + ch4), a1 = *(const f32x4v*)(PART + (((size_t)b * 2 + 1) * 8 + h) * 256 + ch4), cn = *(const f32x4v*)(c_s + (size_t)b * 256 + ch4);
            *(LAS f32x4v*)(ol + h * 256 + ch4) = (a0 * w0 + a1 * w1 + cn * w2) * invL; }
        __syncthreads();
        for (int idx = tid; idx < 1024; idx += NTHR) {
            const int h = idx >> 7; const v4u* w = (const v4u*)(WUKV + (size_t)(1024 + idx) * 256); const LAS float* o = ol + h * 256; float a = 0.f;
#pragma unroll 4
            for (int i = 0; i < 32; ++i) { const v4u wv = w[i]; const f32x4v o0 = *(const LAS f32x4v*)(o + 8 * i), o1 = *(const LAS f32x4v*)(o + 8 * i + 4);
                a += o0[0] * bf2f(wv.x & 0xffff) + o0[1] * bf2f(wv.x >> 16) + o0[2] * bf2f(wv.y & 0xffff) + o0[3] * bf2f(wv.y >> 16) + o1[0] * bf2f(wv.z & 0xffff) + o1[1] * bf2f(wv.z >> 16) + o1[2] * bf2f(wv.w & 0xffff) + o1[3] * bf2f(wv.w >> 16); }
            O[((size_t)MP + b) * 1024 + idx] = (bf16)f2bf(a);
        }
    }
}
constexpr int NPH = 1 + 4 * 11;
__host__ __device__ constexpr bool phase_exists(int k) {
    if (k == 0) return true;
    const int l = (k - 1) / 11, s = (k - 1) % 11;
    if (l < 2) return !(s >= 2 && s <= 5);
    return s != 3 || l == 2;
}
struct Args { const float* in[21]; float* out; unsigned char* ws; int ph_lo, ph_hi, li, pad; };


__device__ __forceinline__ unsigned long long karg64(int byte_off) {
    unsigned long long v;
    asm volatile("s_load_dwordx2 %0, %1, %2\n\ts_waitcnt lgkmcnt(0)" : "=s"(v) : "s"(__builtin_amdgcn_kernarg_segment_ptr()), "i"(byte_off) : "memory");
    return v;
}
__device__ __forceinline__ int karg32(int byte_off) {
    int v;
    asm volatile("s_load_dword %0, %1, %2\n\ts_waitcnt lgkmcnt(0)" : "=s"(v) : "s"(__builtin_amdgcn_kernarg_segment_ptr()), "i"(byte_off) : "memory");
    return v;
}
#define ARG_IN(i) ((const float*)karg64(8 * (i)))
#define ARG_OUT() ((float*)karg64(8 * 21))
#define ARG_WS() ((unsigned char*)karg64(8 * 22))
struct Ctx { LAS unsigned char* lds; int tid, lane, wave, wg, G, gw, NGW; };
__device__ __forceinline__ Ctx fresh(const Ctx& c0) {
    Ctx c; c.lds = c0.lds; int wv = c0.wave; asm volatile("" : "+s"(wv)); int t = wv * 64 + lane_id_v(); int w = blockIdx.x; asm volatile("" : "+s"(w)); int g = gridDim.x; asm volatile("" : "+s"(g));
    c.tid = t; c.lane = t & 63; c.wave = __builtin_amdgcn_readfirstlane(t >> 6); c.wg = w; c.G = g; c.gw = w * NWAVES + c.wave; c.NGW = g * NWAVES; return c;
}

__device__ __forceinline__ void ph_prologue(const Ctx& c0) {
    const Ctx c = fresh(c0);
    unsigned char* ws = ARG_WS();
    const float* norm_gains = ARG_IN(6);
    LAS float* scr = (LAS float*)(c.lds + c.wave * 16384);
    constexpr int NITEMS = 4096 + 1024 + 11264 + 5632 + 192 + 160 + 192 + 576 + 256 + 1024;
    for (int it = c.gw; it < NITEMS; it += c.NGW) {
        int r = it, l; const float* W; int K, N, kind = 0; bf16* WT; const float* gain = nullptr; float scale = 1.f;
        if (r < 4096) { l = r / 2048; r -= l * 2048; W = ARG_IN(9) + (size_t)l * 1024 * 4096; K = 1024; N = 4096; WT = (bf16*)(ws + WS_WIN) + (size_t)l * 4096 * 1024; gain = norm_gains + (l * 4 + 0) * 1024; }
        else if ((r -= 4096) < 1024) { l = r / 512; r -= l * 512; W = ARG_IN(12) + (size_t)l * 1024 * 1024; K = 1024; N = 1024; WT = (bf16*)(ws + WS_WOUTA) + (size_t)l * 1024 * 1024; }
        else if ((r -= 1024) < 11264) { l = r / 2816; r -= l * 2816; W = ARG_IN(7) + (size_t)l * 1024 * 5632; K = 1024; N = 5632; WT = (bf16*)(ws + WS_WFIN) + (size_t)l * 5632 * 1024; kind = 1; gain = norm_gains + (l * 4 + 2) * 1024; }
        else if ((r -= 11264) < 5632) { l = r / 1408; r -= l * 1408; W = ARG_IN(8) + (size_t)l * 2816 * 1024; K = 2816; N = 1024; WT = (bf16*)(ws + WS_WFOUT) + (size_t)l * 1024 * 2816; }
        else if ((r -= 5632) < 192) { W = ARG_IN(17); K = 1024; N = 384; WT = (bf16*)(ws + WS_WDQ0); gain = norm_gains + (2 * 4 + 0) * 1024; }
        else if ((r -= 192) < 160) { W = ARG_IN(14); K = 1024; N = 320; WT = (bf16*)(ws + WS_WDQ0); kind = 2; gain = ARG_IN(13); }
        else if ((r -= 160) < 192) { W = ARG_IN(17) + (size_t)1024 * 384; K = 1024; N = 384; WT = (bf16*)(ws + WS_WDQ1); gain = norm_gains + (3 * 4 + 0) * 1024; }
        else if ((r -= 192) < 576) { l = r / 288; r -= l * 288; W = ARG_IN(19) + (size_t)l * 384 * 1536; K = 384; N = 1536; WT = (bf16*)(ws + WS_WUQ) + (size_t)l * 1536 * 384; kind = 3; gain = ARG_IN(18) + l * 384; scale = QSCALE; }
        else if ((r -= 576) < 256) { W = ARG_IN(16); K = 256; N = 2048; WT = (bf16*)(ws + WS_WUKV); kind = 4; }
        else { r -= 256; l = r / 512; r -= l * 512; W = ARG_IN(20) + (size_t)l * 1024 * 1024; K = 1024; N = 1024; WT = (bf16*)(ws + WS_WOUTB) + (size_t)l * 1024 * 1024; }
        cvt_item(W, K, N, WT, kind, gain, scale, scr, r, c.lane);
    }
    const size_t gt = (size_t)c.wg * NTHR + c.tid, NT = (size_t)c.G * NTHR;
    { bf16* WDQ0 = (bf16*)(ws + WS_WDQ0); bf16* WDQ1 = (bf16*)(ws + WS_WDQ1);
      for (size_t i = gt; i < (size_t)64 * 1024 / 8; i += NT) ((v4u*)(WDQ0 + (size_t)704 * 1024))[i] = (v4u){0u, 0u, 0u, 0u};
      for (size_t i = gt; i < (size_t)128 * 1024 / 8; i += NT) ((v4u*)(WDQ1 + (size_t)384 * 1024))[i] = (v4u){0u, 0u, 0u, 0u}; }
    { const float* w_ukv = ARG_IN(16); bf16* WUKVN = (bf16*)(ws + WS_WUKVN);
      for (size_t i = gt; i < (size_t)256 * 2048 / 4; i += NT) { const f32x4 v = ((const f32x4*)w_ukv)[i]; v2u w; w.x = pk2(v[0], v[1]); w.y = pk2(v[2], v[3]); ((v2u*)WUKVN)[i] = w; } }
    { float* CS = (float*)(ws + WS_CS);
      for (size_t i = gt; i < (size_t)2049 * 32; i += NT) { const int p = (int)(i >> 5), fi = (int)(i & 31); const double pos = p < 2048 ? (double)p : (double)PAST;
        const double ang = pos * pow(10000.0, -(double)fi / 32.0); CS[2 * i] = (float)cos(ang); CS[2 * i + 1] = (float)sin(ang); } }
    { float* LBT = (float*)(ws + WS_LBT); const float* lb_logits = ARG_IN(10);
      for (size_t i = gt; i < 2048; i += NT) { const int l = (int)(i >> 10), d = (int)(i & 1023); float lb = 0.f;
        if (l == 1) lb = 1.f / (1.f + expf(lb_logits[d] - lb_logits[1024 + d]));
        LBT[2 * i] = logf(fmaxf(lb, 1e-30f)); LBT[2 * i + 1] = log1pf(-lb); } }
    { const float* x_prompt = ARG_IN(0); const float* x_sample = ARG_IN(1); float* X = ARG_OUT(); bf16* HN = (bf16*)(ws + WS_HN);
      for (int m = c.gw; m < M; m += c.NGW) {
        const f32x4* xr = (const f32x4*)(m < MP ? x_prompt + (size_t)m * D : x_sample + (size_t)(m - MP) * D) + c.lane; f32x4* xo = (f32x4*)(X + (size_t)m * D) + c.lane;
        f32x4 v[4]; float s = 0.f;
#pragma unroll
        for (int j = 0; j < 4; ++j) { v[j] = xr[64 * j]; xo[64 * j] = v[j]; s += (v[j][0] * v[j][0] + v[j][1] * v[j][1]) + (v[j][2] * v[j][2] + v[j][3] * v[j][3]); }
        const float r = rsqrtf(wave_sum(s) * (1.f / 1024.f) + EPS);
        v2u* o8 = (v2u*)(HN + (size_t)m * D) + c.lane;
#pragma unroll
        for (int j = 0; j < 4; ++j) { v2u w; w.x = pk2(v[j][0] * r, v[j][1] * r); w.y = pk2(v[j][2] * r, v[j][3] * r); o8[64 * j] = w; }
      } }
}
__device__ __forceinline__ void ph_hgrn_in(const Ctx& c0, int l) {
    const Ctx c = fresh(c0);
    unsigned char* ws = ARG_WS();
    const bf16* HN = (const bf16*)(ws + WS_HN); const bf16* Wt = (const bf16*)(ws + WS_WIN) + (size_t)l * 4096 * 1024; const float* lbt = (const float*)(ws + WS_LBT) + (size_t)l * 2048;
    bf16* QB = (bf16*)(ws + WS_QB); float* GB = (float*)(ws + WS_GB); bf16* VB = (bf16*)(ws + WS_VB); bf16* GATE = (bf16*)(ws + WS_GATE);
    pg8::Gemm g{HN, Wt, MP, 4096, 1024}; pg8::StaticOrder S; S.init(MP, 4096, c.G, c.wg);
    pg8::EpiHgrnIn E{ws, l};
    pg8::gemm_phase<pg8::EpiHgrnIn, pg8::StaticOrder, true, true>(c.lds, g, S, E, c.tid);
    const Ctx c2 = fresh(c0);
    sg_hgrn_in(HN, Wt, QB, GB, VB, GATE, lbt, c2.gw, c2.NGW, c2.lane);
}
__device__ __forceinline__ void ph_hgrn_rec(const Ctx& c0, int l) {
    const Ctx c = fresh(c0);
    unsigned char* ws = ARG_WS(); float* X = ARG_OUT();
    float* st_p = X + (size_t)M * D; float* st_s = st_p + (size_t)2 * BATCH * HA * DK * DV + (size_t)MP * KVL + (size_t)MP * 64;
    hgrn_phase((const bf16*)(ws + WS_QB), (const float*)(ws + WS_GB), (const bf16*)(ws + WS_VB), (const bf16*)(ws + WS_GATE), ARG_IN(11) + (size_t)l * D, ARG_IN(2) + (size_t)l * DB * HA * DK * DV,
                     st_p + (size_t)l * BATCH * HA * DK * DV, st_s + (size_t)l * DB * HA * DK * DV, (bf16*)(ws + WS_OG), c.lds, c.wg, c.G, c.tid);
}
__device__ __forceinline__ void ph_dq(const Ctx& c0, int j) {
    const Ctx c = fresh(c0);
    unsigned char* ws = ARG_WS();
    const int N = (j == 0) ? 768 : 512; const bf16* Wt = (const bf16*)(ws + ((j == 0) ? WS_WDQ0 : WS_WDQ1)); const bf16* HN = (const bf16*)(ws + WS_HN); float* QC = (float*)(ws + WS_QC);
    pg8::Gemm g{HN, Wt, MP, N, 1024}; pg8::StaticOrder S; S.init(MP, N, c.G, c.wg);
    pg8::EpiF32 E{QC, QCP};
    pg8::gemm_phase<pg8::EpiF32, pg8::StaticOrder, true, true>(c.lds, g, S, E, c.tid);
    const Ctx c2 = fresh(c0);
    sg_f32(HN, 1024, Wt, N, QC, QCP, c2.gw, c2.NGW, c2.lane);
}
__device__ __forceinline__ void ph_qnorm(const Ctx& c0, int j) {
    const Ctx c = fresh(c0);
    unsigned char* ws = ARG_WS(); float* X = ARG_OUT();
    float* c_p = X + (size_t)M * D + (size_t)2 * BATCH * HA * DK * DV; float* kr_p = c_p + (size_t)MP * KVL; float* c_s = kr_p + (size_t)MP * 64 + (size_t)2 * DB * HA * DK * DV; float* kr_s = c_s + (size_t)DB * KVL;
    const float* QC = (const float*)(ws + WS_QC); bf16* QAN = (bf16*)(ws + WS_QAN); bf16* CB = (bf16*)(ws + WS_CB); bf16* KRB = (bf16*)(ws + WS_KRB); const float* CS = (const float*)(ws + WS_CS);
    const float* kv_a_norm = ARG_IN(15); const int lane = c.lane;
    for (int m = c.gw; m < M; m += c.NGW) {
        const float* qc = QC + (size_t)m * QCP;
        float v[6]; float s = 0.f;
#pragma unroll
        for (int i = 0; i < 6; ++i) { v[i] = qc[lane + 64 * i]; s += v[i] * v[i]; }
        const float r = rsqrtf(wave_sum(s) * (1.f / 384.f) + EPS);
#pragma unroll
        for (int i = 0; i < 6; ++i) QAN[(size_t)m * QL + lane + 64 * i] = (bf16)f2bf(v[i] * r);
        if (j == 0) {
            float cc[4]; float s2 = 0.f;
#pragma unroll
            for (int i = 0; i < 4; ++i) { cc[i] = qc[384 + lane + 64 * i]; s2 += cc[i] * cc[i]; }
            const float r2 = rsqrtf(wave_sum(s2) * (1.f / 256.f) + EPS);
            float* co = m < MP ? c_p + (size_t)m * KVL : c_s + (size_t)(m - MP) * KVL;
#pragma unroll
            for (int i = 0; i < 4; ++i) { const float o = cc[i] * r2 * kv_a_norm[lane + 64 * i]; co[lane + 64 * i] = o; CB[(size_t)m * KVL + lane + 64 * i] = (bf16)f2bf(o); }
            if (lane < 32) {
                const float x1 = qc[640 + lane], x2 = qc[672 + lane]; const int p = m < MP ? (m & (SEQ - 1)) : 2048;
                const float cs = CS[(size_t)(p * 32 + lane) * 2], sn = CS[(size_t)(p * 32 + lane) * 2 + 1];
                const float o1 = x1 * cs - x2 * sn, o2 = x2 * cs + x1 * sn;
                float* ko = m < MP ? kr_p + (size_t)m * 64 : kr_s + (size_t)(m - MP) * 64;
                ko[lane] = o1; ko[32 + lane] = o2;
                if (m < MP) ((unsigned*)(KRB + (size_t)m * 64))[lane] = pk2(o1, o2);
            }
        }
    }
}
__device__ __forceinline__ void ph_uq(const Ctx& c0, int j) {
    const Ctx c = fresh(c0);
    unsigned char* ws = ARG_WS();
    const bf16* QAN = (const bf16*)(ws + WS_QAN); const bf16* Wt = (const bf16*)(ws + WS_WUQ) + (size_t)j * 1536 * 384; bf16* QN = (bf16*)(ws + WS_QN); bf16* QR = (bf16*)(ws + WS_QR); const float* CS = (const float*)(ws + WS_CS);
    { pg8::Gemm g{QAN, Wt, MP, 1024, QL}; pg8::StaticOrder S; S.init(MP, 1024, c.G, c.wg);
      pg8::EpiBf16Split E{QN, 1024, 0, 0};
      pg8::gemm_phase<pg8::EpiBf16Split, pg8::StaticOrder, true, true>(c.lds, g, S, E, c.tid); }
    { const Ctx c1 = fresh(c0);
      pg8::Gemm g{QAN, Wt + (size_t)1024 * QL, MP, 512, QL}; pg8::StaticOrder S; S.init(MP, 512, c1.G, c1.wg);
      pg8::EpiRope E{ws};
      pg8::gemm_phase<pg8::EpiRope, pg8::StaticOrder, true, true>(c1.lds, g, S, E, c1.tid); }
    const Ctx c2 = fresh(c0);
    sg_uq(QAN, Wt, QN, QR, CS, c2.gw, c2.NGW, c2.lane);
}
__device__ __forceinline__ void ph_kvup(const Ctx& c0) {
    const Ctx c = fresh(c0);
    unsigned char* ws = ARG_WS();
    {
        pg8::Gemm g{(const bf16*)(ws + WS_CB), (const bf16*)(ws + WS_WUKV), MP, 1024, KVL}; pg8::StaticOrder S; S.init(MP, 1024, c.G, c.wg);
        pg8::EpiBf16Split E{(bf16*)(ws + WS_KN), 1024, 0, 0};
        pg8::gemm_phase<pg8::EpiBf16Split, pg8::StaticOrder, true, true>(c.lds, g, S, E, c.tid); }
    {
        const Ctx c1 = fresh(c0);
        pg8::Gemm g{(const bf16*)(ws + WS_WUKV) + (size_t)1024 * KVL, (const bf16*)(ws + WS_CB), 1024, MP, KVL}; pg8::StaticOrder S; S.init(1024, MP, c1.G, c1.wg);
        pg8::EpiBf16Split E{(bf16*)(ws + WS_VV), MP, 0, 0};
        pg8::gemm_phase<pg8::EpiBf16Split, pg8::StaticOrder, true, true>(c1.lds, g, S, E, c1.tid); }
}
__device__ __forceinline__ void ph_attn(const Ctx& c0) {
    const Ctx c = fresh(c0);
    unsigned char* ws = ARG_WS(); float* X = ARG_OUT();
    float* c_s = X + (size_t)M * D + (size_t)2 * BATCH * HA * DK * DV + (size_t)MP * KVL + (size_t)MP * 64 + (size_t)2 * DB * HA * DK * DV; float* kr_s = c_s + (size_t)DB * KVL;
    attn_prompt_phase((const bf16*)(ws + WS_QN), (const bf16*)(ws + WS_QR), (const bf16*)(ws + WS_KN), (const bf16*)(ws + WS_KRB), (const bf16*)(ws + WS_VV), (bf16*)(ws + WS_OG), c.lds, c.wg, c.G, c.tid);
    { const Ctx c2 = fresh(c0); unsigned char* ws2 = ARG_WS();
      decode_phase((const bf16*)(ws2 + WS_QN), (const bf16*)(ws2 + WS_QR), (const bf16*)(ws2 + WS_WUKVN), ARG_IN(3), ARG_IN(4), (const int*)ARG_IN(5), (float*)(ws2 + WS_PART), (float*)(ws2 + WS_PML), (float*)(ws2 + WS_QLAT), c2.lds, c2.wg, c2.G, c2.tid); }

}
__device__ __forceinline__ void ph_combine(const Ctx& c0) {
    const Ctx c = fresh(c0);
    unsigned char* ws = ARG_WS(); float* X = ARG_OUT();
    float* c_s = X + (size_t)M * D + (size_t)2 * BATCH * HA * DK * DV + (size_t)MP * KVL + (size_t)MP * 64 + (size_t)2 * DB * HA * DK * DV; float* kr_s = c_s + (size_t)DB * KVL;
    decode_combine_phase((const float*)(ws + WS_PART), (const float*)(ws + WS_PML), (const float*)(ws + WS_QLAT), c_s, kr_s, (const bf16*)(ws + WS_WUKV), (bf16*)(ws + WS_OG), c.lds, c.wg, c.G, c.tid);
}
__device__ __forceinline__ void ph_mixout(const Ctx& c0, int l) {
    const Ctx c = fresh(c0);
    unsigned char* ws = ARG_WS();
    const bf16* Wt = (l < 2) ? (const bf16*)(ws + WS_WOUTA) + (size_t)l * 1024 * 1024 : (const bf16*)(ws + WS_WOUTB) + (size_t)(l - 2) * 1024 * 1024;
    const bf16* OG = (const bf16*)(ws + WS_OG); float* MIX = (float*)(ws + WS_MIX);
    pg8::Gemm g{OG, Wt, MP, 1024, 1024}; pg8::StaticOrder S; S.init(MP, 1024, c.G, c.wg);
    pg8::EpiF32 E{MIX, 1024};
    pg8::gemm_phase<pg8::EpiF32, pg8::StaticOrder, true, true>(c.lds, g, S, E, c.tid);
    const Ctx c2 = fresh(c0);
    sg_f32(OG, 1024, Wt, 1024, MIX, 1024, c2.gw, c2.NGW, c2.lane);
}
__device__ __forceinline__ void ph_resid(const Ctx& c0, int l, int which) {
    const Ctx c = fresh(c0);
    unsigned char* ws = ARG_WS(); float* X = ARG_OUT(); const float* gain = ARG_IN(6) + (size_t)(l * 4 + which) * D;
    const float* MIX = (const float*)(ws + WS_MIX); bf16* HN = (bf16*)(ws + WS_HN);
    for (int m = c.gw; m < M; m += c.NGW) row_resid_norm(MIX + (size_t)m * D, X + (size_t)m * D, gain, HN + (size_t)m * D, c.lane);
}
__device__ __forceinline__ void ph_ffn_in(const Ctx& c0, int l) {
    const Ctx c = fresh(c0);
    unsigned char* ws = ARG_WS();
    const bf16* HN = (const bf16*)(ws + WS_HN); const bf16* Wt = (const bf16*)(ws + WS_WFIN) + (size_t)l * 5632 * 1024; bf16* ACT = (bf16*)(ws + WS_ACT);
    pg8::Gemm g{HN, Wt, MP, 5632, 1024}; pg8::StaticOrder S; S.init(MP, 5632, c.G, c.wg);
    pg8::EpiSwiglu E{ACT, DFF};
    pg8::gemm_phase<pg8::EpiSwiglu, pg8::StaticOrder, true, true>(c.lds, g, S, E, c.tid);
    const Ctx c2 = fresh(c0);
    sg_swiglu(HN, Wt, ACT, c2.gw, c2.NGW, c2.lane);
}
__device__ __forceinline__ void ph_ffn_out(const Ctx& c0, int l) {
    const Ctx c = fresh(c0);
    unsigned char* ws = ARG_WS();
    const bf16* ACT = (const bf16*)(ws + WS_ACT); const bf16* Wt = (const bf16*)(ws + WS_WFOUT) + (size_t)l * 1024 * 2816; float* MIX = (float*)(ws + WS_MIX);
    pg8::Gemm g{ACT, Wt, MP, 1024, DFF}; pg8::StaticOrder S; S.init(MP, 1024, c.G, c.wg);
    pg8::EpiF32 E{MIX, 1024};
    pg8::gemm_phase<pg8::EpiF32, pg8::StaticOrder, true, true>(c.lds, g, S, E, c.tid);
    const Ctx c2 = fresh(c0);
    sg_f32(ACT, DFF, Wt, 1024, MIX, 1024, c2.gw, c2.NGW, c2.lane);
}

__global__ void __launch_bounds__(NTHR, 2) mk_fwd(Args args) {
    extern __shared__ __attribute__((aligned(16))) unsigned char lds_raw[];
    Ctx c;
    c.lds = (LAS unsigned char*)lds_raw;
    c.tid = 0; c.lane = 0; c.wave = __builtin_amdgcn_readfirstlane((int)threadIdx.x >> 6);
    c.wg = blockIdx.x; c.G = gridDim.x; c.gw = c.wg * NWAVES + c.wave; c.NGW = c.G * NWAVES;
    for (int u = threadIdx.x; u < (LDS_BYTES - RING_BYTES) / 4; u += NTHR) ((LAS unsigned*)(c.lds + RING_BYTES))[u] = 0u;
    __syncthreads();
#define MAKE_BAR(b) XcdBarrier b; b.wave = c.wave; b.bar = (unsigned*)(ARG_WS() + WS_CTL) + CW_BAR + karg32(192) * XCD_BAR_WORDS; b.x = xb_xcc_id(); b.st = (volatile LAS unsigned*)(c.lds + MISC_OFF) + 8
    { MAKE_BAR(b0); if (xb_thread0(c.wave)) (void)xb_add(&b0.bar[XB_XCNT(b0.x)], 1u); }
#define PH_BEGIN(k) { const int lo_ = karg32(184), hi_ = karg32(188); if (lo_ <= (k) && (k) < hi_) { if ((k) > lo_) { MAKE_BAR(bb); xcd_barrier(bb); }
#define PH_END } }
    PH_BEGIN(0) ph_prologue(c); PH_END
    for (int l = 0; l < 4; ++l) {
        const int pb = 1 + l * 11;
        if (l < 2) {
            PH_BEGIN(pb + 0) ph_hgrn_in(c, l); PH_END
            PH_BEGIN(pb + 1) ph_hgrn_rec(c, l); PH_END
        } else {
            PH_BEGIN(pb + 0) ph_dq(c, l - 2); PH_END
            PH_BEGIN(pb + 1) ph_qnorm(c, l - 2); PH_END
            PH_BEGIN(pb + 2) ph_uq(c, l - 2); PH_END
            if (l == 2) { PH_BEGIN(pb + 3) ph_kvup(c); PH_END }
            PH_BEGIN(pb + 4) ph_attn(c); PH_END
            PH_BEGIN(pb + 5) ph_combine(c); PH_END
        }
        PH_BEGIN(pb + 6) ph_mixout(c, l); PH_END
        PH_BEGIN(pb + 7) ph_resid(c, l, 1); PH_END
        PH_BEGIN(pb + 8) ph_ffn_in(c, l); PH_END
        PH_BEGIN(pb + 9) ph_ffn_out(c, l); PH_END
        PH_BEGIN(pb + 10) ph_resid(c, l, 3); PH_END
    }
#undef PH_BEGIN
#undef PH_END
}

#ifndef MK_PER_PHASE
#define MK_PER_PHASE 0
#endif
extern "C" void kernel_launch(void* const* d_in, const int* in_sizes, int n_in, void* d_out, int out_size, void* d_ws, size_t ws_size, hipStream_t stream) {
    static int grid = 0;
    if (grid == 0) {
        int dev = 0, cus = 0, per_cu = 0;
        if (n_in != 21 || ws_size < WS_END) { fprintf(stderr, "kernel_launch: unexpected arguments (n_in %d, ws %zu < %zu)\n", n_in, ws_size, (size_t)WS_END); grid = -1; return; }
        if (hipGetDevice(&dev) != hipSuccess || hipDeviceGetAttribute(&cus, hipDeviceAttributeMultiprocessorCount, dev) != hipSuccess) { grid = -1; return; }
        if (hipFuncSetAttribute((const void*)mk_fwd, hipFuncAttributeMaxDynamicSharedMemorySize, LDS_BYTES) != hipSuccess) { fprintf(stderr, "kernel_launch: hipFuncSetAttribute failed\n"); grid = -1; return; }
        if (hipOccupancyMaxActiveBlocksPerMultiprocessor(&per_cu, (const void*)mk_fwd, NTHR, LDS_BYTES) != hipSuccess || per_cu < 1) fprintf(stderr, "kernel_launch: occupancy query reports %d\n", per_cu);
        (void)hipGetLastError();
        grid = cus;
    }
    if (grid < 0) return;
    (void)hipMemsetAsync((char*)d_ws + WS_CTL, 0, CTL_BYTES, stream);
    Args a{};
    for (int i = 0; i < 21; ++i) a.in[i] = (const float*)d_in[i];
    a.out = (float*)d_out; a.ws = (unsigned char*)d_ws;
#if MK_PER_PHASE
    int li = 0;
    for (int k = 0; k < NPH; ++k) { if (!phase_exists(k)) continue; a.ph_lo = k; a.ph_hi = k + 1; a.li = li++; hipLaunchKernelGGL(mk_fwd, dim3(grid), dim3(NTHR), LDS_BYTES, stream, a); }
#else
    a.ph_lo = 0; a.ph_hi = NPH; a.li = 0;
    hipLaunchKernelGGL(mk_fwd, dim3(grid), dim3(NTHR), LDS_BYTES, stream, a);
#endif
    const hipError_t le = hipPeekAtLastError();
    if (le != hipSuccess) fprintf(stderr, "kernel_launch: launch failed: %s\n", hipGetErrorName(le));
}
```

```cpp
#include <hip/hip_runtime.h>
#include <cstdio>
#include <cstdint>
#include <math.h>
#define GAS __attribute__((address_space(1)))
#define LAS __attribute__((address_space(3)))
typedef unsigned short bf16;
typedef unsigned v4u __attribute__((ext_vector_type(4)));
typedef unsigned v2u __attribute__((ext_vector_type(2)));
typedef float f32x4 __attribute__((ext_vector_type(4)));
typedef short bf16x8 __attribute__((ext_vector_type(8)));
constexpr int NWAVES = 8, NTHR = 512;
constexpr int D = 1024, BATCH = 8, SEQ = 2048, MP = BATCH * SEQ, DB = 128, M = MP + DB;
constexpr int HA = 8, DK = 128, DV = 128;
constexpr int QL = 384, KVL = 256;
constexpr int PAST = 8192, PAGE = 128, NPAGES = PAST / PAGE;
constexpr int DFF = 2816;
constexpr float EPS = 1e-6f;
constexpr float QSCALE = 0.07216878364870322f * 1.4426950408889634f;
constexpr int QCP = 768;
constexpr int SCP = PAST + 64;

constexpr size_t MiB = 1u << 20;
constexpr size_t WS_CTL = 0, CTL_BYTES = 1 * MiB;
constexpr size_t WS_WIN   = 1 * MiB;
constexpr size_t WS_WOUTA = WS_WIN + 2 * (size_t)4096 * 1024 * 2;
constexpr size_t WS_WFIN  = WS_WOUTA + 2 * (size_t)1024 * 1024 * 2;
constexpr size_t WS_WFOUT = WS_WFIN + 4 * (size_t)5632 * 1024 * 2;
constexpr size_t WS_WDQ0  = WS_WFOUT + 4 * (size_t)1024 * 2816 * 2;
constexpr size_t WS_WDQ1  = WS_WDQ0 + (size_t)768 * 1024 * 2;
constexpr size_t WS_WUQ   = WS_WDQ1 + (size_t)512 * 1024 * 2;
constexpr size_t WS_WUKV  = WS_WUQ + 2 * (size_t)1536 * 384 * 2;
constexpr size_t WS_WUKVN = WS_WUKV + (size_t)2048 * 256 * 2;
constexpr size_t WS_WOUTB = WS_WUKVN + (size_t)256 * 2048 * 2;
constexpr size_t WS_CS    = WS_WOUTB + 2 * (size_t)1024 * 1024 * 2;
constexpr size_t WS_LBT   = WS_CS + (size_t)2049 * 64 * 4 + 256;
constexpr size_t WS_HN    = ((WS_LBT + 2 * 1024 * 2 * 4 + 4095) / 4096) * 4096;
constexpr size_t WS_QB    = WS_HN + (size_t)M * 1024 * 2;
constexpr size_t WS_VB    = WS_QB + (size_t)M * 1024 * 2;
constexpr size_t WS_GATE  = WS_VB + (size_t)M * 1024 * 2;
constexpr size_t WS_GB    = WS_GATE + (size_t)M * 1024 * 2;
constexpr size_t WS_OG    = WS_GB + (size_t)M * 1024 * 4;
constexpr size_t WS_MIX   = WS_OG + (size_t)M * 1024 * 2;
constexpr size_t WS_ACT   = WS_MIX + (size_t)M * 1024 * 4;
constexpr size_t WS_QC    = WS_ACT + (size_t)M * 2816 * 2;
constexpr size_t WS_QAN   = WS_QC + (size_t)M * QCP * 4;
constexpr size_t WS_CB    = WS_QAN + (size_t)M * 384 * 2;
constexpr size_t WS_KRB   = WS_CB + (size_t)M * 256 * 2;
constexpr size_t WS_QN    = WS_KRB + (size_t)MP * 64 * 2;
constexpr size_t WS_QR    = WS_QN + (size_t)M * 1024 * 2;
constexpr size_t WS_KN    = WS_QR + (size_t)M * 512 * 2;
constexpr size_t WS_VV    = WS_KN + (size_t)MP * 1024 * 2;
constexpr size_t WS_SC    = WS_VV + (size_t)MP * 1024 * 2;
constexpr size_t WS_PART  = WS_SC + (size_t)DB * 8 * SCP * 4;
constexpr size_t WS_PML   = WS_PART + (size_t)DB * 2 * 8 * 256 * 4;
constexpr size_t WS_QLAT  = WS_PML + (size_t)DB * 2 * 8 * 2 * 4;
constexpr size_t WS_END   = WS_QLAT + (size_t)DB * 8 * 320 * 4;
constexpr int CW_BAR = 4096;
constexpr int RING_BYTES = 131072, MISC_OFF = RING_BYTES + 320, LDS_BYTES = 147456;

__device__ __forceinline__ float bf2f(unsigned b) { return __uint_as_float(b << 16); }
__device__ __forceinline__ unsigned f2bf(float f) { unsigned u = __float_as_uint(f); return (u + 0x7fffu + ((u >> 16) & 1u)) >> 16; }
__device__ __forceinline__ unsigned pk2(float lo, float hi) { return f2bf(lo) | (f2bf(hi) << 16); }
typedef __bf16 bf16x2_t __attribute__((ext_vector_type(2)));
typedef float f32x2_t __attribute__((ext_vector_type(2)));
__device__ __forceinline__ unsigned cvtpk(float lo, float hi) { const f32x2_t v = {lo, hi}; const bf16x2_t b = __builtin_convertvector(v, bf16x2_t); return __builtin_bit_cast(unsigned, b); }
#define LDS_WAIT() asm volatile("s_waitcnt lgkmcnt(0)" ::: "memory")
__device__ __forceinline__ int lane_id_v() { int l; asm volatile("v_mbcnt_lo_u32_b32 %0, -1, 0\n\tv_mbcnt_hi_u32_b32 %0, -1, %0" : "=v"(l)); return l; }
__device__ __forceinline__ float shx(float v, int mask, int lane) { return __int_as_float(__builtin_amdgcn_ds_bpermute((lane ^ mask) << 2, __float_as_int(v))); }
__device__ __forceinline__ float wave_sum(float v) {
    const int lane = lane_id_v();
#pragma unroll
    for (int o = 1; o < 64; o <<= 1) v += shx(v, o, lane);
    return v;
}
__device__ __forceinline__ float wave_max(float v) {
    const int lane = lane_id_v();
#pragma unroll
    for (int o = 1; o < 64; o <<= 1) v = fmaxf(v, shx(v, o, lane));
    return v;
}
namespace pg8 {
#define PG8_LAS __attribute__((address_space(3)))
typedef unsigned short bf16_t;
typedef short bf16x8 __attribute__((ext_vector_type(8)));
typedef float f32x4 __attribute__((ext_vector_type(4)));
typedef unsigned u32x4 __attribute__((ext_vector_type(4)));
constexpr int BM = 256, BK = 64, HALF = 128, HTB = HALF * BK * 2  , STAGE_BYTES = 8 * HTB, NXCD = 8, WGM = 8;

__host__ __device__ __forceinline__ int lds_byte(int r, int c) { const int st = (r >> 4) * 2 + (c >> 5), rr = r & 15, cc = c & 31, ob = rr * 64 + cc * 2; return st * 1024 + (ob ^ (((ob >> 9) & 1) << 5)); }
__host__ __device__ __forceinline__ void stage_rc(int b, int& R, int& C) { const int st = b / 1024, sb = b % 1024, swz = sb ^ (((sb >> 9) & 1) << 5); R = (st >> 1) * 16 + swz / 64; C = (st & 1) * 32 + (swz % 64) / 2; }
__host__ __device__ __forceinline__ int perm32(int rho) { const int n = rho >> 4, i = rho & 15; return 8 * (i >> 2) + 4 * n + (i & 3); }

struct Unit { int pm, pn; };
struct Gemm { const bf16_t* A; const bf16_t* Bt; int M, N, K; };

struct StaticOrder {
    int nM, nN, nwg, G, c;
    __host__ __device__ void init(int M, int N, int G_, int c_) { nM = M / BM; nN = N / BM; nwg = nM * nN; G = G_; c = c_; }
    __host__ __device__ bool next(int i, Unit& u) const {
        const long L = (long)i * G + c; if (L >= nwg) return false;
        int wgid = (int)L; { const int q = nwg / NXCD, r = nwg % NXCD, xcd = wgid % NXCD, off = wgid / NXCD; wgid = (xcd < r ? xcd * (q + 1) : r * (q + 1) + (xcd - r) * q) + off; }
        const int nig = WGM * nN, gid = wgid / nig, fm = gid * WGM, gsz = (nM - fm) < WGM ? (nM - fm) : WGM;
        u.pm = fm + ((wgid % nig) % gsz); u.pn = (wgid % nig) / gsz; return true;
    }
    __device__ __forceinline__ void a_ready(const Unit&) const {}
    __device__ __forceinline__ void done(const Unit&) const {}
};

__device__ __forceinline__ unsigned cvt_pk_bf16(float lo, float hi) { unsigned r; asm volatile("v_cvt_pk_bf16_f32 %0, %1, %2" : "=v"(r) : "v"(lo), "v"(hi)); return r; }
typedef float f32x2 __attribute__((ext_vector_type(2)));
__device__ __forceinline__ float silu_fast(float x) { return x * __builtin_amdgcn_rcpf(1.0f + __expf(-x)); }
__device__ __forceinline__ float logf_gate(float z, float log_lb, float l1p) {
    const float lsig = fminf(z, 0.f) - __logf(1.0f + __expf(-fabsf(z)));
    const float bb = l1p + lsig;
    const float mx = fmaxf(log_lb, bb), mn = fminf(log_lb, bb);
    return fminf(mx + __logf(1.0f + __expf(mn - mx)), 0.f);
}
struct EpiF32 {
    static constexpr bool PERM = false, AFTER_DRAIN = false;
    float* C; int ldc;
    __device__ __forceinline__ void operator()(const f32x4 (&acc)[2][2][4][2], const Unit& u, int wr, int wc, int fr_, int fq_) const {
        const int ln_ = lane_id_v(); const int fr = ln_ & 15, fq = ln_ >> 4;
        const int row0 = u.pm * BM + wr * 64 + fr, col0 = u.pn * BM + wc * 32 + 4 * fq;
#pragma unroll
        for (int ai = 0; ai < 2; ++ai)
#pragma unroll
            for (int m = 0; m < 4; ++m) { float* rowp = C + (size_t)(row0 + ai * HALF + m * 16) * ldc + col0;
#pragma unroll
                for (int bj = 0; bj < 2; ++bj)
#pragma unroll
                    for (int n = 0; n < 2; ++n) *(f32x4*)(rowp + bj * HALF + n * 16) = acc[ai][bj][m][n]; }
    }
};
struct EpiBf16Split {
    static constexpr bool PERM = true, AFTER_DRAIN = false;
    bf16_t* O; int ldc; int split_cols; size_t split_stride;
    __device__ __forceinline__ void operator()(const f32x4 (&acc)[2][2][4][2], const Unit& u, int wr, int wc, int fr_, int fq_) const {
        const int ln_ = lane_id_v(); const int fr = ln_ & 15, fq = ln_ >> 4;
        const int row0 = u.pm * BM + wr * 64 + fr; int colt = u.pn * BM; bf16_t* base = O;
        if (split_cols) { const int t = colt / split_cols; base += (size_t)t * split_stride; colt -= t * split_cols; }
        const int col0 = colt + wc * 32 + 8 * fq;
#pragma unroll
        for (int ai = 0; ai < 2; ++ai)
#pragma unroll
            for (int m = 0; m < 4; ++m) { bf16_t* rowp = base + (size_t)(row0 + ai * HALF + m * 16) * ldc + col0;
#pragma unroll
                for (int bj = 0; bj < 2; ++bj) { const f32x4 v0 = acc[ai][bj][m][0], v1 = acc[ai][bj][m][1];
                    u32x4 w; w.x = cvt_pk_bf16(v0[0], v0[1]); w.y = cvt_pk_bf16(v0[2], v0[3]); w.z = cvt_pk_bf16(v1[0], v1[1]); w.w = cvt_pk_bf16(v1[2], v1[3]);
                    *(u32x4*)(rowp + bj * HALF) = w; } }
    }
};
struct EpiHgrnIn {
    static constexpr bool PERM = true, AFTER_DRAIN = false;
    unsigned char* ws; int layer;
    __device__ __forceinline__ void operator()(const f32x4 (&acc)[2][2][4][2], const Unit& u, int wr, int wc, int fr_, int fq_) const {
        const int ln_ = lane_id_v(); const int fr = ln_ & 15, fq = ln_ >> 4;
        const int row0 = u.pm * BM + wr * 64 + fr; const int type = u.pn >> 2; const int cl0 = (u.pn & 3) * 256 + wc * 32 + 8 * fq;
        if (type == 1) {
            const float* lbt = (const float*)(ws + WS_LBT) + (size_t)layer * 2048; float* GB = (float*)(ws + WS_GB);
#pragma unroll
            for (int bj = 0; bj < 2; ++bj) {
                const int cl = cl0 + bj * HALF;
                f32x4 t0 = *(const f32x4*)(lbt + 2 * cl), t1 = *(const f32x4*)(lbt + 2 * cl + 4), t2 = *(const f32x4*)(lbt + 2 * cl + 8), t3 = *(const f32x4*)(lbt + 2 * cl + 12);
#pragma unroll
                for (int ai = 0; ai < 2; ++ai)
#pragma unroll
                    for (int m = 0; m < 4; ++m) {
                        const f32x4 v0 = acc[ai][bj][m][0], v1 = acc[ai][bj][m][1]; f32x4 o0, o1;
                        o0[0] = logf_gate(v0[0], t0[0], t0[1]); o0[1] = logf_gate(v0[1], t0[2], t0[3]); o0[2] = logf_gate(v0[2], t1[0], t1[1]); o0[3] = logf_gate(v0[3], t1[2], t1[3]);
                        o1[0] = logf_gate(v1[0], t2[0], t2[1]); o1[1] = logf_gate(v1[1], t2[2], t2[3]); o1[2] = logf_gate(v1[2], t3[0], t3[1]); o1[3] = logf_gate(v1[3], t3[2], t3[3]);
                        float* p = GB + (size_t)(row0 + ai * HALF + m * 16) * 1024 + cl;
                        *(f32x4*)p = o0; *(f32x4*)(p + 4) = o1;
                    }
            }
        } else {
            bf16_t* dst = (bf16_t*)(ws + (type == 0 ? WS_QB : (type == 2 ? WS_VB : WS_GATE)));
#pragma unroll
            for (int ai = 0; ai < 2; ++ai)
#pragma unroll
                for (int m = 0; m < 4; ++m)
#pragma unroll
                    for (int bj = 0; bj < 2; ++bj) {
                        f32x4 v0 = acc[ai][bj][m][0], v1 = acc[ai][bj][m][1];
                        if (type == 0) {
#pragma unroll
                            for (int j = 0; j < 4; ++j) { v0[j] = silu_fast(v0[j]) * 0.08838834764831845f; v1[j] = silu_fast(v1[j]) * 0.08838834764831845f; }
                        } else if (type == 3) {
#pragma unroll
                            for (int j = 0; j < 4; ++j) { v0[j] = silu_fast(v0[j]); v1[j] = silu_fast(v1[j]); }
                        }
                        u32x4 w; w.x = cvt_pk_bf16(v0[0], v0[1]); w.y = cvt_pk_bf16(v0[2], v0[3]); w.z = cvt_pk_bf16(v1[0], v1[1]); w.w = cvt_pk_bf16(v1[2], v1[3]);
                        *(u32x4*)(dst + (size_t)(row0 + ai * HALF + m * 16) * 1024 + cl0 + bj * HALF) = w;
                    }
        }
    }
};
struct EpiSwiglu {
    static constexpr bool PERM = true, AFTER_DRAIN = false;
    bf16_t* ACT; int ldc;
    __device__ __forceinline__ void operator()(const f32x4 (&acc)[2][2][4][2], const Unit& u, int wr, int wc, int fr_, int fq_) const {
        const int ln_ = lane_id_v(); const int fr = ln_ & 15, fq = ln_ >> 4;
        const int row0 = u.pm * BM + wr * 64 + fr, col0 = u.pn * HALF + wc * 32 + 8 * fq;
#pragma unroll
        for (int ai = 0; ai < 2; ++ai)
#pragma unroll
            for (int m = 0; m < 4; ++m) {
                f32x4 r0, r1;
#pragma unroll
                for (int j = 0; j < 4; ++j) { r0[j] = silu_fast(acc[ai][0][m][0][j]) * acc[ai][1][m][0][j]; r1[j] = silu_fast(acc[ai][0][m][1][j]) * acc[ai][1][m][1][j]; }
                u32x4 w; w.x = cvt_pk_bf16(r0[0], r0[1]); w.y = cvt_pk_bf16(r0[2], r0[3]); w.z = cvt_pk_bf16(r1[0], r1[1]); w.w = cvt_pk_bf16(r1[2], r1[3]);
                *(u32x4*)(ACT + (size_t)(row0 + ai * HALF + m * 16) * ldc + col0) = w;
            }
    }
};
struct EpiRope {
    static constexpr bool PERM = true, AFTER_DRAIN = false;
    unsigned char* ws;
    __device__ __forceinline__ void operator()(const f32x4 (&acc)[2][2][4][2], const Unit& u, int wr, int wc, int fr_, int fq_) const {
        const int ln_ = lane_id_v(); const int fr = ln_ & 15, fq = ln_ >> 4;
        const int row0 = u.pm * BM + wr * 64 + fr;
        {
            bf16_t* QR = (bf16_t*)(ws + WS_QR); const float* CS = (const float*)(ws + WS_CS);
            const int rc0 = u.pn * BM + wc * 32 + 8 * fq;
#pragma unroll
            for (int ai = 0; ai < 2; ++ai)
#pragma unroll
                for (int m = 0; m < 4; ++m) { const int row = row0 + ai * HALF + m * 16; const int pos = row & 2047;
#pragma unroll
                    for (int bj = 0; bj < 2; ++bj) { const int rc = rc0 + bj * HALF; const int i0 = (rc & 63) >> 1;
                        const float* cp = CS + (size_t)(pos * 32 + i0) * 2;
                        u32x4 w;
                        { const f32x4 cc = *(const f32x4*)cp; const f32x4 v0 = acc[ai][bj][m][0];
                          w.x = cvt_pk_bf16(v0[0] * cc[0] - v0[1] * cc[1], v0[1] * cc[0] + v0[0] * cc[1]);
                          w.y = cvt_pk_bf16(v0[2] * cc[2] - v0[3] * cc[3], v0[3] * cc[2] + v0[2] * cc[3]); }
                        asm volatile("" ::: "memory");
                        { const f32x4 cc = *(const f32x4*)(cp + 4); const f32x4 v1 = acc[ai][bj][m][1];
                          w.z = cvt_pk_bf16(v1[0] * cc[0] - v1[1] * cc[1], v1[1] * cc[0] + v1[0] * cc[1]);
                          w.w = cvt_pk_bf16(v1[2] * cc[2] - v1[3] * cc[3], v1[3] * cc[2] + v1[2] * cc[3]); }
                        *(u32x4*)(QR + (size_t)row * 512 + rc) = w;
                        asm volatile("" ::: "memory"); } }
        }
    }
};
template <class Epi, class Sched, bool ALIGN_EPI = false, bool SP2 = false>
__device__ __forceinline__ void gemm_phase(PG8_LAS unsigned char* lds, const Gemm g, const Sched& S, const Epi& E, const int tid_in) {
    int tid_o = tid_in; asm volatile("" : "+v"(tid_o));
    const int tid = tid_o, wid = __builtin_amdgcn_readfirstlane(tid >> 6), lane = tid & 63, wr = wid >> 2, wc = wid & 3, fr = lane & 15, fq = lane >> 4;
    const int K = g.K, nt = K / BK;
    unsigned voffA[2], voffB[2];
#pragma unroll
    for (int i = 0; i < 2; ++i) { int R, C; stage_rc(tid * 16 + i * 8192, R, C); const int Rb = Epi::PERM ? ((R & ~31) + perm32(R & 31)) : R;
        voffA[i] = (unsigned)(R * K + C) * 2u; voffB[i] = (unsigned)(Rb * K + C) * 2u; }
    const size_t kstep = (size_t)(BK * 2);
    const size_t hstep = (size_t)HALF * K * 2;
    const size_t tstep = 2 * hstep;
    const unsigned ldsw = (unsigned)wid * 1024u;
    const int aoff = lds_byte(wr * 64 + fr, fq * 8), boff = lds_byte(wc * 32 + fr, fq * 8);
#define PG8_SA(b, h) (((b) * 2 + (h)) * HTB)
#define PG8_SB(b, h) ((4 + (b) * 2 + (h)) * HTB)
#define PG8_STAGE(bufoff, gbase, voff) do { _Pragma("unroll") for (int _i = 0; _i < 2; ++_i) \
        __builtin_amdgcn_global_load_lds((const unsigned*)((const char*)(gbase) + (voff)[_i]), (PG8_LAS unsigned*)(lds + (bufoff) + ldsw + _i * 8192), 16, 0, 0); } while (0)
#define PG8_LDA(dst, b, h) do { _Pragma("unroll") for (int m = 0; m < 4; ++m) _Pragma("unroll") for (int k = 0; k < 2; ++k) dst[m][k] = *(const PG8_LAS bf16x8*)(lds + PG8_SA(b, h) + aoff + m * 2048 + k * 1024); } while (0)
#define PG8_LDB(dst, b, h) do { _Pragma("unroll") for (int n = 0; n < 2; ++n) _Pragma("unroll") for (int k = 0; k < 2; ++k) dst[n][k] = *(const PG8_LAS bf16x8*)(lds + PG8_SB(b, h) + boff + n * 2048 + k * 1024); } while (0)
#define PG8_MMA(ai, bj, At, Bt) do { __builtin_amdgcn_s_setprio(1); _Pragma("unroll") for (int m = 0; m < 4; ++m) _Pragma("unroll") for (int n = 0; n < 2; ++n) _Pragma("unroll") for (int k = 0; k < 2; ++k) \
        acc[ai][bj][m][n] = __builtin_amdgcn_mfma_f32_16x16x32_bf16(Bt[n][k], At[m][k], acc[ai][bj][m][n], 0, 0, 0); __builtin_amdgcn_s_setprio(0); } while (0)
#define PG8_WAIT_V(n) asm volatile("s_waitcnt vmcnt(" #n ")" ::: "memory")
#define PG8_WAIT_L(n) asm volatile("s_waitcnt lgkmcnt(" #n ")" ::: "memory")
#define PG8_BAR __builtin_amdgcn_s_barrier()
#define PG8_SCHED __builtin_amdgcn_sched_barrier(0)
    Unit cur, nxt; int ui = 0;
    if (!S.next(0, cur)) return;
    f32x4 acc[2][2][4][2];
#pragma unroll
    for (int a = 0; a < 2; ++a)
#pragma unroll
        for (int b = 0; b < 2; ++b)
#pragma unroll
            for (int m = 0; m < 4; ++m)
#pragma unroll
                for (int n = 0; n < 2; ++n) acc[a][b][m][n] = (f32x4){0.f, 0.f, 0.f, 0.f};
    bf16x8 At[4][2], B0[2][2], B1[2][2];
    const char* cA = (const char*)g.A + (size_t)cur.pm * tstep; const char* cB = (const char*)g.Bt + (size_t)cur.pn * tstep;
    S.a_ready(cur);
    if constexpr (SP2) {
        PG8_STAGE(PG8_SB(0, 0), cB, voffB); PG8_STAGE(PG8_SB(0, 1), cB + hstep, voffB); PG8_STAGE(PG8_SA(0, 0), cA, voffA); PG8_STAGE(PG8_SA(0, 1), cA + hstep, voffA);
        if (wr == 1) PG8_BAR;
        PG8_WAIT_V(2); PG8_BAR;
        PG8_STAGE(PG8_SB(1, 0), cB + kstep, voffB); PG8_STAGE(PG8_SA(1, 0), cA + kstep, voffA); PG8_STAGE(PG8_SB(1, 1), cB + hstep + kstep, voffB);
        PG8_WAIT_V(6); PG8_BAR;
    } else {
        PG8_STAGE(PG8_SB(0, 0), cB, voffB); PG8_STAGE(PG8_SA(0, 0), cA, voffA); PG8_STAGE(PG8_SB(0, 1), cB + hstep, voffB); PG8_STAGE(PG8_SA(0, 1), cA + hstep, voffA);
        if (wr == 1) PG8_BAR;
        PG8_WAIT_V(4); PG8_BAR;
        PG8_STAGE(PG8_SB(1, 0), cB + kstep, voffB); PG8_STAGE(PG8_SA(1, 0), cA + kstep, voffA); PG8_STAGE(PG8_SB(1, 1), cB + hstep + kstep, voffB);
        PG8_WAIT_V(6); PG8_BAR;
    }
    for (;;) {
        const bool has_next = S.next(ui + 1, nxt);
        const char* nA = has_next ? (const char*)g.A + (size_t)nxt.pm * tstep : cA; const char* nB = has_next ? (const char*)g.Bt + (size_t)nxt.pn * tstep : cB;
        for (int t = 0; t < nt; t += 2) {
            const bool last = (t == nt - 2);
            const char* a1 = cA + (size_t)(t + 1) * kstep;
            const char* a2 = last ? nA : cA + (size_t)(t + 2) * kstep; const char* b2 = last ? nB : cB + (size_t)(t + 2) * kstep;
            const char* a3 = a2 + kstep; const char* b3 = b2 + kstep;
            if (last && has_next) S.a_ready(nxt);
            if constexpr (SP2) {
            PG8_LDB(B0, 0, 0); PG8_LDB(B1, 0, 1); PG8_SCHED; PG8_LDA(At, 0, 0); PG8_STAGE(PG8_SA(1, 1), a1 + hstep, voffA);
            PG8_WAIT_V(8); PG8_WAIT_L(0); PG8_BAR; PG8_MMA(0, 0, At, B0); PG8_MMA(0, 1, At, B1); PG8_BAR; PG8_SCHED;
            PG8_LDA(At, 0, 1); PG8_STAGE(PG8_SB(0, 0), b2, voffB); PG8_STAGE(PG8_SB(0, 1), b2 + hstep, voffB); PG8_STAGE(PG8_SA(0, 0), a2, voffA);
            PG8_WAIT_V(8); PG8_WAIT_L(0); PG8_BAR; PG8_MMA(1, 0, At, B0); PG8_MMA(1, 1, At, B1); PG8_BAR; PG8_SCHED;
            PG8_LDB(B0, 1, 0); PG8_LDB(B1, 1, 1); PG8_SCHED; PG8_LDA(At, 1, 0); PG8_STAGE(PG8_SA(0, 1), a2 + hstep, voffA);
            PG8_WAIT_V(8); PG8_WAIT_L(0); PG8_BAR; PG8_MMA(0, 0, At, B0); PG8_MMA(0, 1, At, B1); PG8_BAR; PG8_SCHED;
            PG8_LDA(At, 1, 1); PG8_STAGE(PG8_SB(1, 0), b3, voffB); PG8_STAGE(PG8_SB(1, 1), b3 + hstep, voffB); PG8_STAGE(PG8_SA(1, 0), a3, voffA);
            PG8_WAIT_V(8); PG8_WAIT_L(0); PG8_BAR; PG8_MMA(1, 0, At, B0); PG8_MMA(1, 1, At, B1); PG8_BAR; PG8_SCHED;
            } else {
            PG8_LDB(B0, 0, 0); PG8_SCHED; PG8_LDA(At, 0, 0); PG8_STAGE(PG8_SA(1, 1), a1 + hstep, voffA);
            PG8_WAIT_L(8); PG8_BAR; PG8_WAIT_L(0); PG8_MMA(0, 0, At, B0); PG8_BAR; PG8_SCHED;
            PG8_LDB(B1, 0, 1); PG8_STAGE(PG8_SB(0, 0), b2, voffB);
            PG8_BAR; PG8_WAIT_L(0); PG8_MMA(0, 1, At, B1); PG8_BAR;
            PG8_LDA(At, 0, 1); PG8_STAGE(PG8_SA(0, 0), a2, voffA);
            PG8_BAR; PG8_WAIT_L(0); PG8_MMA(1, 0, At, B0); PG8_BAR; PG8_SCHED;
            PG8_STAGE(PG8_SB(0, 1), b2 + hstep, voffB);
            PG8_WAIT_V(6); PG8_BAR; PG8_MMA(1, 1, At, B1); PG8_BAR;
            PG8_LDB(B0, 1, 0); PG8_SCHED; PG8_LDA(At, 1, 0); PG8_STAGE(PG8_SA(0, 1), a2 + hstep, voffA);
            PG8_WAIT_L(8); PG8_BAR; PG8_WAIT_L(0); PG8_MMA(0, 0, At, B0); PG8_BAR; PG8_SCHED;
            PG8_LDB(B1, 1, 1); PG8_STAGE(PG8_SB(1, 0), b3, voffB);
            PG8_BAR; PG8_WAIT_L(0); PG8_MMA(0, 1, At, B1); PG8_BAR;
            PG8_LDA(At, 1, 1); PG8_STAGE(PG8_SA(1, 0), a3, voffA);
            PG8_BAR; PG8_WAIT_L(0); PG8_MMA(1, 0, At, B0); PG8_BAR; PG8_SCHED;
            PG8_STAGE(PG8_SB(1, 1), b3 + hstep, voffB);
            PG8_WAIT_V(6); PG8_BAR; PG8_MMA(1, 1, At, B1); PG8_BAR;
            }
        }
        if constexpr (ALIGN_EPI) { if (wr == 0) PG8_BAR; }
        if constexpr (!Epi::AFTER_DRAIN) { E(acc, cur, wr, wc, fr, fq); S.done(cur); }
        if (!has_next) break;
#pragma unroll
        for (int a = 0; a < 2; ++a)
#pragma unroll
            for (int b = 0; b < 2; ++b)
#pragma unroll
                for (int m = 0; m < 4; ++m)
#pragma unroll
                    for (int n = 0; n < 2; ++n) acc[a][b][m][n] = (f32x4){0.f, 0.f, 0.f, 0.f};
        cur = nxt; cA = nA; cB = nB; ++ui;
        if constexpr (ALIGN_EPI) { if (wr == 1) PG8_BAR; }
    }
    PG8_WAIT_V(0);
    if constexpr (!ALIGN_EPI) { if (wr == 0) PG8_BAR; }
    PG8_BAR;
    if constexpr (Epi::AFTER_DRAIN) { E.fused(acc, cur, wr, wc, fr, fq, lds, wid, lane); S.done(cur); }
#undef PG8_SA
#undef PG8_SB
#undef PG8_STAGE
#undef PG8_LDA
#undef PG8_LDB
#undef PG8_MMA
#undef PG8_WAIT_V
#undef PG8_WAIT_L
#undef PG8_BAR
#undef PG8_SCHED
}
}
#define XB_TMO      128
#define XB_XCNT(j)  (256  + 64 * (j))
#define XB_XSUB(j)  (1280 + 64 * (j))
#define XB_XGEN(j)  (2304 + 64 * (j))
#define XB_TOP      3328
#define XB_TOPGEN   3392
#define XCD_BAR_WORDS 3456
#define XB_SPIN_CAP (1u << 18)

__device__ __forceinline__ unsigned xb_ld(unsigned* p)              { return __hip_atomic_load(p, __ATOMIC_RELAXED, __HIP_MEMORY_SCOPE_AGENT); }
__device__ __forceinline__ unsigned xb_add(unsigned* p, unsigned v) { return __hip_atomic_fetch_add(p, v, __ATOMIC_RELAXED, __HIP_MEMORY_SCOPE_AGENT); }
__device__ __forceinline__ unsigned xb_xcc_id() { return (unsigned)__builtin_amdgcn_s_getreg((3 << 11) | 20) & 0xFu; }
#define XB_SPIN(cond, bar) do { unsigned _sp = 0; while (cond) { __builtin_amdgcn_s_sleep(1); \
    if ((++_sp & 255u) == 0u) { if (xb_ld(&(bar)[XB_TMO])) break; if (_sp > XB_SPIN_CAP) { atomicAdd(&(bar)[XB_TMO], 1u); break; } } } } while (0)

struct XcdBarrier {
    int wave; unsigned* bar; unsigned x;
    volatile LAS unsigned* st;
};

__device__ __forceinline__ bool xb_thread0(int wave) { return wave == 0 && lane_id_v() == 0; }
__device__ __forceinline__ XcdBarrier xcd_barrier_post(unsigned* bar, volatile LAS unsigned* st, int wave) {
    XcdBarrier b; b.wave = wave; b.bar = bar; b.x = xb_xcc_id(); b.st = st;
    if (xb_thread0(wave)) (void)xb_add(&bar[XB_XCNT(b.x)], 1u);
    return b;
}
__device__ __forceinline__ void xcd_barrier_complete(unsigned* bar, unsigned x, unsigned& nloc, unsigned& nx) {
    const unsigned G = gridDim.x * gridDim.y * gridDim.z;
    unsigned sum, cnt, mine, sp = 0u;
    for (;;) {
        sum = 0u; cnt = 0u; mine = 0u;
#pragma unroll
        for (unsigned j = 0; j < 16; ++j) { const unsigned c = xb_ld(&bar[XB_XCNT(j)]); sum += c; cnt += (c > 0u) ? 1u : 0u; mine = (j == x) ? c : mine; }
        if (sum == G) break;
        __builtin_amdgcn_s_sleep(1);
        if ((++sp & 255u) == 0u) { if (xb_ld(&bar[XB_TMO])) break; if (sp > XB_SPIN_CAP) { atomicAdd(&bar[XB_TMO], 1u); break; } }
    }
    nloc = mine > 0u ? mine : 1u; nx = cnt > 0u ? cnt : 1u;
}

__device__ __forceinline__ void xcd_barrier(const XcdBarrier& b) {
    asm volatile("s_waitcnt vmcnt(0)" ::: "memory");
    __syncthreads();
    if (xb_thread0(b.wave)) {
        unsigned* bar = b.bar; asm volatile("" : "+s"(bar));
        __builtin_amdgcn_s_waitcnt(0);
        unsigned nloc = b.st[0], nx = b.st[1];
        if (nloc == 0u) { unsigned xo = b.x; asm volatile("" : "+s"(xo)); xcd_barrier_complete(bar, xo, nloc, nx); b.st[0] = nloc; b.st[1] = nx; }
        const unsigned old = xb_add(&bar[XB_XSUB(b.x)], 1u);
        const unsigned gen = old / nloc;
        if (old + 1u == (gen + 1u) * nloc) {
            __builtin_amdgcn_fence(__ATOMIC_RELEASE, "agent");
            asm volatile("s_waitcnt vmcnt(0)" ::: "memory");
            const unsigned og = xb_add(&bar[XB_TOP], 1u);
            const unsigned tg = og / nx;
            if (og + 1u == (tg + 1u) * nx) xb_add(&bar[XB_TOPGEN], 1u);
            else XB_SPIN(xb_ld(&bar[XB_TOPGEN]) == tg, bar);
            __builtin_amdgcn_fence(__ATOMIC_ACQUIRE, "agent");
            xb_add(&bar[XB_XGEN(b.x)], 1u);
            asm volatile("s_waitcnt vmcnt(0)" ::: "memory");
        } else {
            XB_SPIN(xb_ld(&bar[XB_XGEN(b.x)]) == gen, bar);
            __builtin_amdgcn_fence(__ATOMIC_ACQUIRE, "agent");
            asm volatile("s_waitcnt vmcnt(0)" ::: "memory");
        }
    }
    __syncthreads();
}
template <int NT> __device__ __forceinline__ void sg_tile(const bf16* A, int r0, const bf16* Bt, const int (&nrow)[NT], int K, int lane, f32x4 (&acc)[NT]) {
    const bf16* ap = A + (size_t)(r0 + (lane & 15)) * K + 8 * (lane >> 4);
    const bf16* bp[NT];
#pragma unroll
    for (int t = 0; t < NT; ++t) bp[t] = Bt + (size_t)(nrow[t] + (lane & 15)) * K + 8 * (lane >> 4);
#pragma unroll 8
    for (int k = 0; k < K; k += 32) {
        const bf16x8 av = *(const bf16x8*)(ap + k);
#pragma unroll
        for (int t = 0; t < NT; ++t) { const bf16x8 bv = *(const bf16x8*)(bp[t] + k); acc[t] = __builtin_amdgcn_mfma_f32_16x16x32_bf16(av, bv, acc[t], 0, 0, 0); }
    }
}
__device__ __forceinline__ void sg_hgrn_in(const bf16* HN, const bf16* Wt, bf16* QB, float* GB, bf16* VB, bf16* GATE, const float* lbt, int gw, int NGW, int lane) {
    const bf16* A = HN + (size_t)MP * 1024;
    for (int tile = gw; tile < 8 * 256; tile += NGW) {
        const int mt = tile & 7, nt = tile >> 3; const int nrow[1] = {nt * 16}; f32x4 acc[1] = {{0.f, 0.f, 0.f, 0.f}};
        sg_tile<1>(A, mt * 16, Wt, nrow, 1024, lane, acc);
        const int col = nt * 16 + (lane & 15), type = col >> 10, c = col & 1023;
        const float llb = lbt[2 * c], l1p = lbt[2 * c + 1];
#pragma unroll
        for (int reg = 0; reg < 4; ++reg) {
            const size_t o = (size_t)(MP + mt * 16 + 4 * (lane >> 4) + reg) * 1024 + c; const float x = acc[0][reg];
            if (type == 0) QB[o] = (bf16)f2bf(pg8::silu_fast(x) * 0.08838834764831845f);
            else if (type == 1) GB[o] = pg8::logf_gate(x, llb, l1p);
            else if (type == 2) VB[o] = (bf16)f2bf(x);
            else GATE[o] = (bf16)f2bf(pg8::silu_fast(x));
        }
    }
}
__device__ __forceinline__ void sg_f32(const bf16* Abuf, int K, const bf16* Wt, int N, float* C, int ldc, int gw, int NGW, int lane) {
    const bf16* A = Abuf + (size_t)MP * K;
    for (int tile = gw; tile < 8 * (N / 16); tile += NGW) {
        const int mt = tile & 7, nt = tile >> 3; const int nrow[1] = {nt * 16}; f32x4 acc[1] = {{0.f, 0.f, 0.f, 0.f}};
        sg_tile<1>(A, mt * 16, Wt, nrow, K, lane, acc);
#pragma unroll
        for (int reg = 0; reg < 4; ++reg) C[(size_t)(MP + mt * 16 + 4 * (lane >> 4) + reg) * ldc + nt * 16 + (lane & 15)] = acc[0][reg];
    }
}
__device__ __forceinline__ void sg_swiglu(const bf16* HN, const bf16* Wt, bf16* ACT, int gw, int NGW, int lane) {
    const bf16* A = HN + (size_t)MP * 1024;
    for (int tile = gw; tile < 8 * (DFF / 16); tile += NGW) {
        const int mt = tile & 7, nt = tile >> 3, j0 = nt * 16; const int ng = 256 * (j0 >> 7) + (j0 & 127); const int nrow[2] = {ng, ng + 128};
        f32x4 acc[2] = {{0.f, 0.f, 0.f, 0.f}, {0.f, 0.f, 0.f, 0.f}};
        sg_tile<2>(A, mt * 16, Wt, nrow, 1024, lane, acc);
#pragma unroll
        for (int reg = 0; reg < 4; ++reg) ACT[(size_t)(MP + mt * 16 + 4 * (lane >> 4) + reg) * DFF + j0 + (lane & 15)] = (bf16)f2bf(pg8::silu_fast(acc[0][reg]) * acc[1][reg]);
    }
}
__device__ __forceinline__ void sg_uq(const bf16* QAN, const bf16* Wt, bf16* QN, bf16* QR, const float* CS, int gw, int NGW, int lane) {
    const bf16* A = QAN + (size_t)MP * QL;
    for (int tile = gw; tile < 8 * (1536 / 16); tile += NGW) {
        const int mt = tile & 7, nt = tile >> 3; const int nrow[1] = {nt * 16}; f32x4 acc[1] = {{0.f, 0.f, 0.f, 0.f}};
        sg_tile<1>(A, mt * 16, Wt, nrow, QL, lane, acc);
        const int col = nt * 16 + (lane & 15);
#pragma unroll
        for (int reg = 0; reg < 4; ++reg) {
            const int row = MP + mt * 16 + 4 * (lane >> 4) + reg; const float x = acc[0][reg]; const float partner = shx(x, 1, lane);
            if (col < 1024) QN[(size_t)row * 1024 + col] = (bf16)f2bf(x);
            else { const int rc = col - 1024, h = rc >> 6, ii = rc & 63, i = ii >> 1; const float cs = CS[(size_t)(2048 * 32 + i) * 2], sn = CS[(size_t)(2048 * 32 + i) * 2 + 1];
                float o; int ref;
                if ((ii & 1) == 0) { o = x * cs - partner * sn; ref = i; } else { o = x * cs + partner * sn; ref = 32 + i; }
                QR[(size_t)row * 512 + h * 64 + ref] = (bf16)f2bf(o); }
        }
    }
}

__device__ __forceinline__ int maprow(int kind, int j) {
    if (kind == 1) { if (j < DFF) return 256 * (j >> 7) + (j & 127); const int jj = j - DFF; return 256 * (jj >> 7) + 128 + (jj & 127); }
    if (kind == 2) return 384 + j;
    if (kind == 3) { const int h = j / 192, n = j - h * 192; if (n < 128) return h * 128 + n; const int i = n - 128; return 1024 + h * 64 + (i < 32 ? 2 * i : 2 * (i - 32) + 1); }
    if (kind == 4) { const int h = j >> 8, n = j & 255; return n < 128 ? h * 128 + n : 1024 + h * 128 + (n - 128); }
    return j;
}
__device__ __forceinline__ void cvt_item(const float* W, int K, int N, bf16* WT, int kind, const float* gain, float scale, LAS float* scr, int item, int lane) {
    const int nblk = N / 32, kb = item / nblk, nb = item - kb * nblk, k0 = 64 * kb, n0 = 32 * nb;
#pragma unroll 8
    for (int i = 0; i < 32; ++i) { const int kk = 2 * i + (lane >> 5); const float g = gain ? gain[k0 + kk] * scale : scale;
        scr[kk * 33 + (lane & 31)] = W[(size_t)(k0 + kk) * N + n0 + (lane & 31)] * g; }
    LDS_WAIT(); asm volatile("" ::: "memory");
    const int c = lane & 7;
#pragma unroll
    for (int j = 0; j < 4; ++j) { const int n = (lane >> 3) + 8 * j; const LAS float* s = scr + (8 * c) * 33 + n;
        v4u o; o.x = pk2(s[0 * 33], s[1 * 33]); o.y = pk2(s[2 * 33], s[3 * 33]); o.z = pk2(s[4 * 33], s[5 * 33]); o.w = pk2(s[6 * 33], s[7 * 33]);
        *(v4u*)(WT + (size_t)maprow(kind, n0 + n) * K + k0 + 8 * c) = o; }
    LDS_WAIT(); asm volatile("" ::: "memory");
}
__device__ __forceinline__ void row_resid_norm(const float* mix, float* X, const float* gain, bf16* HN, int lane) {
    const f32x4* mr = (const f32x4*)mix + lane; f32x4* xr = (f32x4*)X + lane; const f32x4* gr = (const f32x4*)gain + lane;
    f32x4 v[4]; float s = 0.f;
#pragma unroll
    for (int j = 0; j < 4; ++j) { v[j] = mr[64 * j]; s += (v[j][0] * v[j][0] + v[j][1] * v[j][1]) + (v[j][2] * v[j][2] + v[j][3] * v[j][3]); }
    const float r = rsqrtf(wave_sum(s) * (1.f / 1024.f) + EPS); float s2 = 0.f;
#pragma unroll
    for (int j = 0; j < 4; ++j) { const f32x4 x = xr[64 * j] + v[j] * r * gr[64 * j]; xr[64 * j] = x; v[j] = x; s2 += (x[0] * x[0] + x[1] * x[1]) + (x[2] * x[2] + x[3] * x[3]); }
    const float r2 = rsqrtf(wave_sum(s2) * (1.f / 1024.f) + EPS);
    v2u* o8 = (v2u*)HN + lane;
#pragma unroll
    for (int j = 0; j < 4; ++j) { v2u w; w.x = pk2(v[j][0] * r2, v[j][1] * r2); w.y = pk2(v[j][2] * r2, v[j][3] * r2); o8[64 * j] = w; }
}
__device__ __forceinline__ void hgrn_naive_phase(const bf16* QB, const float* GB, const bf16* VB, const bf16* GATE, const float* gnorm, const float* s0, float* st_p, float* st_s, bf16* OG,
                                                 LAS unsigned char* lds, int wg, int G, int tid) {
    LAS float* sq = (LAS float*)lds; LAS float* sf = sq + 128; LAS float* sk = sf + 128; LAS float* red = sk + 128;
    const int dv = tid & 127; const bool active = tid < 128;
    for (int unit = wg; unit < 64 + DB * HA; unit += G) {
        const bool prompt = unit < 64; const int uu = prompt ? unit : unit - 64; const int seq = uu >> 3, h = uu & 7;
        const int T = prompt ? SEQ : 1; const int row0 = prompt ? seq * SEQ : MP + seq;
        const size_t sb = ((size_t)seq * HA + h) * DK * DV;
        float S[128];
#pragma unroll
        for (int k = 0; k < 128; ++k) S[k] = (!prompt && active) ? s0[sb + (size_t)k * DV + dv] : 0.f;
        for (int t = 0; t < T; ++t) {
            const size_t o = (size_t)(row0 + t) * 1024 + h * 128 + dv;
            __syncthreads();
            float v = 0.f;
            if (active) { sq[dv] = bf2f(QB[o]); const float lf = GB[o]; sf[dv] = expf(lf); sk[dv] = -expm1f(lf); v = bf2f(VB[o]); }
            __syncthreads();
            float ov = 0.f;
            if (active) {
#pragma unroll
                for (int k = 0; k < 128; ++k) { S[k] = sf[k] * S[k] + sk[k] * v; ov += sq[k] * S[k]; }
            }
            const float ss = wave_sum(ov * ov);
            if (active && (tid & 63) == 0) red[tid >> 6] = ss;
            __syncthreads();
            if (active) { const float r = rsqrtf((red[0] + red[1]) * (1.f / 128.f) + EPS); OG[o] = (bf16)f2bf(ov * r * gnorm[h * 128 + dv] * bf2f(GATE[o])); }
        }
        if (active) { float* so = (prompt ? st_p : st_s) + sb;
#pragma unroll
            for (int k = 0; k < 128; ++k) so[(size_t)k * DV + dv] = S[k]; }
    }
}
__device__ __forceinline__ void attn_naive_phase(const bf16* QN, const bf16* QR, const bf16* KN, const bf16* KRB, const bf16* VV, bf16* O, LAS unsigned char* lds, int wg, int G, int tid) {
    LAS float* sc = (LAS float*)lds;
    LAS float* red = sc + SEQ;
    LAS float* part = red + 16;
    const int g16 = tid >> 4, l16 = tid & 15, wave = tid >> 6;
    for (int unit = wg; unit < BATCH * 8 * SEQ; unit += G) {
        const int t = unit & (SEQ - 1), h = (unit >> 11) & 7, b = unit >> 14; const size_t row = (size_t)b * SEQ + t;
        const v4u qa = *(const v4u*)(QN + row * 1024 + h * 128 + 8 * l16); const v2u qb = *(const v2u*)(QR + row * 512 + h * 64 + 4 * l16);
        float qf[12];
        qf[0] = bf2f(qa.x & 0xffff); qf[1] = bf2f(qa.x >> 16); qf[2] = bf2f(qa.y & 0xffff); qf[3] = bf2f(qa.y >> 16); qf[4] = bf2f(qa.z & 0xffff); qf[5] = bf2f(qa.z >> 16); qf[6] = bf2f(qa.w & 0xffff); qf[7] = bf2f(qa.w >> 16);
        qf[8] = bf2f(qb.x & 0xffff); qf[9] = bf2f(qb.x >> 16); qf[10] = bf2f(qb.y & 0xffff); qf[11] = bf2f(qb.y >> 16);
        __syncthreads();
        float mx = -1e30f;
        for (int s = g16; s <= t; s += 32) {
            const size_t kr = (size_t)b * SEQ + s;
            const v4u ka = *(const v4u*)(KN + kr * 1024 + h * 128 + 8 * l16); const v2u kb = *(const v2u*)(KRB + kr * 64 + 4 * l16);
            float d = qf[0] * bf2f(ka.x & 0xffff) + qf[1] * bf2f(ka.x >> 16) + qf[2] * bf2f(ka.y & 0xffff) + qf[3] * bf2f(ka.y >> 16) + qf[4] * bf2f(ka.z & 0xffff) + qf[5] * bf2f(ka.z >> 16) + qf[6] * bf2f(ka.w & 0xffff) + qf[7] * bf2f(ka.w >> 16)
                    + qf[8] * bf2f(kb.x & 0xffff) + qf[9] * bf2f(kb.x >> 16) + qf[10] * bf2f(kb.y & 0xffff) + qf[11] * bf2f(kb.y >> 16);
            { const int ln = tid & 63; d += shx(d, 1, ln); d += shx(d, 2, ln); d += shx(d, 4, ln); d += shx(d, 8, ln); }
            if (l16 == 0) sc[s] = d;
            mx = fmaxf(mx, d);
        }
        mx = wave_max(mx);
        if ((tid & 63) == 0) red[wave] = mx;
        __syncthreads();
        mx = fmaxf(fmaxf(fmaxf(red[0], red[1]), fmaxf(red[2], red[3])), fmaxf(fmaxf(red[4], red[5]), fmaxf(red[6], red[7])));
        float sum = 0.f;
        for (int s = tid; s <= t; s += NTHR) { const float p = exp2f(sc[s] - mx); sc[s] = p; sum += p; }
        sum = wave_sum(sum);
        if ((tid & 63) == 0) red[8 + wave] = sum;
        __syncthreads();
        sum = ((red[8] + red[9]) + (red[10] + red[11])) + ((red[12] + red[13]) + (red[14] + red[15]));
        const int d = tid & 127, pt = tid >> 7;
        float o = 0.f;
        for (int s = pt; s <= t; s += 4) o += sc[s] * bf2f(VV[((size_t)b * SEQ + s) * 1024 + h * 128 + d]);
        part[pt * 128 + d] = o;
        __syncthreads();
        if (pt == 0) O[row * 1024 + h * 128 + d] = (bf16)f2bf(((part[d] + part[128 + d]) + (part[256 + d] + part[384 + d])) / sum);
    }
}
__device__ __forceinline__ void decode_naive_phase(const bf16* QN, const bf16* QR, const bf16* WUKVN, const bf16* WUKV, const float* cache_c, const float* cache_kr, const int* page_table,
                                                   const float* c_s, const float* kr_s, float* SC, bf16* O, LAS unsigned char* lds, int wg, int G, int tid) {
    LAS float* ql = (LAS float*)lds;
    LAS float* qr = ql + 8 * 256;
    LAS float* red = qr + 8 * 64;
    LAS float* smx = red + 64;
    LAS float* ssum = smx + 8;
    LAS float* part = ssum + 8;
    const int lane = tid & 63, wave = tid >> 6;
    for (int b = wg; b < DB; b += G) {
        const size_t row = (size_t)MP + b;
        __syncthreads();
        { const int c = tid & 255, hh = tid >> 8;
            for (int h = hh * 4; h < hh * 4 + 4; ++h) { float a = 0.f;
                for (int n = 0; n < 128; ++n) a += bf2f(QN[row * 1024 + h * 128 + n]) * bf2f(WUKVN[(size_t)c * 2048 + h * 256 + n]);
                ql[h * 256 + c] = a; } }
        qr[tid] = bf2f(QR[row * 512 + tid]);
        __syncthreads();
        float* sc = SC + (size_t)b * 8 * SCP;
        float mx[8];
#pragma unroll
        for (int h = 0; h < 8; ++h) mx[h] = -1e30f;
        for (int s = wave; s <= PAST; s += NWAVES) {
            const float* cp; const float* kp;
            if (s < PAST) { const int pg = page_table[b * NPAGES + (s >> 7)]; cp = cache_c + ((size_t)pg * PAGE + (s & 127)) * 256; kp = cache_kr + ((size_t)pg * PAGE + (s & 127)) * 64; }
            else { cp = c_s + (size_t)b * 256; kp = kr_s + (size_t)b * 64; }
            const f32x4 cv = *(const f32x4*)(cp + 4 * lane); const float kv = kp[lane];
#pragma unroll
            for (int h = 0; h < 8; ++h) {
                const f32x4 q4 = *(const LAS f32x4*)(ql + h * 256 + 4 * lane);
                float d = (q4[0] * cv[0] + q4[1] * cv[1]) + (q4[2] * cv[2] + q4[3] * cv[3]) + qr[h * 64 + lane] * kv;
                d = wave_sum(d);
                if (lane == 0) sc[(size_t)h * SCP + s] = d;
                mx[h] = fmaxf(mx[h], d);
            }
        }
#pragma unroll
        for (int h = 0; h < 8; ++h) if (lane == 0) red[h * 8 + wave] = mx[h];
        asm volatile("s_waitcnt vmcnt(0)" ::: "memory");
        __syncthreads();
        if (tid < 8) { float m = red[tid * 8]; for (int w = 1; w < 8; ++w) m = fmaxf(m, red[tid * 8 + w]); smx[tid] = m; }
        __syncthreads();
#pragma unroll
        for (int h = 0; h < 8; ++h) {
            float sum = 0.f; const float m = smx[h];
            for (int s = tid; s <= PAST; s += NTHR) { const float p = exp2f(sc[(size_t)h * SCP + s] - m); sc[(size_t)h * SCP + s] = p; sum += p; }
            sum = wave_sum(sum);
            if (lane == 0) red[h * 8 + wave] = sum;
        }
        asm volatile("s_waitcnt vmcnt(0)" ::: "memory");
        __syncthreads();
        if (tid < 8) { float m = 0.f; for (int w = 0; w < 8; ++w) m += red[tid * 8 + w]; ssum[tid] = m; }
        __syncthreads();
        { const int c = tid & 255, pt = tid >> 8;
            float a[8];
#pragma unroll
            for (int h = 0; h < 8; ++h) a[h] = 0.f;
            for (int s = pt; s <= PAST; s += 2) {
                float cv;
                if (s < PAST) { const int pg = page_table[b * NPAGES + (s >> 7)]; cv = cache_c[((size_t)pg * PAGE + (s & 127)) * 256 + c]; }
                else cv = c_s[(size_t)b * 256 + c];
#pragma unroll
                for (int h = 0; h < 8; ++h) a[h] += sc[(size_t)h * SCP + s] * cv;
            }
#pragma unroll
            for (int h = 0; h < 8; ++h) part[(pt * 8 + h) * 256 + c] = a[h];
        }
        __syncthreads();
        for (int i = tid; i < 8 * 256; i += NTHR) { const int h = i >> 8; ql[i] = (part[i] + part[8 * 256 + i]) / ssum[h]; }
        __syncthreads();
        for (int idx = tid; idx < 1024; idx += NTHR) {
            const int h = idx >> 7; const bf16* w = WUKV + (size_t)(1024 + idx) * 256; float a = 0.f;
            for (int c = 0; c < 256; ++c) a += ql[h * 256 + c] * bf2f(w[c]);
            O[row * 1024 + idx] = (bf16)f2bf(a);
        }
    }
}
typedef float f32x16 __attribute__((ext_vector_type(16)));
__device__ __forceinline__ void attn_prompt_phase(const bf16* QN, const bf16* QR, const bf16* KN, const bf16* KRB, const bf16* VT, bf16* O, LAS unsigned char* lds, int wg, int G, int tid) {
    constexpr int KP = 400, VP = 136, KTB = 64 * KP, VTB = 128 * VP, BUFB = KTB + VTB;
    const int lane = tid & 63, wave = __builtin_amdgcn_readfirstlane(tid >> 6), r32 = lane & 31, hh = lane >> 5;
    const int c0 = tid, c1 = tid + 512;
    for (int unit = wg; unit < 256; unit += G) {
        const int bh = unit >> 2, pr = unit & 3, b = bh >> 3, h = bh & 7;
        for (int half = 0; half < 2; ++half) {
            const int qb = half ? 7 - pr : pr; const int ntiles = 4 * (qb + 1); const int q0 = 256 * qb + 32 * wave;
            const size_t qrow = (size_t)b * SEQ + q0 + r32;
            bf16x8 Qf[12];
#pragma unroll
            for (int ks = 0; ks < 8; ++ks) Qf[ks] = *(const bf16x8*)(QN + qrow * 1024 + h * 128 + 16 * ks + 8 * hh);
#pragma unroll
            for (int ks = 0; ks < 4; ++ks) Qf[8 + ks] = *(const bf16x8*)(QR + qrow * 512 + h * 64 + 16 * ks + 8 * hh);
            f32x16 Oa[4];
#pragma unroll
            for (int nb = 0; nb < 4; ++nb)
#pragma unroll
                for (int i = 0; i < 16; ++i) Oa[nb][i] = 0.f;
            float m = -1e30f, l = 0.f;
            v4u sk0, sk1, skr, sv0, sv1;
#define ATT_LOAD(kt) do { const size_t key0 = (size_t)b * SEQ + 64 * (kt); \
                sk0 = *(const v4u*)(KN + (key0 + (c0 >> 4)) * 1024 + h * 128 + (c0 & 15) * 8); sk1 = *(const v4u*)(KN + (key0 + (c1 >> 4)) * 1024 + h * 128 + (c1 & 15) * 8); \
                skr = *(const v4u*)(KRB + (key0 + (tid >> 3)) * 64 + (tid & 7) * 8); \
                sv0 = *(const v4u*)(VT + (size_t)(h * 128 + (c0 >> 3)) * MP + key0 + (c0 & 7) * 8); sv1 = *(const v4u*)(VT + (size_t)(h * 128 + (c1 >> 3)) * MP + key0 + (c1 & 7) * 8); } while (0)
#define ATT_WRITE(bi) do { LAS unsigned char* base = lds + (bi) * BUFB; \
                *(LAS v4u*)(base + (c0 >> 4) * KP + (c0 & 15) * 16) = sk0; *(LAS v4u*)(base + (c1 >> 4) * KP + (c1 & 15) * 16) = sk1; *(LAS v4u*)(base + (tid >> 3) * KP + 256 + (tid & 7) * 16) = skr; \
                { LAS v2u* p = (LAS v2u*)(base + KTB + (c0 >> 3) * VP + (c0 & 7) * 16); p[0] = (v2u){sv0.x, sv0.y}; p[1] = (v2u){sv0.z, sv0.w}; } \
                { LAS v2u* p = (LAS v2u*)(base + KTB + (c1 >> 3) * VP + (c1 & 7) * 16); p[0] = (v2u){sv1.x, sv1.y}; p[1] = (v2u){sv1.z, sv1.w}; } } while (0)
            ATT_LOAD(0); ATT_WRITE(0);
            __syncthreads();
            for (int kt = 0; kt < ntiles; ++kt) {
                if (kt + 1 < ntiles) ATT_LOAD(kt + 1);
                if (64 * kt <= q0 + 31) {
                    const LAS unsigned char* kb_ = lds + (kt & 1) * BUFB; const LAS unsigned char* vb_ = kb_ + KTB;
                    for (int kb = 0; kb < 2; ++kb) {
                        if (64 * kt + 32 * kb > q0 + 31) break;
                        f32x16 X;
#pragma unroll
                        for (int i = 0; i < 16; ++i) X[i] = 0.f;
                        const LAS unsigned char* kp = kb_ + (32 * kb + r32) * KP + hh * 16;
#pragma unroll
                        for (int ks = 0; ks < 12; ++ks) {
                            const bf16x8 kf = *(const LAS bf16x8*)(kp + ks * 32);
                            X = __builtin_amdgcn_mfma_f32_32x32x16_bf16(kf, Qf[ks], X, 0, 0, 0);
                            if ((ks & 3) == 3) asm volatile("" ::: "memory");
                        }
                        if (64 * kt + 32 * kb + 31 > q0) {
                            const int qi = q0 + r32, kbase = 64 * kt + 32 * kb + 4 * hh;
#pragma unroll
                            for (int i = 0; i < 16; ++i) { const int kr = kbase + (i & 3) + 8 * (i >> 2); if (kr > qi) X[i] = -1e30f; }
                        }
                        float mx = X[0];
#pragma unroll
                        for (int i = 1; i < 16; ++i) mx = fmaxf(mx, X[i]);
                        mx = fmaxf(mx, shx(mx, 32, lane));
                        const float mn = fmaxf(m, mx), alpha = __builtin_amdgcn_exp2f(m - mn); m = mn;
                        float ls = 0.f;
#pragma unroll
                        for (int i = 0; i < 16; ++i) { X[i] = __builtin_amdgcn_exp2f(X[i] - mn); ls += X[i]; }
                        l = l * alpha + ls;
                        if (__any(alpha != 1.0f)) {
#pragma unroll
                            for (int nb = 0; nb < 4; ++nb)
#pragma unroll
                                for (int i = 0; i < 16; ++i) Oa[nb][i] *= alpha;
                        }
                        bf16x8 Pf[2];
#pragma unroll
                        for (int s = 0; s < 2; ++s) {
                            v4u w0;
                            w0.x = cvtpk(X[8 * s + 0], X[8 * s + 1]); w0.y = cvtpk(X[8 * s + 2], X[8 * s + 3]); w0.z = cvtpk(X[8 * s + 4], X[8 * s + 5]); w0.w = cvtpk(X[8 * s + 6], X[8 * s + 7]);
                            Pf[s] = __builtin_bit_cast(bf16x8, w0);
                        }
                        const LAS unsigned char* vp0 = vb_ + r32 * VP + (32 * kb + 4 * hh) * 2;
#pragma unroll
                        for (int nb = 0; nb < 4; ++nb) {
#pragma unroll
                            for (int s = 0; s < 2; ++s) {
                                const LAS unsigned char* vp = vp0 + 32 * nb * VP + 32 * s;
                                const v2u a0 = *(const LAS v2u*)vp, a1 = *(const LAS v2u*)(vp + 16);
                                const v4u av = (v4u){a0.x, a0.y, a1.x, a1.y};
                                Oa[nb] = __builtin_amdgcn_mfma_f32_32x32x16_bf16(__builtin_bit_cast(bf16x8, av), Pf[s], Oa[nb], 0, 0, 0);
                            }
                            if (nb & 1) asm volatile("" ::: "memory");
                        }
                    }
                }
                if (kt + 1 < ntiles) ATT_WRITE((kt + 1) & 1);
                __syncthreads();
            }
#undef ATT_LOAD
#undef ATT_WRITE
            l += shx(l, 32, lane);
            const float inv = 1.0f / l;
            bf16* orow = O + qrow * 1024 + h * 128;
#pragma unroll
            for (int nb = 0; nb < 4; ++nb)
#pragma unroll
                for (int g = 0; g < 4; ++g) {
                    v2u w; w.x = pk2(Oa[nb][4 * g + 0] * inv, Oa[nb][4 * g + 1] * inv); w.y = pk2(Oa[nb][4 * g + 2] * inv, Oa[nb][4 * g + 3] * inv);
                    *(v2u*)(orow + 32 * nb + 8 * g + 4 * hh) = w;
                }
        }
    }
}
typedef float f32x4v __attribute__((ext_vector_type(4)));
__device__ __forceinline__ float one_minus_exp(float g) { return g > -0.03f ? -g * (1.0f + g * (0.5f + g * (0.16666667f + g * 0.041666668f))) : 1.0f - __expf(g); }
__device__ __forceinline__ void hgrn_pre_phase(const bf16* QB, const float* GB, const bf16* VB, bf16* QDP, bf16* KLTF, bf16* VTF, float* OI, float* DD, LAS unsigned char* lds, int wg, int G, int tid) {
    constexpr int QDP_ = 272, TP = 80;
    LAS unsigned char* QD = lds; LAS unsigned char* KD = QD + 32 * QDP_; LAS unsigned char* KLT = KD + 32 * QDP_; LAS unsigned char* VTt = KLT + 128 * TP; LAS unsigned char* AM = VTt + 128 * TP;
    LAS float* Dv = (LAS float*)(AM + 32 * TP); LAS float* tot = Dv + 128;
    const int lane = tid & 63, wave = __builtin_amdgcn_readfirstlane(tid >> 6), l15 = lane & 15, q4 = lane >> 4;
    const int kc2 = 2 * (tid & 63), tg = tid >> 6;
    f32x2_t ng[4]; unsigned nq[4], nv[4];
#define PRE_LOAD(uu) do { const int bh_ = (uu) >> 6, c_ = (uu) & 63; const size_t r_ = (size_t)(bh_ >> 3) * SEQ + 32 * c_; \
        _Pragma("unroll") for (int i = 0; i < 4; ++i) { const size_t o_ = (r_ + 4 * tg + i) * 1024 + (bh_ & 7) * 128 + kc2; ng[i] = *(const f32x2_t*)(GB + o_); nq[i] = *(const unsigned*)(QB + o_); nv[i] = *(const unsigned*)(VB + o_); } } while (0)
    if (wg < 64 * (SEQ / 32)) PRE_LOAD(wg);
    for (int u = wg; u < 64 * (SEQ / 32); u += G) {
        const int bh = u >> 6, c = u & 63, b = bh >> 3, h = bh & 7; const size_t row0 = (size_t)b * SEQ + 32 * c;
        float g0[4], g1[4]; unsigned qq[4], vv[4];
#pragma unroll
        for (int i = 0; i < 4; ++i) { g0[i] = ng[i][0]; g1[i] = ng[i][1]; qq[i] = nq[i]; vv[i] = nv[i]; }
        if (u + G < 64 * (SEQ / 32)) PRE_LOAD(u + G);
        float p0[4], p1[4]; p0[0] = g0[0]; p1[0] = g1[0];
#pragma unroll
        for (int i = 1; i < 4; ++i) { p0[i] = p0[i - 1] + g0[i]; p1[i] = p1[i - 1] + g1[i]; }
        __syncthreads();
        *(LAS f32x2_t*)(tot + tg * 128 + kc2) = (f32x2_t){p0[3], p1[3]};
        __syncthreads();
        float off0 = 0.f, off1 = 0.f, bl0 = 0.f, bl1 = 0.f;
#pragma unroll
        for (int j = 0; j < 8; ++j) { const f32x2_t tv = *(const LAS f32x2_t*)(tot + j * 128 + kc2); bl0 += tv[0]; bl1 += tv[1]; if (j < tg) { off0 += tv[0]; off1 += tv[1]; } }
        const float ebl0 = __expf(fmaxf(bl0, -80.f)), ebl1 = __expf(fmaxf(bl1, -80.f));
        float kl0[4], kl1[4];
#pragma unroll
        for (int i = 0; i < 4; ++i) {
            const float bc0 = fmaxf(off0 + p0[i], -80.f), bc1 = fmaxf(off1 + p1[i], -80.f);
            const float kk0 = one_minus_exp(g0[i]), kk1 = one_minus_exp(g1[i]);
            const float e0 = __expf(bc0), e1 = __expf(bc1), ie0 = __builtin_amdgcn_rcpf(e0), ie1 = __builtin_amdgcn_rcpf(e1);
            const float qd0 = bf2f(qq[i] & 0xffff) * e0, qd1 = bf2f(qq[i] >> 16) * e1;
            const float kd0 = kk0 * ie0, kd1 = kk1 * ie1;
            kl0[i] = kd0 * ebl0; kl1[i] = kd1 * ebl1;
            *(LAS unsigned*)(QD + (4 * tg + i) * QDP_ + kc2 * 2) = pk2(qd0, qd1);
            *(LAS unsigned*)(KD + (4 * tg + i) * QDP_ + kc2 * 2) = pk2(kd0, kd1);
        }
        *(LAS v2u*)(KLT + kc2 * TP + tg * 8) = (v2u){pk2(kl0[0], kl0[1]), pk2(kl0[2], kl0[3])};
        *(LAS v2u*)(KLT + (kc2 + 1) * TP + tg * 8) = (v2u){pk2(kl1[0], kl1[1]), pk2(kl1[2], kl1[3])};
        *(LAS v2u*)(VTt + kc2 * TP + tg * 8) = (v2u){(vv[0] & 0xffffu) | (vv[1] << 16), (vv[2] & 0xffffu) | (vv[3] << 16)};
        *(LAS v2u*)(VTt + (kc2 + 1) * TP + tg * 8) = (v2u){(vv[0] >> 16) | (vv[1] & 0xffff0000u), (vv[2] >> 16) | (vv[3] & 0xffff0000u)};
        if (tg == 0) *(LAS f32x2_t*)(Dv + kc2) = (f32x2_t){__expf(bl0), __expf(bl1)};
        __syncthreads();
        if (wave < 4) {
            const int ti = wave >> 1, si = wave & 1; f32x4v a = (f32x4v){0.f, 0.f, 0.f, 0.f};
            if (si <= ti) {
#pragma unroll
                for (int ks = 0; ks < 4; ++ks) {
                    const bf16x8 af = *(const LAS bf16x8*)(QD + (16 * ti + l15) * QDP_ + 64 * ks + 16 * q4), bfr = *(const LAS bf16x8*)(KD + (16 * si + l15) * QDP_ + 64 * ks + 16 * q4);
                    a = __builtin_amdgcn_mfma_f32_16x16x32_bf16(af, bfr, a, 0, 0, 0);
                }
            }
#pragma unroll
            for (int r = 0; r < 4; ++r) { const int t = 16 * ti + 4 * q4 + r, s = 16 * si + l15; *(LAS bf16*)(AM + t * TP + s * 2) = (bf16)f2bf(s <= t ? a[r] : 0.f); }
        } else {
            const int w4 = wave - 4;
#pragma unroll
            for (int j = 0; j < 2; ++j) {
                const int idx = 2 * w4 + j, tt = idx >> 2, ks = idx & 3;
                const LAS unsigned char* qp = QD + (16 * tt + l15) * QDP_ + (32 * ks + 4 * q4) * 2;
                const v2u a0 = *(const LAS v2u*)qp, a1 = *(const LAS v2u*)(qp + 32);
                *(v4u*)(QDP + (((size_t)u * 8 + idx) * 64 + lane) * 8) = (v4u){a0.x, a0.y, a1.x, a1.y};
                *(v4u*)(KLTF + (((size_t)u * 8 + idx) * 64 + lane) * 8) = *(const LAS v4u*)(KLT + (16 * idx + l15) * TP + 16 * q4);
                *(v4u*)(VTF + (((size_t)u * 8 + idx) * 64 + lane) * 8) = *(const LAS v4u*)(VTt + (16 * idx + l15) * TP + 16 * q4);
            }
            if (w4 == 0) { DD[(size_t)u * 128 + lane] = Dv[lane]; DD[(size_t)u * 128 + 64 + lane] = Dv[64 + lane]; }
        }
        __syncthreads();
        {
            const bf16x8 vtf = *(const LAS bf16x8*)(VTt + (16 * wave + l15) * TP + 16 * q4);
#pragma unroll
            for (int tt = 0; tt < 2; ++tt) {
                const bf16x8 amf = *(const LAS bf16x8*)(AM + (16 * tt + l15) * TP + 16 * q4);
                const f32x4v o = __builtin_amdgcn_mfma_f32_16x16x32_bf16(amf, vtf, (f32x4v){0.f, 0.f, 0.f, 0.f}, 0, 0, 0);
#pragma unroll
                for (int r = 0; r < 4; ++r) OI[(row0 + 16 * tt + 4 * q4 + r) * 1024 + h * 128 + 16 * wave + l15] = o[r];
            }
        }
    }
}
#undef PRE_LOAD
__device__ __forceinline__ void hgrn_chain_phase(const bf16* QB, const float* GB, const bf16* VB, const bf16* GATE, const float* gnorm, const float* s0, float* st_p, float* st_s, bf16* OG,
                                                 const bf16* QDP, const bf16* KLTF, const bf16* VTF, const float* OI, const float* DD, float* ORAW, LAS unsigned char* lds, int wg, int G, int tid) {
    const int lane = tid & 63, wave = __builtin_amdgcn_readfirstlane(tid >> 6), l15 = lane & 15, q4 = lane >> 4;
    if (wg < 64) {
        constexpr int CH_SLOT = 25600, CH_NS = 5;
        for (int bh = wg; bh < 64; bh += G) {
            const int b = bh >> 3, h = bh & 7; const size_t row0 = (size_t)b * SEQ; const size_t u0 = (size_t)bh * 64;
            if (wave >= 4) {
                const int lw = wave - 4;
#define CH_DMA(c) do { const size_t ub = u0 + (c); LAS unsigned char* sl = lds + ((c) % CH_NS) * CH_SLOT; \
                    _Pragma("unroll") for (int i = 0; i < 6; ++i) { const int p = lw + 4 * i; const bf16* src = (p < 8 ? QDP : (p < 16 ? KLTF : VTF)) + ((ub * 8 + (p & 7)) * 64 + lane) * 8; \
                        __builtin_amdgcn_global_load_lds((const unsigned*)src, (LAS unsigned*)(sl + p * 1024), 16, 0, 0); } \
                    __builtin_amdgcn_global_load_lds((const unsigned*)(DD + ub * 128 + (lane & 31) * 4), (LAS unsigned*)(sl + 24576), 16, 0, 0); } while (0)
                CH_DMA(0); CH_DMA(1); CH_DMA(2); CH_DMA(3);
                for (int c = 0; c < SEQ / 32; ++c) {
                    if (c <= SEQ / 32 - 4) asm volatile("s_waitcnt vmcnt(21)" ::: "memory"); else asm volatile("s_waitcnt vmcnt(0)" ::: "memory");
                    __builtin_amdgcn_s_barrier();
                    asm volatile("" ::: "memory");
                    if (c + 4 < SEQ / 32) CH_DMA(c + 4);
                }
#undef CH_DMA
            } else {
                f32x4v S[2][8];
#pragma unroll
                for (int s2 = 0; s2 < 2; ++s2)
#pragma unroll
                    for (int kt = 0; kt < 8; ++kt) S[s2][kt] = (f32x4v){0.f, 0.f, 0.f, 0.f};
                for (int c = 0; c < SEQ / 32; ++c) {
                    asm volatile("s_waitcnt lgkmcnt(0)" ::: "memory");
                    __builtin_amdgcn_s_barrier();
                    asm volatile("" ::: "memory");
                    const LAS unsigned char* sl = lds + (c % CH_NS) * CH_SLOT;
                    bf16x8 qf[8];
#pragma unroll
                    for (int i = 0; i < 8; ++i) qf[i] = *(const LAS bf16x8*)(sl + (i * 64 + lane) * 16);
                    bf16x8 Sb[2][4];
#pragma unroll
                    for (int s2 = 0; s2 < 2; ++s2)
#pragma unroll
                        for (int ks = 0; ks < 4; ++ks) { const v4u w = (v4u){cvtpk(S[s2][2 * ks][0], S[s2][2 * ks][1]), cvtpk(S[s2][2 * ks][2], S[s2][2 * ks][3]), cvtpk(S[s2][2 * ks + 1][0], S[s2][2 * ks + 1][1]), cvtpk(S[s2][2 * ks + 1][2], S[s2][2 * ks + 1][3])}; Sb[s2][ks] = __builtin_bit_cast(bf16x8, w); }
                    asm volatile("s_waitcnt lgkmcnt(0)" ::: "memory");
                    f32x4v o[2][2];
#pragma unroll
                    for (int s2 = 0; s2 < 2; ++s2)
#pragma unroll
                        for (int tt = 0; tt < 2; ++tt) o[s2][tt] = (f32x4v){0.f, 0.f, 0.f, 0.f};
#pragma unroll
                    for (int ks = 0; ks < 4; ++ks)
#pragma unroll
                        for (int s2 = 0; s2 < 2; ++s2)
#pragma unroll
                            for (int tt = 0; tt < 2; ++tt) o[s2][tt] = __builtin_amdgcn_mfma_f32_16x16x32_bf16(qf[4 * tt + ks], Sb[s2][ks], o[s2][tt], 0, 0, 0);
#pragma unroll
                    for (int s2 = 0; s2 < 2; ++s2)
#pragma unroll
                        for (int tt = 0; tt < 2; ++tt)
#pragma unroll
                            for (int r = 0; r < 4; ++r) ORAW[(row0 + 32 * c + 16 * tt + 4 * q4 + r) * 1024 + h * 128 + 16 * (2 * wave + s2) + l15] = o[s2][tt][r];
#pragma unroll
                    for (int s2 = 0; s2 < 2; ++s2) {
                        const bf16x8 vf = *(const LAS bf16x8*)(sl + 16384 + ((2 * wave + s2) * 64 + lane) * 16);
#pragma unroll
                        for (int kt = 0; kt < 8; ++kt) {
                            const f32x4v d4 = *(const LAS f32x4v*)(sl + 24576 + (16 * kt + 4 * q4) * 4);
                            S[s2][kt] = __builtin_amdgcn_mfma_f32_16x16x32_bf16(*(const LAS bf16x8*)(sl + 8192 + (kt * 64 + lane) * 16), vf, S[s2][kt] * d4, 0, 0, 0);
                        }
                    }
                }
#pragma unroll
                for (int s2 = 0; s2 < 2; ++s2) {
                    float* so = st_p + ((size_t)b * HA + h) * DK * DV + 16 * (2 * wave + s2) + l15;
#pragma unroll
                    for (int kt = 0; kt < 8; ++kt)
#pragma unroll
                        for (int r = 0; r < 4; ++r) so[(size_t)(16 * kt + 4 * q4 + r) * DV] = S[s2][kt][r];
                }
            }
            asm volatile("s_waitcnt vmcnt(0) lgkmcnt(0)" ::: "memory");
            __syncthreads();
            __syncthreads();
        }
    }
    if (G <= 64 || wg >= 64) {
        LAS float* red = (LAS float*)lds; LAS float* po = red + 16;
        const int first = G > 64 ? wg - 64 : wg, step = G > 64 ? G - 64 : G;
        const int dv4 = (tid & 31) * 4, kg = tid >> 5;
        f32x4v sn_[8]; float gq[8], qk[8]; f32x4v vv_;
#define SM_LOAD(un) do { const int b_ = (un) >> 3, h_ = (un) & 7; const size_t ib = ((size_t)MP + b_) * 1024 + h_ * 128; const size_t sb_ = ((size_t)b_ * HA + h_) * DK * DV; \
            _Pragma("unroll") for (int i = 0; i < 8; ++i) { const int k = kg + 16 * i; sn_[i] = *(const f32x4v*)(s0 + sb_ + (size_t)k * DV + dv4); gq[i] = GB[ib + k]; qk[i] = bf2f(QB[ib + k]); } \
            { const v2u vw = *(const v2u*)(VB + ib + dv4); vv_ = (f32x4v){bf2f(vw.x & 0xffff), bf2f(vw.x >> 16), bf2f(vw.y & 0xffff), bf2f(vw.y >> 16)}; } } while (0)
        if (first < DB * HA) SM_LOAD(first);
        for (int unit = first; unit < DB * HA; unit += step) {
            const int b = unit >> 3, h = unit & 7; const size_t idx = ((size_t)MP + b) * 1024 + h * 128 + (tid & 127); const size_t sb = ((size_t)b * HA + h) * DK * DV;
            f32x4v oacc = (f32x4v){0.f, 0.f, 0.f, 0.f};
#pragma unroll
            for (int i = 0; i < 8; ++i) { const int k = kg + 16 * i; const float f = __expf(gq[i]), kk = one_minus_exp(gq[i]);
                const f32x4v sn = sn_[i] * f + vv_ * kk; *(f32x4v*)(st_s + sb + (size_t)k * DV + dv4) = sn; oacc += sn * qk[i]; }
            if (unit + step < DB * HA) SM_LOAD(unit + step);
            __syncthreads();
            *(LAS f32x4v*)(po + kg * 128 + dv4) = oacc;
            __syncthreads();
            float ov = 0.f;
            if (tid < 128) {
#pragma unroll
                for (int j = 0; j < 16; ++j) ov += po[j * 128 + tid];
            }
            const float ss = wave_sum(ov * ov);
            if (tid < 128 && lane == 0) red[wave] = ss;
            __syncthreads();
            if (tid < 128) { const float rs = rsqrtf((red[0] + red[1]) * (1.f / 128.f) + EPS); OG[idx] = (bf16)f2bf(ov * rs * gnorm[h * 128 + tid] * bf2f(GATE[idx])); }
        }
#undef SM_LOAD
    }
}
__device__ __forceinline__ void hgrn_post_phase(const float* ORAW, const float* OI, const bf16* GATE, const float* gnorm, bf16* OG, int gw, int NGW, int lane) {
    f32x4v gn[4];
#pragma unroll
    for (int j = 0; j < 4; ++j) gn[j] = *(const f32x4v*)(gnorm + 16 * lane + 4 * j);
    for (int row = gw; row < MP; row += 2 * NGW) {
        f32x4v x[2][4]; v4u gt[2][2];
#pragma unroll
        for (int r = 0; r < 2; ++r) { const int rw = row + r * NGW; if (rw < MP) { const size_t base = (size_t)rw * 1024 + 16 * lane;
#pragma unroll
                for (int j = 0; j < 4; ++j) x[r][j] = *(const f32x4v*)(ORAW + base + 4 * j) + *(const f32x4v*)(OI + base + 4 * j);
                gt[r][0] = *(const v4u*)(GATE + base); gt[r][1] = *(const v4u*)(GATE + base + 8); } }
#pragma unroll
        for (int r = 0; r < 2; ++r) { const int rw = row + r * NGW; if (rw < MP) { const size_t base = (size_t)rw * 1024 + 16 * lane;
                float ss = 0.f;
#pragma unroll
                for (int j = 0; j < 4; ++j) ss += (x[r][j][0] * x[r][j][0] + x[r][j][1] * x[r][j][1]) + (x[r][j][2] * x[r][j][2] + x[r][j][3] * x[r][j][3]);
                ss += shx(ss, 1, lane); ss += shx(ss, 2, lane); ss += shx(ss, 4, lane);
                const float rs = rsqrtf(ss * (1.f / 128.f) + EPS);
                v4u w0, w1; const v4u g0 = gt[r][0], g1 = gt[r][1];
                w0.x = pk2(x[r][0][0] * rs * gn[0][0] * bf2f(g0.x & 0xffff), x[r][0][1] * rs * gn[0][1] * bf2f(g0.x >> 16)); w0.y = pk2(x[r][0][2] * rs * gn[0][2] * bf2f(g0.y & 0xffff), x[r][0][3] * rs * gn[0][3] * bf2f(g0.y >> 16));
                w0.z = pk2(x[r][1][0] * rs * gn[1][0] * bf2f(g0.z & 0xffff), x[r][1][1] * rs * gn[1][1] * bf2f(g0.z >> 16)); w0.w = pk2(x[r][1][2] * rs * gn[1][2] * bf2f(g0.w & 0xffff), x[r][1][3] * rs * gn[1][3] * bf2f(g0.w >> 16));
                w1.x = pk2(x[r][2][0] * rs * gn[2][0] * bf2f(g1.x & 0xffff), x[r][2][1] * rs * gn[2][1] * bf2f(g1.x >> 16)); w1.y = pk2(x[r][2][2] * rs * gn[2][2] * bf2f(g1.y & 0xffff), x[r][2][3] * rs * gn[2][3] * bf2f(g1.y >> 16));
                w1.z = pk2(x[r][3][0] * rs * gn[3][0] * bf2f(g1.z & 0xffff), x[r][3][1] * rs * gn[3][1] * bf2f(g1.z >> 16)); w1.w = pk2(x[r][3][2] * rs * gn[3][2] * bf2f(g1.w & 0xffff), x[r][3][3] * rs * gn[3][3] * bf2f(g1.w >> 16));
                *(v4u*)(OG + base) = w0; *(v4u*)(OG + base + 8) = w1; } }
    }
}
__device__ __forceinline__ void decode_phase(const bf16* QN, const bf16* QR, const bf16* WUKVN, const float* cache_c, const float* cache_kr, const int* page_table,
                                             float* PART, float* PML, float* QLAT, LAS unsigned char* lds, int wg, int G, int tid) {
    constexpr int QLP = 656;
    LAS unsigned char* QL = lds;
    LAS float* WO = (LAS float*)(lds + 16384);
    LAS float* WM = WO + 8 * 8 * 256;
    const int lane = tid & 63, wave = __builtin_amdgcn_readfirstlane(tid >> 6), l15 = lane & 15, q4 = lane >> 4;
    for (int unit = wg; unit < 2 * DB; unit += G) {
        const int b = unit >> 1, sp = unit & 1; const size_t row = (size_t)MP + b;
        __syncthreads();
        {
            const int c = tid & 255, hh = tid >> 8;
#pragma unroll 1
            for (int h = hh * 4; h < hh * 4 + 4; ++h) {
                const v4u* qp = (const v4u*)(QN + row * 1024 + h * 128); const v4u* wp = (const v4u*)(WUKVN + (size_t)c * 2048 + h * 256);
                float a = 0.f;
#pragma unroll 4
                for (int i = 0; i < 16; ++i) { const v4u qv = qp[i], wv = wp[i];
                    a += bf2f(qv.x & 0xffff) * bf2f(wv.x & 0xffff) + bf2f(qv.x >> 16) * bf2f(wv.x >> 16) + bf2f(qv.y & 0xffff) * bf2f(wv.y & 0xffff) + bf2f(qv.y >> 16) * bf2f(wv.y >> 16)
                       + bf2f(qv.z & 0xffff) * bf2f(wv.z & 0xffff) + bf2f(qv.z >> 16) * bf2f(wv.z >> 16) + bf2f(qv.w & 0xffff) * bf2f(wv.w & 0xffff) + bf2f(qv.w >> 16) * bf2f(wv.w >> 16); }
                *(LAS bf16*)(QL + h * QLP + c * 2) = (bf16)f2bf(a);
                if (sp == 0) QLAT[((size_t)b * 8 + h) * 320 + c] = a;
            }
            { const int h = tid >> 6, i = tid & 63; const unsigned qv = QR[row * 512 + tid]; *(LAS bf16*)(QL + h * QLP + 512 + i * 2) = (bf16)qv; if (sp == 0) QLAT[((size_t)b * 8 + h) * 320 + 256 + i] = bf2f(qv); }
            for (int i = tid; i < 8 * QLP / 4; i += NTHR) ((LAS unsigned*)(QL + 8 * QLP))[i] = 0u;
        }
        __syncthreads();
        bf16x8 ID[2];
        { v4u w0, w1; const int kl = 8 * q4;
#define IDW(x, j) ((kl + (j) == 16 * (x) + l15) ? 0x3F80u : 0u)
            w0.x = IDW(0, 0) | (IDW(0, 1) << 16); w0.y = IDW(0, 2) | (IDW(0, 3) << 16); w0.z = IDW(0, 4) | (IDW(0, 5) << 16); w0.w = IDW(0, 6) | (IDW(0, 7) << 16);
            w1.x = IDW(1, 0) | (IDW(1, 1) << 16); w1.y = IDW(1, 2) | (IDW(1, 3) << 16); w1.z = IDW(1, 4) | (IDW(1, 5) << 16); w1.w = IDW(1, 6) | (IDW(1, 7) << 16);
#undef IDW
            ID[0] = __builtin_bit_cast(bf16x8, w0); ID[1] = __builtin_bit_cast(bf16x8, w1); }
        f32x4v Oa[16];
#pragma unroll
        for (int cb = 0; cb < 16; ++cb) Oa[cb] = (f32x4v){0.f, 0.f, 0.f, 0.f};
        float m = -1e30f, l = 0.f;
        const LAS unsigned char* qfp = QL + l15 * QLP + 16 * q4;
        for (int pi = 0; pi < 4; ++pi) {
            const int page = page_table[b * NPAGES + 32 * sp + 4 * wave + pi];
            for (int st = 0; st < 8; ++st) {
                const size_t slot = (size_t)page * PAGE + 16 * st + l15;
                const GAS float* crow = (const GAS float*)cache_c + slot * 256 + 8 * q4; const GAS float* krow = (const GAS float*)cache_kr + slot * 64 + 8 * q4;
                f32x4v raw[20];
#pragma unroll
                for (int ks = 0; ks < 10; ++ks) {
                    const GAS float* p = ks < 8 ? crow + 32 * ks : krow + 32 * (ks - 8);
                    raw[2 * ks] = __builtin_nontemporal_load((const GAS f32x4v*)p); raw[2 * ks + 1] = __builtin_nontemporal_load((const GAS f32x4v*)(p + 4));
                }
                bf16x8 Cf[10];
#pragma unroll
                for (int ks = 0; ks < 10; ++ks) {
                    const f32x4v r0 = raw[2 * ks], r1 = raw[2 * ks + 1];
                    const v4u w = (v4u){cvtpk(r0[0], r0[1]), cvtpk(r0[2], r0[3]), cvtpk(r1[0], r1[1]), cvtpk(r1[2], r1[3])};
                    Cf[ks] = __builtin_bit_cast(bf16x8, w);
                }
                f32x4v S = (f32x4v){0.f, 0.f, 0.f, 0.f};
#pragma unroll
                for (int ks = 0; ks < 10; ++ks) { const bf16x8 qf = *(const LAS bf16x8*)(qfp + 64 * ks); S = __builtin_amdgcn_mfma_f32_16x16x32_bf16(Cf[ks], qf, S, 0, 0, 0); }
                float mx = fmaxf(fmaxf(S[0], S[1]), fmaxf(S[2], S[3]));
                mx = fmaxf(mx, shx(mx, 16, lane)); mx = fmaxf(mx, shx(mx, 32, lane));
                const float mn = fmaxf(m, mx), alpha = __builtin_amdgcn_exp2f(m - mn); m = mn;
                const float p0 = __builtin_amdgcn_exp2f(S[0] - mn), p1 = __builtin_amdgcn_exp2f(S[1] - mn), p2 = __builtin_amdgcn_exp2f(S[2] - mn), p3 = __builtin_amdgcn_exp2f(S[3] - mn);
                l = l * alpha + ((p0 + p1) + (p2 + p3));
                if (__any(alpha != 1.0f)) {
#pragma unroll
                    for (int cb = 0; cb < 16; ++cb) Oa[cb] *= alpha;
                }
                const v4u pw = (v4u){cvtpk(p0, p1), cvtpk(p2, p3), 0u, 0u};
                const bf16x8 Pf = __builtin_bit_cast(bf16x8, pw);
#pragma unroll
                for (int cb = 0; cb < 16; ++cb) {
                    const f32x4v Dt = __builtin_amdgcn_mfma_f32_16x16x32_bf16(Cf[cb >> 1], ID[cb & 1], (f32x4v){0.f, 0.f, 0.f, 0.f}, 0, 0, 0);
                    const v4u aw = (v4u){cvtpk(Dt[0], Dt[1]), cvtpk(Dt[2], Dt[3]), 0u, 0u};
                    Oa[cb] = __builtin_amdgcn_mfma_f32_16x16x32_bf16(__builtin_bit_cast(bf16x8, aw), Pf, Oa[cb], 0, 0, 0);
                }
            }
        }
        l += shx(l, 16, lane); l += shx(l, 32, lane);
        if (l15 < 8) {
#pragma unroll
            for (int cb = 0; cb < 16; ++cb) *(LAS f32x4v*)(WO + (wave * 8 + l15) * 256 + 16 * cb + 4 * q4) = Oa[cb];
            if (q4 == 0) { WM[(wave * 8 + l15) * 2] = m; WM[(wave * 8 + l15) * 2 + 1] = l; }
        }
        __syncthreads();
        {
            const int t2 = wave * 64 + lane_id_v(); const int h = t2 >> 6, ch4 = (t2 & 63) * 4;
            float M = -1e30f;
#pragma unroll
            for (int w = 0; w < 8; ++w) M = fmaxf(M, WM[(w * 8 + h) * 2]);
            float L = 0.f; f32x4v acc = (f32x4v){0.f, 0.f, 0.f, 0.f};
#pragma unroll
            for (int w = 0; w < 8; ++w) { const float e = __builtin_amdgcn_exp2f(WM[(w * 8 + h) * 2] - M); L += WM[(w * 8 + h) * 2 + 1] * e; acc += *(const LAS f32x4v*)(WO + (w * 8 + h) * 256 + ch4) * e; }
            *(f32x4v*)(PART + (((size_t)b * 2 + sp) * 8 + h) * 256 + ch4) = acc;
            if ((t2 & 63) == 0) { PML[(((size_t)b * 2 + sp) * 8 + h) * 2] = M; PML[(((size_t)b * 2 + sp) * 8 + h) * 2 + 1] = L; }
        }
    }
}
__device__ __forceinline__ void decode_combine_phase(const float* PART, const float* PML, const float* QLAT, const float* c_s, const float* kr_s, const bf16* WUKV, bf16* O, LAS unsigned char* lds, int wg, int G, int tid) {
    LAS float* ol = (LAS float*)lds;
    LAS float* sn = ol + 8 * 256;
    const int lane = tid & 63, wave = __builtin_amdgcn_readfirstlane(tid >> 6);
    for (int b = wg; b < DB; b += G) {
        __syncthreads();
        { const float* q = QLAT + ((size_t)b * 8 + wave) * 320; float d = 0.f;
#pragma unroll
            for (int i = 0; i < 4; ++i) d += q[lane + 64 * i] * c_s[(size_t)b * 256 + lane + 64 * i];
            d += q[256 + lane] * kr_s[(size_t)b * 64 + lane];
            d = wave_sum(d);
            if (lane == 0) sn[wave] = d; }
        __syncthreads();
        { const int h = tid >> 6, ch4 = (tid & 63) * 4;
            const float m0 = PML[(((size_t)b * 2 + 0) * 8 + h) * 2], l0 = PML[(((size_t)b * 2 + 0) * 8 + h) * 2 + 1], m1 = PML[(((size_t)b * 2 + 1) * 8 + h) * 2], l1 = PML[(((size_t)b * 2 + 1) * 8 + h) * 2 + 1], s2 = sn[h];
            const float Mx = fmaxf(fmaxf(m0, m1), s2), w0 = __builtin_amdgcn_exp2f(m0 - Mx), w1 = __builtin_amdgcn_exp2f(m1 - Mx), w2 = __builtin_amdgcn_exp2f(s2 - Mx);
            const float invL = 1.0f / (l0 * w0 + l1 * w1 + w2);
            const f32x4v a0 = *(const f32x4v*)(PART + (((size_t)b * 2 + 0) * 8 + h) * 256 + ch4), a1 = *(const f32x4v*)(PART + (((size_t)b * 2 + 1) * 8 + h) * 256 + ch4), cn = *(const f32x4v*)(c_s + (size_t)b * 256 + ch4);
            *(LAS f32x4v*)(ol + h * 256 + ch4) = (a0 * w0 + a1 * w1 + cn * w2) * invL; }
        __syncthreads();
        for (int idx = tid; idx < 1024; idx += NTHR) {
            const int h = idx >> 7; const v4u* w = (const v4u*)(WUKV + (size_t)(1024 + idx) * 256); const LAS float* o = ol + h * 256; float a = 0.f;
#pragma unroll 4
            for (int i = 0; i < 32; ++i) { const v4u wv = w[i]; const f32x4v o0 = *(const LAS f32x4v*)(o + 8 * i), o1 = *(const LAS f32x4v*)(o + 8 * i + 4);
                a += o0[0] * bf2f(wv.x & 0xffff) + o0[1] * bf2f(wv.x >> 16) + o0[2] * bf2f(wv.y & 0xffff) + o0[3] * bf2f(wv.y >> 16) + o1[0] * bf2f(wv.z & 0xffff) + o1[1] * bf2f(wv.z >> 16) + o1[2] * bf2f(wv.w & 0xffff) + o1[3] * bf2f(wv.w >> 16); }
            O[((size_t)MP + b) * 1024 + idx] = (bf16)f2bf(a);
        }
    }
}
constexpr int NPH = 1 + 4 * 11;
__host__ __device__ constexpr bool phase_exists(int k) {
    if (k == 0) return true;
    const int l = (k - 1) / 11, s = (k - 1) % 11;
    if (l < 2) return !(s >= 4 && s <= 5);
    return s != 3 || l == 2;
}
struct Args { const float* in[21]; float* out; unsigned char* ws; int ph_lo, ph_hi, li, pad; };


__device__ __forceinline__ unsigned long long karg64(int byte_off) {
    unsigned long long v;
    asm volatile("s_load_dwordx2 %0, %1, %2\n\ts_waitcnt lgkmcnt(0)" : "=s"(v) : "s"(__builtin_amdgcn_kernarg_segment_ptr()), "i"(byte_off) : "memory");
    return v;
}
__device__ __forceinline__ int karg32(int byte_off) {
    int v;
    asm volatile("s_load_dword %0, %1, %2\n\ts_waitcnt lgkmcnt(0)" : "=s"(v) : "s"(__builtin_amdgcn_kernarg_segment_ptr()), "i"(byte_off) : "memory");
    return v;
}
#define ARG_IN(i) ((const float*)karg64(8 * (i)))
#define ARG_OUT() ((float*)karg64(8 * 21))
#define ARG_WS() ((unsigned char*)karg64(8 * 22))
#ifndef REP_GEMM
#define REP_GEMM 1
#endif
#ifndef REP_SG
#define REP_SG 1
#endif
#ifndef REP_ATTN
#define REP_ATTN 1
#endif
#ifndef REP_DEC
#define REP_DEC 1
#endif
#ifndef REP_HPRE
#define REP_HPRE 1
#endif
#ifndef REP_HGRN
#define REP_HGRN 1
#endif
#ifndef REP_BAR
#define REP_BAR 1
#endif
struct Ctx { LAS unsigned char* lds; int tid, lane, wave, wg, G, gw, NGW; };
__device__ __forceinline__ Ctx fresh(const Ctx& c0) {
    Ctx c; c.lds = c0.lds; int wv = c0.wave; asm volatile("" : "+s"(wv)); int t = wv * 64 + lane_id_v(); int w = blockIdx.x; asm volatile("" : "+s"(w)); int g = gridDim.x; asm volatile("" : "+s"(g));
    c.tid = t; c.lane = t & 63; c.wave = __builtin_amdgcn_readfirstlane(t >> 6); c.wg = w; c.G = g; c.gw = w * NWAVES + c.wave; c.NGW = g * NWAVES; return c;
}

__device__ __forceinline__ void ph_prologue(const Ctx& c0) {
    const Ctx c = fresh(c0);
    unsigned char* ws = ARG_WS();
    const float* norm_gains = ARG_IN(6);
    LAS float* scr = (LAS float*)(c.lds + c.wave * 16384);
    constexpr int NITEMS = 4096 + 1024 + 11264 + 5632 + 192 + 160 + 192 + 576 + 256 + 1024;
    for (int it = c.gw; it < NITEMS; it += c.NGW) {
        int r = it, l; const float* W; int K, N, kind = 0; bf16* WT; const float* gain = nullptr; float scale = 1.f;
        if (r < 4096) { l = r / 2048; r -= l * 2048; W = ARG_IN(9) + (size_t)l * 1024 * 4096; K = 1024; N = 4096; WT = (bf16*)(ws + WS_WIN) + (size_t)l * 4096 * 1024; gain = norm_gains + (l * 4 + 0) * 1024; }
        else if ((r -= 4096) < 1024) { l = r / 512; r -= l * 512; W = ARG_IN(12) + (size_t)l * 1024 * 1024; K = 1024; N = 1024; WT = (bf16*)(ws + WS_WOUTA) + (size_t)l * 1024 * 1024; }
        else if ((r -= 1024) < 11264) { l = r / 2816; r -= l * 2816; W = ARG_IN(7) + (size_t)l * 1024 * 5632; K = 1024; N = 5632; WT = (bf16*)(ws + WS_WFIN) + (size_t)l * 5632 * 1024; kind = 1; gain = norm_gains + (l * 4 + 2) * 1024; }
        else if ((r -= 11264) < 5632) { l = r / 1408; r -= l * 1408; W = ARG_IN(8) + (size_t)l * 2816 * 1024; K = 2816; N = 1024; WT = (bf16*)(ws + WS_WFOUT) + (size_t)l * 1024 * 2816; }
        else if ((r -= 5632) < 192) { W = ARG_IN(17); K = 1024; N = 384; WT = (bf16*)(ws + WS_WDQ0); gain = norm_gains + (2 * 4 + 0) * 1024; }
        else if ((r -= 192) < 160) { W = ARG_IN(14); K = 1024; N = 320; WT = (bf16*)(ws + WS_WDQ0); kind = 2; gain = ARG_IN(13); }
        else if ((r -= 160) < 192) { W = ARG_IN(17) + (size_t)1024 * 384; K = 1024; N = 384; WT = (bf16*)(ws + WS_WDQ1); gain = norm_gains + (3 * 4 + 0) * 1024; }
        else if ((r -= 192) < 576) { l = r / 288; r -= l * 288; W = ARG_IN(19) + (size_t)l * 384 * 1536; K = 384; N = 1536; WT = (bf16*)(ws + WS_WUQ) + (size_t)l * 1536 * 384; kind = 3; gain = ARG_IN(18) + l * 384; scale = QSCALE; }
        else if ((r -= 576) < 256) { W = ARG_IN(16); K = 256; N = 2048; WT = (bf16*)(ws + WS_WUKV); kind = 4; }
        else { r -= 256; l = r / 512; r -= l * 512; W = ARG_IN(20) + (size_t)l * 1024 * 1024; K = 1024; N = 1024; WT = (bf16*)(ws + WS_WOUTB) + (size_t)l * 1024 * 1024; }
        cvt_item(W, K, N, WT, kind, gain, scale, scr, r, c.lane);
    }
    const size_t gt = (size_t)c.wg * NTHR + c.tid, NT = (size_t)c.G * NTHR;
    { bf16* WDQ0 = (bf16*)(ws + WS_WDQ0); bf16* WDQ1 = (bf16*)(ws + WS_WDQ1);
      for (size_t i = gt; i < (size_t)64 * 1024 / 8; i += NT) ((v4u*)(WDQ0 + (size_t)704 * 1024))[i] = (v4u){0u, 0u, 0u, 0u};
      for (size_t i = gt; i < (size_t)128 * 1024 / 8; i += NT) ((v4u*)(WDQ1 + (size_t)384 * 1024))[i] = (v4u){0u, 0u, 0u, 0u}; }
    { const float* w_ukv = ARG_IN(16); bf16* WUKVN = (bf16*)(ws + WS_WUKVN);
      for (size_t i = gt; i < (size_t)256 * 2048 / 4; i += NT) { const f32x4 v = ((const f32x4*)w_ukv)[i]; v2u w; w.x = pk2(v[0], v[1]); w.y = pk2(v[2], v[3]); ((v2u*)WUKVN)[i] = w; } }
    { float* CS = (float*)(ws + WS_CS);
      for (size_t i = gt; i < (size_t)2049 * 32; i += NT) { const int p = (int)(i >> 5), fi = (int)(i & 31); const double pos = p < 2048 ? (double)p : (double)PAST;
        const double ang = pos * pow(10000.0, -(double)fi / 32.0); CS[2 * i] = (float)cos(ang); CS[2 * i + 1] = (float)sin(ang); } }
    { float* LBT = (float*)(ws + WS_LBT); const float* lb_logits = ARG_IN(10);
      for (size_t i = gt; i < 2048; i += NT) { const int l = (int)(i >> 10), d = (int)(i & 1023); float lb = 0.f;
        if (l == 1) lb = 1.f / (1.f + expf(lb_logits[d] - lb_logits[1024 + d]));
        LBT[2 * i] = logf(fmaxf(lb, 1e-30f)); LBT[2 * i + 1] = log1pf(-lb); } }
    { const float* x_prompt = ARG_IN(0); const float* x_sample = ARG_IN(1); float* X = ARG_OUT(); bf16* HN = (bf16*)(ws + WS_HN);
      for (int m = c.gw; m < M; m += c.NGW) {
        const f32x4* xr = (const f32x4*)(m < MP ? x_prompt + (size_t)m * D : x_sample + (size_t)(m - MP) * D) + c.lane; f32x4* xo = (f32x4*)(X + (size_t)m * D) + c.lane;
        f32x4 v[4]; float s = 0.f;
#pragma unroll
        for (int j = 0; j < 4; ++j) { v[j] = xr[64 * j]; xo[64 * j] = v[j]; s += (v[j][0] * v[j][0] + v[j][1] * v[j][1]) + (v[j][2] * v[j][2] + v[j][3] * v[j][3]); }
        const float r = rsqrtf(wave_sum(s) * (1.f / 1024.f) + EPS);
        v2u* o8 = (v2u*)(HN + (size_t)m * D) + c.lane;
#pragma unroll
        for (int j = 0; j < 4; ++j) { v2u w; w.x = pk2(v[j][0] * r, v[j][1] * r); w.y = pk2(v[j][2] * r, v[j][3] * r); o8[64 * j] = w; }
      } }
}
__device__ __forceinline__ void ph_hgrn_in(const Ctx& c0, int l) {
    const Ctx c = fresh(c0);
    unsigned char* ws = ARG_WS();
    const bf16* HN = (const bf16*)(ws + WS_HN); const bf16* Wt = (const bf16*)(ws + WS_WIN) + (size_t)l * 4096 * 1024; const float* lbt = (const float*)(ws + WS_LBT) + (size_t)l * 2048;
    bf16* QB = (bf16*)(ws + WS_QB); float* GB = (float*)(ws + WS_GB); bf16* VB = (bf16*)(ws + WS_VB); bf16* GATE = (bf16*)(ws + WS_GATE);
    pg8::Gemm g{HN, Wt, MP, 4096, 1024}; pg8::StaticOrder S; S.init(MP, 4096, c.G, c.wg);
    pg8::EpiHgrnIn E{ws, l};
    for (int r_ = 0; r_ < REP_GEMM; ++r_) pg8::gemm_phase<pg8::EpiHgrnIn, pg8::StaticOrder, true, true>(c.lds, g, S, E, c.tid);
    const Ctx c2 = fresh(c0);
    for (int r_ = 0; r_ < REP_SG; ++r_) sg_hgrn_in(HN, Wt, QB, GB, VB, GATE, lbt, c2.gw, c2.NGW, c2.lane);
}
__device__ __forceinline__ void ph_hgrn_pre(const Ctx& c0) {
    const Ctx c = fresh(c0);
    unsigned char* ws = ARG_WS();
    for (int r_ = 0; r_ < REP_HPRE; ++r_) hgrn_pre_phase((const bf16*)(ws + WS_QB), (const float*)(ws + WS_GB), (const bf16*)(ws + WS_VB), (bf16*)(ws + WS_KN), (bf16*)(ws + WS_VV), (bf16*)(ws + WS_QN), (float*)(ws + WS_ACT), (float*)(ws + WS_QC), c.lds, c.wg, c.G, c.tid);
}
__device__ __forceinline__ void ph_hgrn_rec(const Ctx& c0, int l) {
    const Ctx c = fresh(c0);
    unsigned char* ws = ARG_WS(); float* X = ARG_OUT();
    float* st_p = X + (size_t)M * D; float* st_s = st_p + (size_t)2 * BATCH * HA * DK * DV + (size_t)MP * KVL + (size_t)MP * 64;
    for (int r_ = 0; r_ < REP_HGRN; ++r_) hgrn_chain_phase((const bf16*)(ws + WS_QB), (const float*)(ws + WS_GB), (const bf16*)(ws + WS_VB), (const bf16*)(ws + WS_GATE), ARG_IN(11) + (size_t)l * D, ARG_IN(2) + (size_t)l * DB * HA * DK * DV,
                     st_p + (size_t)l * BATCH * HA * DK * DV, st_s + (size_t)l * DB * HA * DK * DV, (bf16*)(ws + WS_OG),
                     (const bf16*)(ws + WS_KN), (const bf16*)(ws + WS_VV), (const bf16*)(ws + WS_QN), (const float*)(ws + WS_ACT), (const float*)(ws + WS_QC), (float*)(ws + WS_MIX), c.lds, c.wg, c.G, c.tid);
}
__device__ __forceinline__ void ph_hgrn_post(const Ctx& c0, int l) {
    const Ctx c = fresh(c0);
    unsigned char* ws = ARG_WS();
    hgrn_post_phase((const float*)(ws + WS_MIX), (const float*)(ws + WS_ACT), (const bf16*)(ws + WS_GATE), ARG_IN(11) + (size_t)l * D, (bf16*)(ws + WS_OG), c.gw, c.NGW, c.lane);
}
__device__ __forceinline__ void ph_dq(const Ctx& c0, int j) {
    const Ctx c = fresh(c0);
    unsigned char* ws = ARG_WS();
    const int N = (j == 0) ? 768 : 512; const bf16* Wt = (const bf16*)(ws + ((j == 0) ? WS_WDQ0 : WS_WDQ1)); const bf16* HN = (const bf16*)(ws + WS_HN); float* QC = (float*)(ws + WS_QC);
    pg8::Gemm g{HN, Wt, MP, N, 1024}; pg8::StaticOrder S; S.init(MP, N, c.G, c.wg);
    pg8::EpiF32 E{QC, QCP};
    for (int r_ = 0; r_ < REP_GEMM; ++r_) pg8::gemm_phase<pg8::EpiF32, pg8::StaticOrder, true, true>(c.lds, g, S, E, c.tid);
    const Ctx c2 = fresh(c0);
    for (int r_ = 0; r_ < REP_SG; ++r_) sg_f32(HN, 1024, Wt, N, QC, QCP, c2.gw, c2.NGW, c2.lane);
}
__device__ __forceinline__ void ph_qnorm(const Ctx& c0, int j) {
    const Ctx c = fresh(c0);
    unsigned char* ws = ARG_WS(); float* X = ARG_OUT();
    float* c_p = X + (size_t)M * D + (size_t)2 * BATCH * HA * DK * DV; float* kr_p = c_p + (size_t)MP * KVL; float* c_s = kr_p + (size_t)MP * 64 + (size_t)2 * DB * HA * DK * DV; float* kr_s = c_s + (size_t)DB * KVL;
    const float* QC = (const float*)(ws + WS_QC); bf16* QAN = (bf16*)(ws + WS_QAN); bf16* CB = (bf16*)(ws + WS_CB); bf16* KRB = (bf16*)(ws + WS_KRB); const float* CS = (const float*)(ws + WS_CS);
    const float* kv_a_norm = ARG_IN(15); const int lane = c.lane;
    for (int m = c.gw; m < M; m += c.NGW) {
        const float* qc = QC + (size_t)m * QCP;
        float v[6]; float s = 0.f;
#pragma unroll
        for (int i = 0; i < 6; ++i) { v[i] = qc[lane + 64 * i]; s += v[i] * v[i]; }
        const float r = rsqrtf(wave_sum(s) * (1.f / 384.f) + EPS);
#pragma unroll
        for (int i = 0; i < 6; ++i) QAN[(size_t)m * QL + lane + 64 * i] = (bf16)f2bf(v[i] * r);
        if (j == 0) {
            float cc[4]; float s2 = 0.f;
#pragma unroll
            for (int i = 0; i < 4; ++i) { cc[i] = qc[384 + lane + 64 * i]; s2 += cc[i] * cc[i]; }
            const float r2 = rsqrtf(wave_sum(s2) * (1.f / 256.f) + EPS);
            float* co = m < MP ? c_p + (size_t)m * KVL : c_s + (size_t)(m - MP) * KVL;
#pragma unroll
            for (int i = 0; i < 4; ++i) { const float o = cc[i] * r2 * kv_a_norm[lane + 64 * i]; co[lane + 64 * i] = o; CB[(size_t)m * KVL + lane + 64 * i] = (bf16)f2bf(o); }
            if (lane < 32) {
                const float x1 = qc[640 + lane], x2 = qc[672 + lane]; const int p = m < MP ? (m & (SEQ - 1)) : 2048;
                const float cs = CS[(size_t)(p * 32 + lane) * 2], sn = CS[(size_t)(p * 32 + lane) * 2 + 1];
                const float o1 = x1 * cs - x2 * sn, o2 = x2 * cs + x1 * sn;
                float* ko = m < MP ? kr_p + (size_t)m * 64 : kr_s + (size_t)(m - MP) * 64;
                ko[lane] = o1; ko[32 + lane] = o2;
                if (m < MP) ((unsigned*)(KRB + (size_t)m * 64))[lane] = pk2(o1, o2);
            }
        }
    }
}
__device__ __forceinline__ void ph_uq(const Ctx& c0, int j) {
    const Ctx c = fresh(c0);
    unsigned char* ws = ARG_WS();
    const bf16* QAN = (const bf16*)(ws + WS_QAN); const bf16* Wt = (const bf16*)(ws + WS_WUQ) + (size_t)j * 1536 * 384; bf16* QN = (bf16*)(ws + WS_QN); bf16* QR = (bf16*)(ws + WS_QR); const float* CS = (const float*)(ws + WS_CS);
    { pg8::Gemm g{QAN, Wt, MP, 1024, QL}; pg8::StaticOrder S; S.init(MP, 1024, c.G, c.wg);
      pg8::EpiBf16Split E{QN, 1024, 0, 0};
      for (int r_ = 0; r_ < REP_GEMM; ++r_) pg8::gemm_phase<pg8::EpiBf16Split, pg8::StaticOrder, true, true>(c.lds, g, S, E, c.tid); }
    { const Ctx c1 = fresh(c0);
      pg8::Gemm g{QAN, Wt + (size_t)1024 * QL, MP, 512, QL}; pg8::StaticOrder S; S.init(MP, 512, c1.G, c1.wg);
      pg8::EpiRope E{ws};
      for (int r_ = 0; r_ < REP_GEMM; ++r_) pg8::gemm_phase<pg8::EpiRope, pg8::StaticOrder, true, true>(c1.lds, g, S, E, c1.tid); }
    const Ctx c2 = fresh(c0);
    for (int r_ = 0; r_ < REP_SG; ++r_) sg_uq(QAN, Wt, QN, QR, CS, c2.gw, c2.NGW, c2.lane);
}
__device__ __forceinline__ void ph_kvup(const Ctx& c0) {
    const Ctx c = fresh(c0);
    unsigned char* ws = ARG_WS();
    {
        pg8::Gemm g{(const bf16*)(ws + WS_CB), (const bf16*)(ws + WS_WUKV), MP, 1024, KVL}; pg8::StaticOrder S; S.init(MP, 1024, c.G, c.wg);
        pg8::EpiBf16Split E{(bf16*)(ws + WS_KN), 1024, 0, 0};
        for (int r_ = 0; r_ < REP_GEMM; ++r_) pg8::gemm_phase<pg8::EpiBf16Split, pg8::StaticOrder, true, true>(c.lds, g, S, E, c.tid); }
    {
        const Ctx c1 = fresh(c0);
        pg8::Gemm g{(const bf16*)(ws + WS_WUKV) + (size_t)1024 * KVL, (const bf16*)(ws + WS_CB), 1024, MP, KVL}; pg8::StaticOrder S; S.init(1024, MP, c1.G, c1.wg);
        pg8::EpiBf16Split E{(bf16*)(ws + WS_VV), MP, 0, 0};
        for (int r_ = 0; r_ < REP_GEMM; ++r_) pg8::gemm_phase<pg8::EpiBf16Split, pg8::StaticOrder, true, true>(c1.lds, g, S, E, c1.tid); }
}
__device__ __forceinline__ void ph_attn(const Ctx& c0) {
    const Ctx c = fresh(c0);
    unsigned char* ws = ARG_WS(); float* X = ARG_OUT();
    float* c_s = X + (size_t)M * D + (size_t)2 * BATCH * HA * DK * DV + (size_t)MP * KVL + (size_t)MP * 64 + (size_t)2 * DB * HA * DK * DV; float* kr_s = c_s + (size_t)DB * KVL;
    for (int r_ = 0; r_ < REP_ATTN; ++r_) attn_prompt_phase((const bf16*)(ws + WS_QN), (const bf16*)(ws + WS_QR), (const bf16*)(ws + WS_KN), (const bf16*)(ws + WS_KRB), (const bf16*)(ws + WS_VV), (bf16*)(ws + WS_OG), c.lds, c.wg, c.G, c.tid);
    { const Ctx c2 = fresh(c0); unsigned char* ws2 = ARG_WS();
      for (int r_ = 0; r_ < REP_DEC; ++r_) decode_phase((const bf16*)(ws2 + WS_QN), (const bf16*)(ws2 + WS_QR), (const bf16*)(ws2 + WS_WUKVN), ARG_IN(3), ARG_IN(4), (const int*)ARG_IN(5), (float*)(ws2 + WS_PART), (float*)(ws2 + WS_PML), (float*)(ws2 + WS_QLAT), c2.lds, c2.wg, c2.G, c2.tid); }

}
__device__ __forceinline__ void ph_combine(const Ctx& c0) {
    const Ctx c = fresh(c0);
    unsigned char* ws = ARG_WS(); float* X = ARG_OUT();
    float* c_s = X + (size_t)M * D + (size_t)2 * BATCH * HA * DK * DV + (size_t)MP * KVL + (size_t)MP * 64 + (size_t)2 * DB * HA * DK * DV; float* kr_s = c_s + (size_t)DB * KVL;
    decode_combine_phase((const float*)(ws + WS_PART), (const float*)(ws + WS_PML), (const float*)(ws + WS_QLAT), c_s, kr_s, (const bf16*)(ws + WS_WUKV), (bf16*)(ws + WS_OG), c.lds, c.wg, c.G, c.tid);
}
__device__ __forceinline__ void ph_mixout(const Ctx& c0, int l) {
    const Ctx c = fresh(c0);
    unsigned char* ws = ARG_WS();
    const bf16* Wt = (l < 2) ? (const bf16*)(ws + WS_WOUTA) + (size_t)l * 1024 * 1024 : (const bf16*)(ws + WS_WOUTB) + (size_t)(l - 2) * 1024 * 1024;
    const bf16* OG = (const bf16*)(ws + WS_OG); float* MIX = (float*)(ws + WS_MIX);
    pg8::Gemm g{OG, Wt, MP, 1024, 1024}; pg8::StaticOrder S; S.init(MP, 1024, c.G, c.wg);
    pg8::EpiF32 E{MIX, 1024};
    for (int r_ = 0; r_ < REP_GEMM; ++r_) pg8::gemm_phase<pg8::EpiF32, pg8::StaticOrder, true, true>(c.lds, g, S, E, c.tid);
    const Ctx c2 = fresh(c0);
    for (int r_ = 0; r_ < REP_SG; ++r_) sg_f32(OG, 1024, Wt, 1024, MIX, 1024, c2.gw, c2.NGW, c2.lane);
}
__device__ __forceinline__ void ph_resid(const Ctx& c0, int l, int which) {
    const Ctx c = fresh(c0);
    unsigned char* ws = ARG_WS(); float* X = ARG_OUT(); const float* gain = ARG_IN(6) + (size_t)(l * 4 + which) * D;
    const float* MIX = (const float*)(ws + WS_MIX); bf16* HN = (bf16*)(ws + WS_HN);
    for (int m = c.gw; m < M; m += c.NGW) row_resid_norm(MIX + (size_t)m * D, X + (size_t)m * D, gain, HN + (size_t)m * D, c.lane);
}
__device__ __forceinline__ void ph_ffn_in(const Ctx& c0, int l) {
    const Ctx c = fresh(c0);
    unsigned char* ws = ARG_WS();
    const bf16* HN = (const bf16*)(ws + WS_HN); const bf16* Wt = (const bf16*)(ws + WS_WFIN) + (size_t)l * 5632 * 1024; bf16* ACT = (bf16*)(ws + WS_ACT);
    pg8::Gemm g{HN, Wt, MP, 5632, 1024}; pg8::StaticOrder S; S.init(MP, 5632, c.G, c.wg);
    pg8::EpiSwiglu E{ACT, DFF};
    for (int r_ = 0; r_ < REP_GEMM; ++r_) pg8::gemm_phase<pg8::EpiSwiglu, pg8::StaticOrder, true, true>(c.lds, g, S, E, c.tid);
    const Ctx c2 = fresh(c0);
    for (int r_ = 0; r_ < REP_SG; ++r_) sg_swiglu(HN, Wt, ACT, c2.gw, c2.NGW, c2.lane);
}
__device__ __forceinline__ void ph_ffn_out(const Ctx& c0, int l) {
    const Ctx c = fresh(c0);
    unsigned char* ws = ARG_WS();
    const bf16* ACT = (const bf16*)(ws + WS_ACT); const bf16* Wt = (const bf16*)(ws + WS_WFOUT) + (size_t)l * 1024 * 2816; float* MIX = (float*)(ws + WS_MIX);
    pg8::Gemm g{ACT, Wt, MP, 1024, DFF}; pg8::StaticOrder S; S.init(MP, 1024, c.G, c.wg);
    pg8::EpiF32 E{MIX, 1024};
    for (int r_ = 0; r_ < REP_GEMM; ++r_) pg8::gemm_phase<pg8::EpiF32, pg8::StaticOrder, true, true>(c.lds, g, S, E, c.tid);
    const Ctx c2 = fresh(c0);
    for (int r_ = 0; r_ < REP_SG; ++r_) sg_f32(ACT, DFF, Wt, 1024, MIX, 1024, c2.gw, c2.NGW, c2.lane);
}

__global__ void __launch_bounds__(NTHR, 2) mk_fwd(Args args) {
    extern __shared__ __attribute__((aligned(16))) unsigned char lds_raw[];
    Ctx c;
    c.lds = (LAS unsigned char*)lds_raw;
    c.tid = 0; c.lane = 0; c.wave = __builtin_amdgcn_readfirstlane((int)threadIdx.x >> 6);
    c.wg = blockIdx.x; c.G = gridDim.x; c.gw = c.wg * NWAVES + c.wave; c.NGW = c.G * NWAVES;
    for (int u = threadIdx.x; u < (LDS_BYTES - RING_BYTES) / 4; u += NTHR) ((LAS unsigned*)(c.lds + RING_BYTES))[u] = 0u;
    __syncthreads();
#define MAKE_BAR(b) XcdBarrier b; b.wave = c.wave; b.bar = (unsigned*)(ARG_WS() + WS_CTL) + CW_BAR + karg32(192) * XCD_BAR_WORDS; b.x = xb_xcc_id(); b.st = (volatile LAS unsigned*)(c.lds + MISC_OFF) + 8
    { MAKE_BAR(b0); if (xb_thread0(c.wave)) (void)xb_add(&b0.bar[XB_XCNT(b0.x)], 1u); }
#define PH_BEGIN(k) { const int lo_ = karg32(184), hi_ = karg32(188); if (lo_ <= (k) && (k) < hi_) { if ((k) > lo_) { MAKE_BAR(bb); for (int r_ = 0; r_ < REP_BAR; ++r_) xcd_barrier(bb); }
#define PH_END } }
    PH_BEGIN(0) ph_prologue(c); PH_END
    for (int l = 0; l < 4; ++l) {
        const int pb = 1 + l * 11;
        if (l < 2) {
            PH_BEGIN(pb + 0) ph_hgrn_in(c, l); PH_END
            PH_BEGIN(pb + 1) ph_hgrn_pre(c); PH_END
            PH_BEGIN(pb + 2) ph_hgrn_rec(c, l);
#ifdef PROBE_HREC2
            ph_hgrn_rec(c, l);
#endif
            PH_END
            PH_BEGIN(pb + 3) ph_hgrn_post(c, l); PH_END
        } else {
            PH_BEGIN(pb + 0) ph_dq(c, l - 2); PH_END
            PH_BEGIN(pb + 1) ph_qnorm(c, l - 2); PH_END
            PH_BEGIN(pb + 2) ph_uq(c, l - 2); PH_END
            if (l == 2) { PH_BEGIN(pb + 3) ph_kvup(c); PH_END }
            PH_BEGIN(pb + 4) ph_attn(c); PH_END
            PH_BEGIN(pb + 5) ph_combine(c); PH_END
        }
        PH_BEGIN(pb + 6) ph_mixout(c, l); PH_END
        PH_BEGIN(pb + 7) ph_resid(c, l, 1); PH_END
        PH_BEGIN(pb + 8) ph_ffn_in(c, l); PH_END
        PH_BEGIN(pb + 9) ph_ffn_out(c, l); PH_END
        PH_BEGIN(pb + 10) ph_resid(c, l, 3); PH_END
    }
#undef PH_BEGIN
#undef PH_END
}

#ifndef MK_PER_PHASE
#define MK_PER_PHASE 0
#endif
extern "C" void kernel_launch(void* const* d_in, const int* in_sizes, int n_in, void* d_out, int out_size, void* d_ws, size_t ws_size, hipStream_t stream) {
    static int grid = 0;
    if (grid == 0) {
        int dev = 0, cus = 0, per_cu = 0;
        if (n_in != 21 || ws_size < WS_END) { fprintf(stderr, "kernel_launch: unexpected arguments (n_in %d, ws %zu < %zu)\n", n_in, ws_size, (size_t)WS_END); grid = -1; return; }
        if (hipGetDevice(&dev) != hipSuccess || hipDeviceGetAttribute(&cus, hipDeviceAttributeMultiprocessorCount, dev) != hipSuccess) { grid = -1; return; }
        if (hipFuncSetAttribute((const void*)mk_fwd, hipFuncAttributeMaxDynamicSharedMemorySize, LDS_BYTES) != hipSuccess) { fprintf(stderr, "kernel_launch: hipFuncSetAttribute failed\n"); grid = -1; return; }
        if (hipOccupancyMaxActiveBlocksPerMultiprocessor(&per_cu, (const void*)mk_fwd, NTHR, LDS_BYTES) != hipSuccess || per_cu < 1) fprintf(stderr, "kernel_launch: occupancy query reports %d\n", per_cu);
        (void)hipGetLastError();
        grid = cus;
    }
    if (grid < 0) return;
    (void)hipMemsetAsync((char*)d_ws + WS_CTL, 0, CTL_BYTES, stream);
    Args a{};
    for (int i = 0; i < 21; ++i) a.in[i] = (const float*)d_in[i];
    a.out = (float*)d_out; a.ws = (unsigned char*)d_ws;
#if MK_PER_PHASE
    int li = 0;
    for (int k = 0; k < NPH; ++k) { if (!phase_exists(k)) continue; a.ph_lo = k; a.ph_hi = k + 1; a.li = li++; hipLaunchKernelGGL(mk_fwd, dim3(grid), dim3(NTHR), LDS_BYTES, stream, a); }
#else
    a.ph_lo = 0; a.ph_hi = NPH; a.li = 0;
    hipLaunchKernelGGL(mk_fwd, dim3(grid), dim3(NTHR), LDS_BYTES, stream, a);
#endif
    const hipError_t le = hipPeekAtLastError();
    if (le != hipSuccess) fprintf(stderr, "kernel_launch: launch failed: %s\n", hipGetErrorName(le));
}
```
